# Optimizing an MI355X kernel written in HIP

```python
import jax, jax.numpy as jnp
from jax import lax
import numpy as np

D_MODEL = 1024
BATCH = 1
SEQ = 16384
DEPTH = 4

HEAD_DIM = 64
N_Q_HEADS = 12
N_KV_HEADS_A = 4
N_MEM_HEADS = 4
N_MEM = 256
MIX_WIDTH = (N_Q_HEADS + N_MEM_HEADS) * HEAD_DIM
W_IN_A = (N_Q_HEADS + 2 * N_KV_HEADS_A + N_MEM_HEADS) * HEAD_DIM
W_IN_B = (3 * N_Q_HEADS + N_MEM_HEADS) * HEAD_DIM
WINDOW = 128
BLOCK = 128
GRID_W = 64
NA_ROWS_MAX = 8
NA_COLS = 16
D_FF = -(-8 * D_MODEL // (3 * 256)) * 256
N_LAYERS_A = (DEPTH + 1) // 2
N_LAYERS_B = DEPTH // 2
EPS = 1e-6
NEG_INF = -1e30

kernel_name = "hybrid_window_gqa_neighbourhood_memory_encoder"


def rmsnorm(x, g):
    x32 = x.astype(jnp.float32)
    y = x32 * lax.rsqrt(jnp.mean(x32 * x32, axis=-1, keepdims=True) + EPS)
    return (y * g.astype(jnp.float32)).astype(x.dtype)


def alibi_slopes(n_heads):
    return 2.0 ** (-8.0 * jnp.arange(1, n_heads + 1, dtype=jnp.float32) / n_heads)


def windowed_gqa(q, k, v, sink):
    B, S, H, D = q.shape
    Hk = k.shape[2]
    G = H // Hk
    nb = S // BLOCK
    qb = q.reshape(B, nb, BLOCK, Hk, G, D)
    pad = ((0, 0), (BLOCK, BLOCK), (0, 0), (0, 0))
    kp = jnp.pad(k, pad).reshape(B, nb + 2, BLOCK, Hk, D)
    vp = jnp.pad(v, pad).reshape(B, nb + 2, BLOCK, Hk, D)
    kband = jnp.concatenate([kp[:, :-2], kp[:, 1:-1], kp[:, 2:]], axis=2)
    vband = jnp.concatenate([vp[:, :-2], vp[:, 1:-1], vp[:, 2:]], axis=2)
    q_pos = jnp.arange(S).reshape(nb, BLOCK)
    k_pos = jnp.arange(nb)[:, None] * BLOCK - BLOCK + jnp.arange(3 * BLOCK)[None, :]
    dist = jnp.abs(q_pos[:, :, None] - k_pos[:, None, :])
    allowed = (dist <= WINDOW) & (k_pos[:, None, :] >= 0) & (k_pos[:, None, :] < S)
    slopes = alibi_slopes(H).reshape(1, Hk, G, 1, 1, 1)
    s = jnp.einsum('bnikgd,bnukd->bkgniu', qb, kband).astype(jnp.float32) * (D ** -0.5)
    s = s - slopes * dist.astype(jnp.float32)[None, None, None]
    s = jnp.where(allowed[None, None, None], s, NEG_INF)
    sink_col = jnp.broadcast_to(sink.astype(jnp.float32).reshape(1, Hk, G, 1, 1, 1), s.shape[:-1] + (1,))
    p = jax.nn.softmax(jnp.concatenate([s, sink_col], axis=-1), axis=-1)[..., :-1]
    o = jnp.einsum('bkgniu,bnukd->bnikgd', p.astype(v.dtype), vband)
    return o.reshape(B, S, H * D)


def neighbourhood_attn(q, k, v, rpb):
    B, S, H, D = q.shape
    rows = S // GRID_W
    kr = min(NA_ROWS_MAX, rows)
    qg = q.reshape(B, rows, GRID_W, H, D)
    kg = k.reshape(B, rows, GRID_W, H, D)
    vg = v.reshape(B, rows, GRID_W, H, D)
    r = jnp.arange(rows)
    row_start = jnp.clip(r - kr // 2, 0, rows - kr)
    row_idx = row_start[:, None] + jnp.arange(kr)[None, :]
    kband = kg[:, row_idx]
    vband = vg[:, row_idx]
    c = jnp.arange(GRID_W)
    col_start = jnp.clip(c - NA_COLS // 2, 0, GRID_W - NA_COLS)
    in_win = (c[None, :] >= col_start[:, None]) & (c[None, :] < col_start[:, None] + NA_COLS)
    dr_idx = row_idx - r[:, None] + NA_ROWS_MAX - 1
    dc_idx = jnp.clip(c[None, :] - c[:, None], -(NA_COLS - 1), NA_COLS - 1) + NA_COLS - 1
    bias = rpb.astype(jnp.float32)[:, dr_idx][:, :, :, dc_idx]
    bias = bias.transpose(0, 1, 3, 2, 4)
    s = jnp.einsum('brchd,brijhd->bhrcij', qg, kband).astype(jnp.float32) * (D ** -0.5)
    s = s + bias[None]
    s = jnp.where(in_win[None, None, None, :, None, :], s, NEG_INF)
    sh = s.shape
    p = jax.nn.softmax(s.reshape(sh[:-2] + (kr * GRID_W,)), axis=-1).reshape(sh)
    o = jnp.einsum('bhrcij,brijhd->brchd', p.astype(v.dtype), vband)
    return o.reshape(B, S, H * D)


def memory_attn(q, k, v):
    B, S, Hm, D = q.shape
    s = jnp.einsum('bshd,bmhd->bhsm', q, k).astype(jnp.float32) * (D ** -0.5)
    p = jax.nn.softmax(s, axis=-1)
    o = jnp.einsum('bhsm,bmhd->bshd', p.astype(v.dtype), v)
    return o.reshape(B, S, Hm * D)


def setup_inputs(seed: int = 0) -> dict:
    key = jax.random.key(seed)
    ks = jax.random.split(key, 16)
    f32 = jnp.float32
    nrm = lambda k, shape, scale: jax.random.normal(k, shape, f32) * scale
    return {
        "x": nrm(ks[0], (BATCH, SEQ, D_MODEL), 1.0),
        "mem": nrm(ks[1], (BATCH, N_MEM, D_MODEL), 1.0),
        "norm_mix": 1.0 + nrm(ks[2], (DEPTH, D_MODEL), 0.02),
        "norm_ffn": 1.0 + nrm(ks[3], (DEPTH, D_MODEL), 0.02),
        "norm_mem": 1.0 + nrm(ks[4], (D_MODEL,), 0.02),
        "norm_final": 1.0 + nrm(ks[5], (D_MODEL,), 0.02),
        "w_in_a": nrm(ks[6], (N_LAYERS_A, D_MODEL, W_IN_A), D_MODEL ** -0.5),
        "sink_a": nrm(ks[7], (N_LAYERS_A, N_Q_HEADS), 0.5),
        "w_in_b": nrm(ks[8], (N_LAYERS_B, D_MODEL, W_IN_B), D_MODEL ** -0.5),
        "rpb_b": nrm(ks[9], (N_LAYERS_B, N_Q_HEADS, 2 * NA_ROWS_MAX - 1, 2 * NA_COLS - 1), 0.3),
        "w_mem_kv": nrm(ks[10], (DEPTH, D_MODEL, 2 * N_MEM_HEADS * HEAD_DIM), D_MODEL ** -0.5),
        "w_out": nrm(ks[11], (DEPTH, MIX_WIDTH, D_MODEL), MIX_WIDTH ** -0.5),
        "w_gate_up": nrm(ks[12], (DEPTH, D_MODEL, 2 * D_FF), D_MODEL ** -0.5),
        "w_down": nrm(ks[13], (DEPTH, D_FF, D_MODEL), D_FF ** -0.5),
    }


def reference(x, mem, norm_mix, norm_ffn, norm_mem, norm_final, w_in_a, sink_a, w_in_b, rpb_b,
              w_mem_kv, w_out, w_gate_up, w_down):
    B, S, _ = x.shape
    qw = N_Q_HEADS * HEAD_DIM
    kvw = N_KV_HEADS_A * HEAD_DIM
    mw = N_MEM_HEADS * HEAD_DIM
    mem_n = rmsnorm(mem, norm_mem)
    for i in range(DEPTH):
        li = i // 2
        h = rmsnorm(x, norm_mix[i])
        mkv = mem_n @ w_mem_kv[i]
        mk = mkv[..., :mw].reshape(B, N_MEM, N_MEM_HEADS, HEAD_DIM)
        mv = mkv[..., mw:].reshape(B, N_MEM, N_MEM_HEADS, HEAD_DIM)
        if i % 2 == 0:
            proj = h @ w_in_a[li]
            q, k, v, qm = jnp.split(proj, [qw, qw + kvw, qw + 2 * kvw], axis=-1)
            y_tok = windowed_gqa(q.reshape(B, S, N_Q_HEADS, HEAD_DIM),
                                 k.reshape(B, S, N_KV_HEADS_A, HEAD_DIM),
                                 v.reshape(B, S, N_KV_HEADS_A, HEAD_DIM), sink_a[li])
        else:
            proj = h @ w_in_b[li]
            q, k, v, qm = jnp.split(proj, [qw, 2 * qw, 3 * qw], axis=-1)
            y_tok = neighbourhood_attn(q.reshape(B, S, N_Q_HEADS, HEAD_DIM),
                                       k.reshape(B, S, N_Q_HEADS, HEAD_DIM),
                                       v.reshape(B, S, N_Q_HEADS, HEAD_DIM), rpb_b[li])
        y_mem = memory_attn(qm.reshape(B, S, N_MEM_HEADS, HEAD_DIM), mk, mv)
        x = x + jnp.concatenate([y_tok, y_mem], axis=-1) @ w_out[i]
        h = rmsnorm(x, norm_ffn[i])
        gu = h @ w_gate_up[i]
        x = x + (jax.nn.silu(gu[..., :D_FF]) * gu[..., D_FF:]) @ w_down[i]
    return rmsnorm(x, norm_final)
```

```cpp
#define MK_PER_PHASE 1
#define MK_NAIVE 0
#include <hip/hip_runtime.h>
#include <cstdio>
#include <cstdint>
namespace pg8 {
#define PG8_LAS __attribute__((address_space(3)))
typedef unsigned short bf16_t;
typedef short bf16x8 __attribute__((ext_vector_type(8)));
typedef float f32x4 __attribute__((ext_vector_type(4)));
typedef unsigned u32x4 __attribute__((ext_vector_type(4)));
constexpr int BM = 256, BK = 64, HALF = 128, HTB = HALF * BK * 2  , STAGE_BYTES = 8 * HTB, NXCD = 8, WGM = 8;

__host__ __device__ __forceinline__ int lds_byte(int r, int c) { const int st = (r >> 4) * 2 + (c >> 5), rr = r & 15, cc = c & 31, ob = rr * 64 + cc * 2; return st * 1024 + (ob ^ (((ob >> 9) & 1) << 5)); }
__host__ __device__ __forceinline__ void stage_rc(int b, int& R, int& C) { const int st = b / 1024, sb = b % 1024, swz = sb ^ (((sb >> 9) & 1) << 5); R = (st >> 1) * 16 + swz / 64; C = (st & 1) * 32 + (swz % 64) / 2; }
__host__ __device__ __forceinline__ int perm32(int rho) { const int n = rho >> 4, i = rho & 15; return 8 * (i >> 2) + 4 * n + (i & 3); }

struct Unit { int pm, pn; };
struct Gemm { const bf16_t* A; const bf16_t* Bt; int M, N, K; };

struct StaticOrder {
    int nM, nN, nwg, G, c;
    __host__ __device__ void init(int M, int N, int G_, int c_) { nM = M / BM; nN = N / BM; nwg = nM * nN; G = G_; c = c_; }
    __host__ __device__ bool next(int i, Unit& u) const {
        const long L = (long)i * G + c; if (L >= nwg) return false;
        int wgid = (int)L; { const int q = nwg / NXCD, r = nwg % NXCD, xcd = wgid % NXCD, off = wgid / NXCD; wgid = (xcd < r ? xcd * (q + 1) : r * (q + 1) + (xcd - r) * q) + off; }
        const int nig = WGM * nN, gid = wgid / nig, fm = gid * WGM, gsz = (nM - fm) < WGM ? (nM - fm) : WGM;
        u.pm = fm + ((wgid % nig) % gsz); u.pn = (wgid % nig) / gsz; return true;
    }
    __device__ __forceinline__ void a_ready(const Unit&) const {}
    __device__ __forceinline__ void done(const Unit&) const {}
};

__device__ __forceinline__ unsigned cvt_pk_bf16(float lo, float hi) { unsigned r; asm volatile("v_cvt_pk_bf16_f32 %0, %1, %2" : "=v"(r) : "v"(lo), "v"(hi)); return r; }
typedef float f32x2 __attribute__((ext_vector_type(2)));
__device__ __forceinline__ float row_rstd(const float* ssq, int row) {
    const f32x4* p = (const f32x4*)(ssq + (size_t)row * 16);
    const f32x4 a = p[0], b = p[1], c = p[2], d = p[3];
    const float s = (((a[0] + a[1]) + (a[2] + a[3])) + ((b[0] + b[1]) + (b[2] + b[3]))) + (((c[0] + c[1]) + (c[2] + c[3])) + ((d[0] + d[1]) + (d[2] + d[3])));
    return __builtin_amdgcn_rsqf(s * (1.0f / 1024.0f) + 1e-6f);
}
struct EpiProj {
    static constexpr bool PERM = true, AFTER_DRAIN = false;
    bf16_t* O; int ldc; const float* ssq; int nq_tiles, qm_tile; float qscale;
    __device__ __forceinline__ void operator()(const f32x4 (&acc)[2][2][4][2], const Unit& u, int wr, int wc, int fr, int fq) const {
        const int row0 = u.pm * BM + wr * 64 + fr;
        const float sc = (u.pn < nq_tiles || u.pn == qm_tile) ? qscale : 1.f;
        const int col0 = u.pn * BM + wc * 32 + 8 * fq;
#pragma unroll
        for (int ai = 0; ai < 2; ++ai)
#pragma unroll
            for (int m = 0; m < 4; ++m) { const int row = row0 + ai * HALF + m * 16; const float rs = ssq ? row_rstd(ssq, row) * sc : sc;
                bf16_t* rowp = O + (size_t)row * ldc + col0;
#pragma unroll
                for (int bj = 0; bj < 2; ++bj) { const f32x4 v0 = acc[ai][bj][m][0] * rs, v1 = acc[ai][bj][m][1] * rs;
                    u32x4 w; w.x = cvt_pk_bf16(v0[0], v0[1]); w.y = cvt_pk_bf16(v0[2], v0[3]); w.z = cvt_pk_bf16(v1[0], v1[1]); w.w = cvt_pk_bf16(v1[2], v1[3]);
                    *(u32x4*)(rowp + bj * HALF) = w; } }
    }
};
struct EpiRes {
    static constexpr bool PERM = true, AFTER_DRAIN = false;
    const float* base; float* out; bf16_t* xb; float* ssq_out; int ldc;
    __device__ __forceinline__ void operator()(const f32x4 (&acc)[2][2][4][2], const Unit& u, int wr, int wc, int fr, int fq) const {
        const int row0 = u.pm * BM + wr * 64 + fr;
        const int col0 = u.pn * BM + wc * 32 + 8 * fq;
#pragma unroll
        for (int ai = 0; ai < 2; ++ai)
#pragma unroll
            for (int m = 0; m < 4; ++m) { const int row = row0 + ai * HALF + m * 16; const size_t off = (size_t)row * ldc + col0; float ss = 0.f;
#pragma unroll
                for (int bj = 0; bj < 2; ++bj) { const f32x4 b0 = *(const f32x4*)(base + off + bj * HALF), b1 = *(const f32x4*)(base + off + bj * HALF + 4);
                    const f32x4 v0 = b0 + acc[ai][bj][m][0], v1 = b1 + acc[ai][bj][m][1];
                    *(f32x4*)(out + off + bj * HALF) = v0; *(f32x4*)(out + off + bj * HALF + 4) = v1;
                    u32x4 w; w.x = cvt_pk_bf16(v0[0], v0[1]); w.y = cvt_pk_bf16(v0[2], v0[3]); w.z = cvt_pk_bf16(v1[0], v1[1]); w.w = cvt_pk_bf16(v1[2], v1[3]);
                    *(u32x4*)(xb + off + bj * HALF) = w;
                    ss += ((v0[0] * v0[0] + v0[1] * v0[1]) + (v0[2] * v0[2] + v0[3] * v0[3])) + ((v1[0] * v1[0] + v1[1] * v1[1]) + (v1[2] * v1[2] + v1[3] * v1[3])); }
                ss += __shfl_xor(ss, 16); ss += __shfl_xor(ss, 32);
                if (fq == 0) ssq_out[(size_t)row * 16 + u.pn * 4 + wc] = ss; }
    }
};
struct EpiGU {
    static constexpr bool PERM = true, AFTER_DRAIN = false;
    bf16_t* H; int ldh; const float* ssq;
    static __device__ __forceinline__ float swi(float g, float u) { return g * u * __builtin_amdgcn_rcpf(1.0f + __builtin_amdgcn_exp2f(-1.4426950408889634f * g)); }
    __device__ __forceinline__ void operator()(const f32x4 (&acc)[2][2][4][2], const Unit& u, int wr, int wc, int fr, int fq) const {
        const int row0 = u.pm * BM + wr * 64 + fr;
        const int col0 = u.pn * HALF + wc * 32 + 8 * fq;
#pragma unroll
        for (int ai = 0; ai < 2; ++ai)
#pragma unroll
            for (int m = 0; m < 4; ++m) { const int row = row0 + ai * HALF + m * 16; const float rs = row_rstd(ssq, row);
                const f32x4 g0 = acc[ai][0][m][0] * rs, g1 = acc[ai][0][m][1] * rs, u0 = acc[ai][1][m][0] * rs, u1 = acc[ai][1][m][1] * rs;
                u32x4 w; w.x = cvt_pk_bf16(swi(g0[0], u0[0]), swi(g0[1], u0[1])); w.y = cvt_pk_bf16(swi(g0[2], u0[2]), swi(g0[3], u0[3]));
                w.z = cvt_pk_bf16(swi(g1[0], u1[0]), swi(g1[1], u1[1])); w.w = cvt_pk_bf16(swi(g1[2], u1[2]), swi(g1[3], u1[3]));
                *(u32x4*)(H + (size_t)row * ldh + col0) = w; }
    }
};
template <class Epi, class Sched, bool ALIGN_EPI = false, bool SP2 = false>
__device__ __forceinline__ void gemm_phase(PG8_LAS unsigned char* lds, const Gemm g, const Sched& S, const Epi& E) {
    int tid_ = threadIdx.x; asm volatile("" : "+v"(tid_));
    const int tid = tid_, wid = __builtin_amdgcn_readfirstlane(tid >> 6), lane = tid & 63, wr = wid >> 2, wc = wid & 3, fr = lane & 15, fq = lane >> 4;
    const int K = g.K, nt = K / BK;
    unsigned voffA[2], voffB[2];
#pragma unroll
    for (int i = 0; i < 2; ++i) { int R, C; stage_rc(tid * 16 + i * 8192, R, C); const int Rb = Epi::PERM ? ((R & ~31) + perm32(R & 31)) : R;
        voffA[i] = (unsigned)(R * K + C) * 2u; voffB[i] = (unsigned)(Rb * K + C) * 2u; }
    const size_t kstep = (size_t)(BK * 2);
    const size_t hstep = (size_t)HALF * K * 2;
    const size_t tstep = 2 * hstep;
    const unsigned ldsw = (unsigned)wid * 1024u;
    const int aoff = lds_byte(wr * 64 + fr, fq * 8), boff = lds_byte(wc * 32 + fr, fq * 8);
#define PG8_SA(b, h) (((b) * 2 + (h)) * HTB)
#define PG8_SB(b, h) ((4 + (b) * 2 + (h)) * HTB)
#define PG8_STAGE(bufoff, gbase, voff) do { _Pragma("unroll") for (int _i = 0; _i < 2; ++_i) \
        __builtin_amdgcn_global_load_lds((const unsigned*)((const char*)(gbase) + (voff)[_i]), (PG8_LAS unsigned*)(lds + (bufoff) + ldsw + _i * 8192), 16, 0, 0); } while (0)
#define PG8_LDA(dst, b, h) do { _Pragma("unroll") for (int m = 0; m < 4; ++m) _Pragma("unroll") for (int k = 0; k < 2; ++k) dst[m][k] = *(const PG8_LAS bf16x8*)(lds + PG8_SA(b, h) + aoff + m * 2048 + k * 1024); } while (0)
#define PG8_LDB(dst, b, h) do { _Pragma("unroll") for (int n = 0; n < 2; ++n) _Pragma("unroll") for (int k = 0; k < 2; ++k) dst[n][k] = *(const PG8_LAS bf16x8*)(lds + PG8_SB(b, h) + boff + n * 2048 + k * 1024); } while (0)
#define PG8_MMA(ai, bj, At, Bt) do { __builtin_amdgcn_s_setprio(1); _Pragma("unroll") for (int m = 0; m < 4; ++m) _Pragma("unroll") for (int n = 0; n < 2; ++n) _Pragma("unroll") for (int k = 0; k < 2; ++k) \
        acc[ai][bj][m][n] = __builtin_amdgcn_mfma_f32_16x16x32_bf16(Bt[n][k], At[m][k], acc[ai][bj][m][n], 0, 0, 0); __builtin_amdgcn_s_setprio(0); } while (0)
#define PG8_WAIT_V(n) asm volatile("s_waitcnt vmcnt(" #n ")" ::: "memory")
#define PG8_WAIT_L(n) asm volatile("s_waitcnt lgkmcnt(" #n ")" ::: "memory")
#define PG8_BAR __builtin_amdgcn_s_barrier()
#define PG8_SCHED __builtin_amdgcn_sched_barrier(0)
    Unit cur, nxt; int ui = 0;
    if (!S.next(0, cur)) return;
    f32x4 acc[2][2][4][2];
#pragma unroll
    for (int a = 0; a < 2; ++a)
#pragma unroll
        for (int b = 0; b < 2; ++b)
#pragma unroll
            for (int m = 0; m < 4; ++m)
#pragma unroll
                for (int n = 0; n < 2; ++n) acc[a][b][m][n] = (f32x4){0.f, 0.f, 0.f, 0.f};
    bf16x8 At[4][2], B0[2][2], B1[2][2];
    const char* cA = (const char*)g.A + (size_t)cur.pm * tstep; const char* cB = (const char*)g.Bt + (size_t)cur.pn * tstep;
    S.a_ready(cur);
    if constexpr (SP2) {
        PG8_STAGE(PG8_SB(0, 0), cB, voffB); PG8_STAGE(PG8_SB(0, 1), cB + hstep, voffB); PG8_STAGE(PG8_SA(0, 0), cA, voffA); PG8_STAGE(PG8_SA(0, 1), cA + hstep, voffA);
        if (wr == 1) PG8_BAR;
        PG8_WAIT_V(2); PG8_BAR;
        PG8_STAGE(PG8_SB(1, 0), cB + kstep, voffB); PG8_STAGE(PG8_SA(1, 0), cA + kstep, voffA); PG8_STAGE(PG8_SB(1, 1), cB + hstep + kstep, voffB);
        PG8_WAIT_V(6); PG8_BAR;
    } else {
        PG8_STAGE(PG8_SB(0, 0), cB, voffB); PG8_STAGE(PG8_SA(0, 0), cA, voffA); PG8_STAGE(PG8_SB(0, 1), cB + hstep, voffB); PG8_STAGE(PG8_SA(0, 1), cA + hstep, voffA);
        if (wr == 1) PG8_BAR;
        PG8_WAIT_V(4); PG8_BAR;
        PG8_STAGE(PG8_SB(1, 0), cB + kstep, voffB); PG8_STAGE(PG8_SA(1, 0), cA + kstep, voffA); PG8_STAGE(PG8_SB(1, 1), cB + hstep + kstep, voffB);
        PG8_WAIT_V(6); PG8_BAR;
    }
    for (;;) {
        const bool has_next = S.next(ui + 1, nxt);
        const char* nA = has_next ? (const char*)g.A + (size_t)nxt.pm * tstep : cA; const char* nB = has_next ? (const char*)g.Bt + (size_t)nxt.pn * tstep : cB;
        for (int t = 0; t < nt; t += 2) {
            const bool last = (t == nt - 2);
            const char* a1 = cA + (size_t)(t + 1) * kstep;
            const char* a2 = last ? nA : cA + (size_t)(t + 2) * kstep; const char* b2 = last ? nB : cB + (size_t)(t + 2) * kstep;
            const char* a3 = a2 + kstep; const char* b3 = b2 + kstep;
            if (last && has_next) S.a_ready(nxt);
            if constexpr (SP2) {
            PG8_LDB(B0, 0, 0); PG8_LDB(B1, 0, 1); PG8_SCHED; PG8_LDA(At, 0, 0); PG8_STAGE(PG8_SA(1, 1), a1 + hstep, voffA);
            PG8_WAIT_V(8); PG8_WAIT_L(0); PG8_BAR; PG8_MMA(0, 0, At, B0); PG8_MMA(0, 1, At, B1); PG8_BAR; PG8_SCHED;
            PG8_LDA(At, 0, 1); PG8_STAGE(PG8_SB(0, 0), b2, voffB); PG8_STAGE(PG8_SB(0, 1), b2 + hstep, voffB); PG8_STAGE(PG8_SA(0, 0), a2, voffA);
            PG8_WAIT_V(8); PG8_WAIT_L(0); PG8_BAR; PG8_MMA(1, 0, At, B0); PG8_MMA(1, 1, At, B1); PG8_BAR; PG8_SCHED;
            PG8_LDB(B0, 1, 0); PG8_LDB(B1, 1, 1); PG8_SCHED; PG8_LDA(At, 1, 0); PG8_STAGE(PG8_SA(0, 1), a2 + hstep, voffA);
            PG8_WAIT_V(8); PG8_WAIT_L(0); PG8_BAR; PG8_MMA(0, 0, At, B0); PG8_MMA(0, 1, At, B1); PG8_BAR; PG8_SCHED;
            PG8_LDA(At, 1, 1); PG8_STAGE(PG8_SB(1, 0), b3, voffB); PG8_STAGE(PG8_SB(1, 1), b3 + hstep, voffB); PG8_STAGE(PG8_SA(1, 0), a3, voffA);
            PG8_WAIT_V(8); PG8_WAIT_L(0); PG8_BAR; PG8_MMA(1, 0, At, B0); PG8_MMA(1, 1, At, B1); PG8_BAR; PG8_SCHED;
            } else {
            PG8_LDB(B0, 0, 0); PG8_SCHED; PG8_LDA(At, 0, 0); PG8_STAGE(PG8_SA(1, 1), a1 + hstep, voffA);
            PG8_WAIT_L(8); PG8_BAR; PG8_WAIT_L(0); PG8_MMA(0, 0, At, B0); PG8_BAR; PG8_SCHED;
            PG8_LDB(B1, 0, 1); PG8_STAGE(PG8_SB(0, 0), b2, voffB);
            PG8_BAR; PG8_WAIT_L(0); PG8_MMA(0, 1, At, B1); PG8_BAR;
            PG8_LDA(At, 0, 1); PG8_STAGE(PG8_SA(0, 0), a2, voffA);
            PG8_BAR; PG8_WAIT_L(0); PG8_MMA(1, 0, At, B0); PG8_BAR; PG8_SCHED;
            PG8_STAGE(PG8_SB(0, 1), b2 + hstep, voffB);
            PG8_WAIT_V(6); PG8_BAR; PG8_MMA(1, 1, At, B1); PG8_BAR;
            PG8_LDB(B0, 1, 0); PG8_SCHED; PG8_LDA(At, 1, 0); PG8_STAGE(PG8_SA(0, 1), a2 + hstep, voffA);
            PG8_WAIT_L(8); PG8_BAR; PG8_WAIT_L(0); PG8_MMA(0, 0, At, B0); PG8_BAR; PG8_SCHED;
            PG8_LDB(B1, 1, 1); PG8_STAGE(PG8_SB(1, 0), b3, voffB);
            PG8_BAR; PG8_WAIT_L(0); PG8_MMA(0, 1, At, B1); PG8_BAR;
            PG8_LDA(At, 1, 1); PG8_STAGE(PG8_SA(1, 0), a3, voffA);
            PG8_BAR; PG8_WAIT_L(0); PG8_MMA(1, 0, At, B0); PG8_BAR; PG8_SCHED;
            PG8_STAGE(PG8_SB(1, 1), b3 + hstep, voffB);
            PG8_WAIT_V(6); PG8_BAR; PG8_MMA(1, 1, At, B1); PG8_BAR;
            }
        }
        if constexpr (ALIGN_EPI) { if (wr == 0) PG8_BAR; }
        if constexpr (!Epi::AFTER_DRAIN) { E(acc, cur, wr, wc, fr, fq); S.done(cur); }
        if (!has_next) break;
#pragma unroll
        for (int a = 0; a < 2; ++a)
#pragma unroll
            for (int b = 0; b < 2; ++b)
#pragma unroll
                for (int m = 0; m < 4; ++m)
#pragma unroll
                    for (int n = 0; n < 2; ++n) acc[a][b][m][n] = (f32x4){0.f, 0.f, 0.f, 0.f};
        cur = nxt; cA = nA; cB = nB; ++ui;
        if constexpr (ALIGN_EPI) { if (wr == 1) PG8_BAR; }
    }
    PG8_WAIT_V(0);
    if constexpr (!ALIGN_EPI) { if (wr == 0) PG8_BAR; }
    PG8_BAR;
    if constexpr (Epi::AFTER_DRAIN) { E.fused(acc, cur, wr, wc, fr, fq, lds, wid, lane); S.done(cur); }
#undef PG8_SA
#undef PG8_SB
#undef PG8_STAGE
#undef PG8_LDA
#undef PG8_LDB
#undef PG8_MMA
#undef PG8_WAIT_V
#undef PG8_WAIT_L
#undef PG8_BAR
#undef PG8_SCHED
}
}
namespace att {
typedef unsigned short bf16_t;
using bf16x8 = __attribute__((ext_vector_type(8))) short;
using s16x4 = __attribute__((ext_vector_type(4))) short;
using f32x16 = __attribute__((ext_vector_type(16))) float;
using u32x4 = __attribute__((ext_vector_type(4))) unsigned;
#define ATT_LAS __attribute__((address_space(3)))
constexpr int NW = 8, NSLOT = 3, SLOTB = 16384, VOFF = 8192;
constexpr int LDS_WS = NSLOT * SLOTB, LDS_OST = LDS_WS + NW * 256, LDS_TAB = LDS_OST + NW * 4096, TAB_PAD = 64, LDS_END = LDS_TAB + 4096;
constexpr float NEG_INF = -__builtin_inff();
__device__ __forceinline__ constexpr int crow(int r, int hi) { return (r & 3) + 8 * (r >> 2) + 4 * hi; }
__device__ __forceinline__ void glds16(const void* gsrc, unsigned lds_dst) { unsigned keep;
    asm volatile("s_mov_b32 %0, m0\n\ts_mov_b32 m0, %2\n\ts_nop 0\n\tglobal_load_lds_dwordx4 %1, off\n\ts_mov_b32 m0, %0" : "=&s"(keep) : "v"(gsrc), "s"(lds_dst) : "memory"); }
__device__ __forceinline__ float max3f(float a, float b, float c) { return __builtin_fmaxf(__builtin_fmaxf(a, b), c); }
typedef float f32x2_t __attribute__((ext_vector_type(2))); typedef __bf16 bf16x2_t __attribute__((ext_vector_type(2)));
__device__ __forceinline__ unsigned cvtpk_s(float lo, float hi) { f32x2_t v = {lo, hi}; bf16x2_t b = __builtin_convertvector(v, bf16x2_t); return __builtin_bit_cast(unsigned, b); }

__device__ __forceinline__ void qkt(f32x16& p0, f32x16& p1, const ATT_LAS char* kp, const bf16x8* qr) {
    const f32x16 z = f32x16{};
#pragma unroll
    for (int d0 = 0; d0 < 4; ++d0) {
        const bf16x8 b0 = *(const ATT_LAS bf16x8*)(kp + d0 * 2048);
        const bf16x8 b1 = *(const ATT_LAS bf16x8*)(kp + d0 * 2048 + 512);
        if (d0 == 0) { p0 = __builtin_amdgcn_mfma_f32_32x32x16_bf16(b0, qr[0], z, 0, 0, 0); p1 = __builtin_amdgcn_mfma_f32_32x32x16_bf16(b1, qr[0], z, 0, 0, 0); }
        else { p0 = __builtin_amdgcn_mfma_f32_32x32x16_bf16(b0, qr[d0], p0, 0, 0, 0); p1 = __builtin_amdgcn_mfma_f32_32x32x16_bf16(b1, qr[d0], p1, 0, 0, 0); } }
}
__device__ __forceinline__ float rowmax(const f32x16& p0, const f32x16& p1) {
    float a = max3f(p0[0], p0[1], p1[0]), b = max3f(p0[2], p0[3], p1[1]); a = max3f(a, p1[2], p1[3]);
#pragma unroll
    for (int r = 4; r < 16; r += 4) { a = max3f(a, p0[r], p0[r + 1]); b = max3f(b, p0[r + 2], p0[r + 3]); a = max3f(a, p1[r], p1[r + 1]); b = max3f(b, p1[r + 2], p1[r + 3]); }
    const float m = __builtin_fmaxf(a, b);
    auto rr = __builtin_amdgcn_permlane32_swap(__float_as_uint(m), __float_as_uint(m), false, false);
    return __builtin_fmaxf(__uint_as_float(rr[0]), __uint_as_float(rr[1]));
}
__device__ __forceinline__ void pv(f32x16* o, int vb, bf16x8 pa0, bf16x8 pa1, bf16x8 pa2, bf16x8 pa3) {
#pragma unroll
    for (int d0 = 0; d0 < 2; ++d0) { s16x4 lo[4], hi[4];
#pragma unroll
        for (int ks = 0; ks < 4; ++ks) {
            asm volatile("ds_read_b64_tr_b16 %0,%1 offset:%c2" : "=&v"(lo[ks]) : "v"(vb), "i"(d0 * 4096 + ks * 1024) : "memory");
            asm volatile("ds_read_b64_tr_b16 %0,%1 offset:%c2" : "=&v"(hi[ks]) : "v"(vb), "i"(d0 * 4096 + ks * 1024 + 512) : "memory"); }
        asm volatile("s_waitcnt lgkmcnt(0)" ::: "memory"); __builtin_amdgcn_sched_barrier(0);
#define ATT_PK(k) (bf16x8){lo[k][0], lo[k][1], lo[k][2], lo[k][3], hi[k][0], hi[k][1], hi[k][2], hi[k][3]}
        o[d0] = __builtin_amdgcn_mfma_f32_32x32x16_bf16(pa0, ATT_PK(0), o[d0], 0, 0, 0);
        o[d0] = __builtin_amdgcn_mfma_f32_32x32x16_bf16(pa1, ATT_PK(1), o[d0], 0, 0, 0);
        o[d0] = __builtin_amdgcn_mfma_f32_32x32x16_bf16(pa2, ATT_PK(2), o[d0], 0, 0, 0);
        o[d0] = __builtin_amdgcn_mfma_f32_32x32x16_bf16(pa3, ATT_PK(3), o[d0], 0, 0, 0);
#undef ATT_PK
    }
}

struct UnitP {
    const bf16_t* Q; int qpitch;
    const bf16_t* K; const bf16_t* V; int kvpitch, kvmax;
    int row0, ntiles;
    bf16_t* O; int opitch;
    int tok0;
    float slope2, m0, l0;
    const float* rpb;
    int seqlen;
};
template <int TYPE>
__device__ __forceinline__ void attn_unit(const UnitP& U, ATT_LAS unsigned char* lds) {
    int tid_ = threadIdx.x; asm volatile("" : "+v"(tid_));
    const int tid = tid_, lane = tid & 63, r32 = lane & 31, hi = lane >> 5; const int wid = __builtin_amdgcn_readfirstlane(tid >> 6);
    const unsigned lds0 = (unsigned)(uintptr_t)lds;
    const ATT_LAS char* shm3 = (const ATT_LAS char*)lds;
    ATT_LAS float* wsf = (ATT_LAS float*)(lds + LDS_WS) + wid * 64;
    ATT_LAS float* tab = (ATT_LAS float*)(lds + LDS_TAB);
    if (TYPE == 1) { for (int i = tid; i < 15 * 31; i += NW * 64) tab[TAB_PAD + i] = U.rpb[i] * 1.4426950408889634f; }
    const int NT = U.ntiles;
    const int krow = lane, vrow = 16 * (wid & 3) + (lane >> 2);
    const bf16_t* kcol = U.K + wid * 8; const bf16_t* vcol = U.V + (wid >> 2) * 32 + (lane & 3) * 8;
    const unsigned kdst = lds0 + wid * 1024, vdst = lds0 + VOFF + wid * 1024;
#define ATT_CLAMP(r) ((r) < 0 ? 0 : ((r) > U.kvmax ? U.kvmax : (r)))
#define ATT_DMA(t, slot) do { const int rb_ = U.row0 + 64 * (t); const int kr_ = ATT_CLAMP(rb_ + krow), vr_ = ATT_CLAMP(rb_ + vrow); \
        glds16(kcol + (size_t)kr_ * U.kvpitch, (unsigned)__builtin_amdgcn_readfirstlane(kdst + (slot) * SLOTB)); \
        glds16(vcol + (size_t)vr_ * U.kvpitch, (unsigned)__builtin_amdgcn_readfirstlane(vdst + (slot) * SLOTB)); } while (0)
    ATT_DMA(0, 0);
    bf16x8 qr[4];
    { const bf16_t* Qw = U.Q + (size_t)(wid * 32 + r32) * U.qpitch + hi * 8;
#pragma unroll
      for (int d0 = 0; d0 < 4; ++d0) qr[d0] = *(const bf16x8*)(Qw + d0 * 16); }
    float m = U.m0, l = (hi == 0) ? U.l0 : 0.f;
    f32x16 o[2]; o[0] = f32x16{}; o[1] = f32x16{};
    const int vb0 = (int)(lds0 + VOFF) + ((lane >> 4) & 1) * 32 + (lane & 3) * 8 + (4 * hi + ((lane & 15) >> 2)) * 64;
    const ATT_LAS char* kp0 = shm3 + hi * 1024 + r32 * 16;
    int t_lo, t_hi;
    if (TYPE == 0) { t_lo = wid >> 1; t_hi = t_lo + 4; }
    else if (TYPE == 1) { const int r = U.tok0 + (wid >> 1); int rs = r - 4; rs = rs < 0 ? 0 : (rs > 248 ? 248 : rs); const int T0 = U.row0 >> 6; t_lo = rs - T0; t_hi = t_lo + 7; }
    else { t_lo = 0; t_hi = NT - 1; }
    int slot = 0;
    for (int t = 0; t < NT; ++t) {
        const int nslot = (slot == NSLOT - 1) ? 0 : slot + 1;
        if (t + 1 < NT) { ATT_DMA(t + 1, nslot); asm volatile("s_waitcnt vmcnt(2) lgkmcnt(0)\n\ts_barrier" ::: "memory"); }
        else { asm volatile("s_waitcnt vmcnt(0) lgkmcnt(0)\n\ts_barrier" ::: "memory"); }
        bool rel = (t >= t_lo) && (t <= t_hi);
        if (TYPE == 0) { const int rb = U.row0 + 64 * t; rel = rel && (rb >= 0) && (rb < U.seqlen); }
        if (rel) {
            f32x16 p0, p1;
            qkt(p0, p1, kp0 + slot * SLOTB, qr);
            if (TYPE == 0) {
                const int dq = (U.tok0 + wid * 32 + r32) - (U.row0 + 64 * t + 4 * hi);
#pragma unroll
                for (int r = 0; r < 16; ++r) { const int cr = (r & 3) + 8 * (r >> 2); const int d0_ = dq - cr, d1_ = dq - cr - 32;
                    const int a0 = d0_ < 0 ? -d0_ : d0_, a1 = d1_ < 0 ? -d1_ : d1_;
                    p0[r] = (a0 <= 128) ? p0[r] - U.slope2 * (float)a0 : NEG_INF; p1[r] = (a1 <= 128) ? p1[r] - U.slope2 * (float)a1 : NEG_INF; }
            } else if (TYPE == 1) {
                const int rq = U.tok0 + (wid >> 1), c = 32 * (wid & 1) + r32; int cs = c - 8; cs = cs < 0 ? 0 : (cs > 48 ? 48 : cs);
                const int kr = (U.row0 >> 6) + t;
                const ATT_LAS float* tb = tab + TAB_PAD + (kr - rq + 7) * 31 + 15 - c + 4 * hi;
                const int kc = 4 * hi - cs;
#pragma unroll
                for (int r = 0; r < 16; ++r) { const int cr = (r & 3) + 8 * (r >> 2);
                    const float b0 = tb[cr], b1 = tb[cr + 32];
                    p0[r] = ((unsigned)(kc + cr) < 16u) ? p0[r] + b0 : NEG_INF; p1[r] = ((unsigned)(kc + cr + 32) < 16u) ? p1[r] + b1 : NEG_INF; }
            }
            const float rm = rowmax(p0, p1);
            const float mn = __builtin_fmaxf(m, rm);
            if (__any(mn > m)) {
                const float alpha = __builtin_amdgcn_exp2f(m - mn); l *= alpha;
                if (hi == 0) wsf[r32] = alpha;
                asm volatile("s_waitcnt lgkmcnt(0)" ::: "memory");
#pragma unroll
                for (int r = 0; r < 16; ++r) { const float f = wsf[crow(r, hi)]; o[0][r] *= f; o[1][r] *= f; }
                asm volatile("" ::: "memory");
            }
            m = mn;
            float sacc = 0.f;
#pragma unroll
            for (int r = 0; r < 16; ++r) { p0[r] = __builtin_amdgcn_exp2f(p0[r] - m); p1[r] = __builtin_amdgcn_exp2f(p1[r] - m); sacc += p0[r] + p1[r]; }
            l += sacc;
            u32x4 pw0, pw1, pw2, pw3;
            pw0 = (u32x4){cvtpk_s(p0[0], p0[1]), cvtpk_s(p0[2], p0[3]), cvtpk_s(p0[4], p0[5]), cvtpk_s(p0[6], p0[7])};
            pw1 = (u32x4){cvtpk_s(p0[8], p0[9]), cvtpk_s(p0[10], p0[11]), cvtpk_s(p0[12], p0[13]), cvtpk_s(p0[14], p0[15])};
            pw2 = (u32x4){cvtpk_s(p1[0], p1[1]), cvtpk_s(p1[2], p1[3]), cvtpk_s(p1[4], p1[5]), cvtpk_s(p1[6], p1[7])};
            pw3 = (u32x4){cvtpk_s(p1[8], p1[9]), cvtpk_s(p1[10], p1[11]), cvtpk_s(p1[12], p1[13]), cvtpk_s(p1[14], p1[15])};
            __builtin_amdgcn_sched_barrier(0);
            pv(o, vb0 + slot * SLOTB, __builtin_bit_cast(bf16x8, pw0), __builtin_bit_cast(bf16x8, pw1), __builtin_bit_cast(bf16x8, pw2), __builtin_bit_cast(bf16x8, pw3));
        }
        slot = nslot;
    }
    { auto rr = __builtin_amdgcn_permlane32_swap(__float_as_uint(l), __float_as_uint(l), false, false); l = __uint_as_float(rr[0]) + __uint_as_float(rr[1]); }
    asm volatile("" ::: "memory");
    if (hi == 0) wsf[32 + r32] = l;
    asm volatile("s_waitcnt lgkmcnt(0)" ::: "memory");
    float rli[16];
#pragma unroll
    for (int r = 0; r < 16; ++r) rli[r] = __builtin_amdgcn_rcpf(wsf[32 + crow(r, hi)]);
    { ATT_LAS bf16_t* stg = (ATT_LAS bf16_t*)(lds + LDS_OST) + wid * 2048;
#pragma unroll
      for (int r = 0; r < 16; ++r) { const int orow = crow(r, hi);
#pragma unroll
          for (int d0 = 0; d0 < 2; ++d0) { const unsigned pk = cvtpk_s(o[d0][r] * rli[r], 0.f); stg[orow * 64 + d0 * 32 + r32] = (bf16_t)(pk & 0xffffu); } }
      asm volatile("s_waitcnt lgkmcnt(0)" ::: "memory");
      bf16_t* Ow = U.O + (size_t)(wid * 32) * U.opitch;
#pragma unroll
      for (int i = 0; i < 4; ++i) { const int row = i * 8 + (lane >> 3), ch = lane & 7; const u32x4 v = *(const ATT_LAS u32x4*)(stg + row * 64 + ch * 8); *(u32x4*)(Ow + (size_t)row * U.opitch + ch * 8) = v; } }
    asm volatile("s_waitcnt vmcnt(0) lgkmcnt(0)\n\ts_barrier" ::: "memory");
#undef ATT_DMA
#undef ATT_CLAMP
}
}
constexpr int NWAVES = 8;
constexpr int SEQ = 16384, DM = 1024, DEPTH = 4, NQH = 12, NMH = 4, NMEM = 256, WIN_A = 1536, WIN_B = 2560, DFF = 2816, NGU = 2 * DFF;
constexpr float LOG2E = 1.4426950408889634f, C2 = 0.125f * LOG2E;
constexpr int N_PHASES = 2 + 5 * DEPTH;
#ifndef MK_PER_PHASE
#define MK_PER_PHASE 0
#endif
#ifndef MK_NAIVE
#define MK_NAIVE 0
#endif

constexpr size_t MiB = 1u << 20;
constexpr size_t WS_CTL = 0, CTL_ZERO_BYTES = 1 * MiB;
constexpr size_t WS_SSQA = 1 * MiB, WS_SSQB = 2 * MiB;
constexpr size_t WS_MEMN = 3 * MiB;
constexpr size_t WS_MKV = 4 * MiB;
constexpr size_t WS_WIN = 6 * MiB;
constexpr size_t WS_WOUT = WS_WIN + 16 * MiB, WS_WGU = WS_WOUT + 8 * MiB, WS_WDN = WS_WGU + 44 * MiB, WS_WMKV = WS_WDN + 22 * MiB;
constexpr size_t WS_XB = WS_WMKV + 4 * MiB;
constexpr size_t WS_PROJ = WS_XB + 32 * MiB;
constexpr size_t WS_Y = WS_PROJ + 80 * MiB;
constexpr size_t WS_H = WS_PROJ;
constexpr size_t WS_END = WS_Y + 32 * MiB;
static_assert(WS_END <= 256 * MiB, "d_ws map");
__host__ __device__ constexpr size_t win_off(int l) { return (size_t)((l >> 1) * 8 + (l & 1) * 3) * MiB; }
constexpr int CW_BAR = 4096;

constexpr int RING_OFF = 0, RING_BYTES = 131072, LDSCTL_OFF = RING_BYTES, MISC_OFF = LDSCTL_OFF + 320, LDS_BYTES = 147456;
static_assert(att::LDS_END <= RING_BYTES, "attention scratch inside the ring region");

#define GAS __attribute__((address_space(1)))
#define LAS __attribute__((address_space(3)))
typedef unsigned short bf16;
typedef unsigned v4u __attribute__((ext_vector_type(4)));
typedef float f32x4 __attribute__((ext_vector_type(4)));
typedef short bf16x8 __attribute__((ext_vector_type(8)));
typedef GAS unsigned gu32;
typedef GAS unsigned long long gu64;
#define RLX_AGENT __ATOMIC_RELAXED, __HIP_MEMORY_SCOPE_AGENT
#define LDS_WAIT() asm volatile("s_waitcnt lgkmcnt(0)" ::: "memory")
#define VM_WAIT() asm volatile("s_waitcnt vmcnt(0)" ::: "memory")
__device__ __forceinline__ unsigned long long rt() { return __builtin_amdgcn_s_memrealtime(); }
__device__ __forceinline__ unsigned f2bf(float f) { unsigned u = __builtin_bit_cast(unsigned, f); return (u + 0x7fffu + ((u >> 16) & 1u)) >> 16; }
__device__ __forceinline__ unsigned pk2(float lo, float hi) { return f2bf(lo) | (f2bf(hi) << 16); }

#define XB_TMO      128
#define XB_XCNT(j)  (256  + 64 * (j))
#define XB_XSUB(j)  (1280 + 64 * (j))
#define XB_XGEN(j)  (2304 + 64 * (j))
#define XB_TOP      3328
#define XB_TOPGEN   3392
#define XCD_BAR_WORDS 3456
#define XB_SPIN_CAP (1u << 18)

__device__ __forceinline__ unsigned xb_ld(unsigned* p)              { return __hip_atomic_load(p, __ATOMIC_RELAXED, __HIP_MEMORY_SCOPE_AGENT); }
__device__ __forceinline__ unsigned xb_add(unsigned* p, unsigned v) { return __hip_atomic_fetch_add(p, v, __ATOMIC_RELAXED, __HIP_MEMORY_SCOPE_AGENT); }
__device__ __forceinline__ unsigned xb_xcc_id() { return (unsigned)__builtin_amdgcn_s_getreg((3 << 11) | 20) & 0xFu; }
#define XB_SPIN(cond, bar) do { unsigned _sp = 0; while (cond) { __builtin_amdgcn_s_sleep(1); \
    if ((++_sp & 255u) == 0u) { if (xb_ld(&(bar)[XB_TMO])) break; if (_sp > XB_SPIN_CAP) { atomicAdd(&(bar)[XB_TMO], 1u); break; } } } } while (0)

struct XcdBarrier {
    unsigned* bar; unsigned x;
    volatile LAS unsigned* st;
};

__device__ __forceinline__ XcdBarrier xcd_barrier_post(unsigned* bar, volatile LAS unsigned* st) {
    XcdBarrier b; b.bar = bar; b.x = xb_xcc_id(); b.st = st;
    if (threadIdx.x == 0) (void)xb_add(&bar[XB_XCNT(b.x)], 1u);
    return b;
}
__device__ __forceinline__ void xcd_barrier_complete(unsigned* bar, unsigned x, unsigned& nloc, unsigned& nx) {
    const unsigned G = gridDim.x * gridDim.y * gridDim.z;
    unsigned sum, cnt, mine, sp = 0u;
    for (;;) {
        sum = 0u; cnt = 0u; mine = 0u;
#pragma unroll
        for (unsigned j = 0; j < 16; ++j) { const unsigned c = xb_ld(&bar[XB_XCNT(j)]); sum += c; cnt += (c > 0u) ? 1u : 0u; mine = (j == x) ? c : mine; }
        if (sum == G) break;
        __builtin_amdgcn_s_sleep(1);
        if ((++sp & 255u) == 0u) { if (xb_ld(&bar[XB_TMO])) break; if (sp > XB_SPIN_CAP) { atomicAdd(&bar[XB_TMO], 1u); break; } }
    }
    nloc = mine > 0u ? mine : 1u; nx = cnt > 0u ? cnt : 1u;
}

__device__ __forceinline__ void xcd_barrier(const XcdBarrier& b) {
    asm volatile("s_waitcnt vmcnt(0)" ::: "memory");
    __syncthreads();
    if (threadIdx.x == 0) {
        unsigned* bar = b.bar;
        __builtin_amdgcn_s_waitcnt(0);
        unsigned nloc = b.st[0], nx = b.st[1];
        if (nloc == 0u) { xcd_barrier_complete(bar, b.x, nloc, nx); b.st[0] = nloc; b.st[1] = nx; }
        const unsigned old = xb_add(&bar[XB_XSUB(b.x)], 1u);
        const unsigned gen = old / nloc;
        if (old + 1u == (gen + 1u) * nloc) {
            __builtin_amdgcn_fence(__ATOMIC_RELEASE, "agent");
            asm volatile("s_waitcnt vmcnt(0)" ::: "memory");
            const unsigned og = xb_add(&bar[XB_TOP], 1u);
            const unsigned tg = og / nx;
            if (og + 1u == (tg + 1u) * nx) xb_add(&bar[XB_TOPGEN], 1u);
            else XB_SPIN(xb_ld(&bar[XB_TOPGEN]) == tg, bar);
            __builtin_amdgcn_fence(__ATOMIC_ACQUIRE, "agent");
            xb_add(&bar[XB_XGEN(b.x)], 1u);
            asm volatile("s_waitcnt vmcnt(0)" ::: "memory");
        } else {
            XB_SPIN(xb_ld(&bar[XB_XGEN(b.x)]) == gen, bar);
            __builtin_amdgcn_fence(__ATOMIC_ACQUIRE, "agent");
            asm volatile("s_waitcnt vmcnt(0)" ::: "memory");
        }
    }
    __syncthreads();
}
struct Frame {
    LAS unsigned char* lds;
    volatile LAS unsigned* MISC;
    gu32* ctl;
    int tid, lane, wave;
    int vcu, G;
    const float *x, *mem, *norm_mix, *norm_ffn, *norm_mem, *norm_final, *w_in_a, *sink_a, *w_in_b, *rpb_b, *w_mem_kv, *w_out, *w_gate_up, *w_down;
    float* out; unsigned char* ws;
};
__device__ __forceinline__ float wave_sum(float v) {
#pragma unroll
    for (int o = 1; o < 64; o <<= 1) v += __shfl_xor(v, o);
    return v;
}
__device__ __forceinline__ void transpose_item(const float* W, int K, int N, bf16* WT, int mode, const float* g, LAS float* scr, int item, int lane) {
    const int nblk = N / 32, kb = item / nblk, nb = item % nblk, k0 = 64 * kb, n0 = 32 * nb;
#pragma unroll 8
    for (int i = 0; i < 32; ++i) { const int kk = 2 * i + (lane >> 5); const float gv = g ? g[k0 + kk] : 1.f; scr[kk * 33 + (lane & 31)] = W[(size_t)(k0 + kk) * N + n0 + (lane & 31)] * gv; }
    LDS_WAIT(); asm volatile("" ::: "memory");
    int rbase = n0;
    if (mode == 1) { rbase = (n0 < DFF) ? ((n0 / 128) * 256 + (n0 % 128)) : (((n0 - DFF) / 128) * 256 + 128 + ((n0 - DFF) % 128)); }
    const int c = lane & 7;
#pragma unroll
    for (int j = 0; j < 4; ++j) { const int n = (lane >> 3) + 8 * j; const LAS float* s = scr + (8 * c) * 33 + n;
        v4u o; o.x = pk2(s[0 * 33], s[1 * 33]); o.y = pk2(s[2 * 33], s[3 * 33]); o.z = pk2(s[4 * 33], s[5 * 33]); o.w = pk2(s[6 * 33], s[7 * 33]);
        *(GAS v4u*)(WT + (size_t)(rbase + n) * K + k0 + 8 * c) = o; }
    LDS_WAIT(); asm volatile("" ::: "memory");
}
__device__ __forceinline__ int items_in(int l) { return 16 * (((l & 1) ? WIN_B : WIN_A) / 32); }
constexpr int IT_OUT = 16 * 32, IT_GU = 16 * (NGU / 32), IT_DN = (DFF / 64) * 32, IT_MKV = 16 * 16;
__device__ __forceinline__ void p0_prologue(Frame& F) {
    LAS float* scr = (LAS float*)(F.lds + RING_OFF + F.wave * 16384);
    const int gw = F.vcu * NWAVES + F.wave, NGW = F.G * NWAVES;
    const int per_a = 16 * (WIN_A / 32) + IT_OUT + IT_GU + IT_DN + IT_MKV, per_b = 16 * (WIN_B / 32) + IT_OUT + IT_GU + IT_DN + IT_MKV;
    const int NITEMS = 2 * (per_a + per_b);
    for (int it = gw; it < NITEMS; it += NGW) {
        int r = it, l = 0;
        { const int pair = per_a + per_b; l = 2 * (r / pair); r = r % pair; if (r >= per_a) { r -= per_a; l += 1; } }
        const int nin = (l & 1) ? WIN_B : WIN_A, iin = 16 * (nin / 32);
        if (r < iin) { const float* W = (l & 1) ? F.w_in_b + (size_t)(l >> 1) * DM * WIN_B : F.w_in_a + (size_t)(l >> 1) * DM * WIN_A;
            transpose_item(W, DM, nin, (bf16*)(F.ws + WS_WIN + win_off(l)), 0, F.norm_mix + l * DM, scr, r, F.lane); continue; } r -= iin;
        if (r < IT_OUT) { transpose_item(F.w_out + (size_t)l * DM * DM, DM, DM, (bf16*)(F.ws + WS_WOUT + (size_t)l * 2 * MiB), 0, nullptr, scr, r, F.lane); continue; } r -= IT_OUT;
        if (r < IT_GU) { transpose_item(F.w_gate_up + (size_t)l * DM * NGU, DM, NGU, (bf16*)(F.ws + WS_WGU + (size_t)l * 11 * MiB), 1, F.norm_ffn + l * DM, scr, r, F.lane); continue; } r -= IT_GU;
        if (r < IT_DN) { transpose_item(F.w_down + (size_t)l * DFF * DM, DFF, DM, (bf16*)(F.ws + WS_WDN + (size_t)l * DFF * DM * 2), 0, nullptr, scr, r, F.lane); continue; } r -= IT_DN;
        transpose_item(F.w_mem_kv + (size_t)l * DM * 512, DM, 512, (bf16*)(F.ws + WS_WMKV + (size_t)l * MiB), 0, nullptr, scr, r, F.lane);
    }
    for (int m = gw; m < SEQ; m += NGW) {
        const GAS f32x4* xr = (const GAS f32x4*)(F.x + (size_t)m * DM) + F.lane; f32x4 v[4]; float s = 0.f;
#pragma unroll
        for (int j = 0; j < 4; ++j) { v[j] = xr[64 * j]; s += (v[j].x * v[j].x + v[j].y * v[j].y) + (v[j].z * v[j].z + v[j].w * v[j].w); }
        s = wave_sum(s);
        GAS unsigned long long* o8 = (GAS unsigned long long*)(F.ws + WS_XB + (size_t)m * DM * 2) + F.lane;
#pragma unroll
        for (int j = 0; j < 4; ++j) o8[64 * j] = (unsigned long long)pk2(v[j].x, v[j].y) | ((unsigned long long)pk2(v[j].z, v[j].w) << 32);
        if (F.lane < 16) ((GAS float*)(F.ws + WS_SSQA))[(size_t)m * 16 + F.lane] = (F.lane == 0) ? s : 0.f;
    }
    for (int m = gw; m < NMEM; m += NGW) {
        const GAS f32x4* xr = (const GAS f32x4*)(F.mem + (size_t)m * DM) + F.lane; const GAS f32x4* gr = (const GAS f32x4*)F.norm_mem + F.lane; f32x4 v[4]; float s = 0.f;
#pragma unroll
        for (int j = 0; j < 4; ++j) { v[j] = xr[64 * j]; s += (v[j].x * v[j].x + v[j].y * v[j].y) + (v[j].z * v[j].z + v[j].w * v[j].w); }
        const float rstd = 1.0f / sqrtf(wave_sum(s) * (1.0f / DM) + 1e-6f);
        GAS unsigned long long* o8 = (GAS unsigned long long*)(F.ws + WS_MEMN + (size_t)m * DM * 2) + F.lane;
#pragma unroll
        for (int j = 0; j < 4; ++j) { const f32x4 g = gr[64 * j]; const f32x4 y = v[j] * rstd * g; o8[64 * j] = (unsigned long long)pk2(y.x, y.y) | ((unsigned long long)pk2(y.z, y.w) << 32); }
    }
}
__device__ __forceinline__ void final_norm(Frame& F) {
    const int gw = F.vcu * NWAVES + F.wave, NGW = F.G * NWAVES;
    const GAS f32x4* gr = (const GAS f32x4*)F.norm_final + F.lane;
    for (int m = gw; m < SEQ; m += NGW) {
        GAS f32x4* xr = (GAS f32x4*)(F.out + (size_t)m * DM) + F.lane;
        const float rstd = pg8::row_rstd((const float*)(F.ws + WS_SSQA), m);
#pragma unroll
        for (int j = 0; j < 4; ++j) { const f32x4 v = xr[64 * j], g = gr[64 * j]; xr[64 * j] = v * rstd * g; }
    }
}
__device__ __forceinline__ void attn_phase(Frame& F, int l, int amask) {
    const bool isA = (l & 1) == 0; const int pitch = isA ? WIN_A : WIN_B;
    const att::bf16_t* P = (const att::bf16_t*)(F.ws + WS_PROJ); att::bf16_t* Y = (att::bf16_t*)(F.ws + WS_Y);
    const att::bf16_t* MKV = (const att::bf16_t*)(F.ws + WS_MKV) + l * 512;
    for (int u = F.vcu; u < 1024; u += F.G) {
        att::UnitP U; U.seqlen = SEQ; U.rpb = nullptr; U.slope2 = 0.f; U.m0 = -1e30f; U.l0 = 0.f;
        if (u < 768) {
            if (!(amask & 1)) continue;
            const int h = u % NQH, blk = u / NQH, tok0 = blk * 256;
            U.Q = P + (size_t)tok0 * pitch + h * 64; U.qpitch = pitch; U.O = Y + (size_t)tok0 * DM + h * 64; U.opitch = DM; U.kvpitch = pitch; U.kvmax = SEQ - 1;
            if (isA) {
                U.K = P + 768 + (h / 3) * 64; U.V = P + 1024 + (h / 3) * 64; U.row0 = tok0 - 128; U.ntiles = 8; U.tok0 = tok0;
                U.slope2 = exp2f(-8.0f * (float)(h + 1) / 12.0f) * LOG2E; U.m0 = F.sink_a[(l >> 1) * NQH + h] * LOG2E; U.l0 = 1.f;
                att::attn_unit<0>(U, F.lds + RING_OFF);
            } else {
                const int R0 = blk * 4; int T0 = R0 - 4; T0 = T0 < 0 ? 0 : (T0 > 248 ? 248 : T0); int T1 = R0 - 1; T1 = T1 < 0 ? 0 : (T1 > 248 ? 248 : T1); T1 += 7;
                U.K = P + 768 + h * 64; U.V = P + 1536 + h * 64; U.row0 = T0 * 64; U.ntiles = T1 - T0 + 1; U.tok0 = R0;
                U.rpb = F.rpb_b + ((size_t)(l >> 1) * NQH + h) * 15 * 31;
                att::attn_unit<1>(U, F.lds + RING_OFF);
            }
        } else {
            if (!(amask & 2)) continue;
            const int v = u - 768, hm = v % NMH, blk = v / NMH, tok0 = blk * 256;
            U.Q = P + (size_t)tok0 * pitch + (pitch - 256) + hm * 64; U.qpitch = pitch; U.O = Y + (size_t)tok0 * DM + 768 + hm * 64; U.opitch = DM;
            U.K = MKV + hm * 64; U.V = MKV + 256 + hm * 64; U.kvpitch = 2048; U.kvmax = NMEM - 1; U.row0 = 0; U.ntiles = 4; U.tok0 = tok0;
            att::attn_unit<2>(U, F.lds + RING_OFF);
        }
    }
}

struct Args { const float* in[14]; float* out; unsigned char* ws; int ph_lo, ph_hi, li, amask; };
__global__ void __launch_bounds__(NWAVES * 64, 2) skel_fwd(Args args) {
    extern __shared__ __attribute__((aligned(16))) unsigned char lds[];
    Frame F;
    F.lds = (LAS unsigned char*)lds;
    F.MISC = (volatile LAS unsigned*)(F.lds + MISC_OFF);
    F.tid = threadIdx.x; F.lane = F.tid & 63; F.wave = __builtin_amdgcn_readfirstlane(F.tid >> 6);
    F.G = gridDim.x; { const int bx = blockIdx.x; F.vcu = (F.G % 8 == 0) ? (bx % 8) * (F.G / 8) + bx / 8 : bx; }
    F.ws = args.ws; F.out = args.out; F.ctl = (gu32*)(args.ws + WS_CTL);
    F.x = args.in[0]; F.mem = args.in[1]; F.norm_mix = args.in[2]; F.norm_ffn = args.in[3]; F.norm_mem = args.in[4]; F.norm_final = args.in[5]; F.w_in_a = args.in[6]; F.sink_a = args.in[7];
    F.w_in_b = args.in[8]; F.rpb_b = args.in[9]; F.w_mem_kv = args.in[10]; F.w_out = args.in[11]; F.w_gate_up = args.in[12]; F.w_down = args.in[13];
    for (int u = F.tid; u < (LDS_BYTES - LDSCTL_OFF) / 4; u += NWAVES * 64) ((LAS unsigned*)(F.lds + LDSCTL_OFF))[u] = 0u;
    __syncthreads();
    XcdBarrier bar; bar.bar = (unsigned*)(F.ctl + CW_BAR) + args.li * XCD_BAR_WORDS; bar.x = 0; bar.st = nullptr;
    if (!MK_PER_PHASE) bar = xcd_barrier_post((unsigned*)(F.ctl + CW_BAR) + args.li * XCD_BAR_WORDS, F.MISC + 8);
    const int lo = args.ph_lo, hi = args.ph_hi;
#define IN(k) (lo <= (k) && (k) < hi)
#define SEAM(k) do { if (IN((k) + 1)) xcd_barrier(bar); } while (0)
    typedef pg8::bf16_t pb;
    if (IN(0)) { p0_prologue(F); SEAM(0); }
    for (int l = 0; l < DEPTH; ++l) {
        const int pb0 = 1 + 5 * l; const bool isA = (l & 1) == 0; const int nin = isA ? WIN_A : WIN_B;
        if (IN(pb0)) {
            { pg8::Gemm g{(const pb*)(F.ws + WS_XB), (const pb*)(F.ws + WS_WIN + win_off(l)), SEQ, nin, DM}; pg8::StaticOrder S; S.init(SEQ, nin, F.G, (int)blockIdx.x);
              pg8::EpiProj E{(pb*)(F.ws + WS_PROJ), nin, (const float*)(F.ws + WS_SSQA), 3, nin / 256 - 1, C2};
              pg8::gemm_phase<pg8::EpiProj, pg8::StaticOrder, true, true>(F.lds + RING_OFF, g, S, E); }
            if (l == 0) { pg8::Gemm g{(const pb*)(F.ws + WS_MEMN), (const pb*)(F.ws + WS_WMKV), NMEM, 2048, DM}; pg8::StaticOrder S; S.init(NMEM, 2048, F.G, (int)((blockIdx.x + F.G - 8) % F.G));
              pg8::EpiProj E{(pb*)(F.ws + WS_MKV), 2048, nullptr, 0, -1, 1.f};
              pg8::gemm_phase<pg8::EpiProj, pg8::StaticOrder, true, true>(F.lds + RING_OFF, g, S, E); }
            SEAM(pb0);
        }
        if (IN(pb0 + 1)) { attn_phase(F, l, args.amask); SEAM(pb0 + 1); }
        if (IN(pb0 + 2)) {
            pg8::Gemm g{(const pb*)(F.ws + WS_Y), (const pb*)(F.ws + WS_WOUT + (size_t)l * 2 * MiB), SEQ, DM, DM}; pg8::StaticOrder S; S.init(SEQ, DM, F.G, (int)blockIdx.x);
            pg8::EpiRes E{l == 0 ? F.x : (const float*)F.out, F.out, (pb*)(F.ws + WS_XB), (float*)(F.ws + WS_SSQB), DM};
            pg8::gemm_phase<pg8::EpiRes, pg8::StaticOrder, true, true>(F.lds + RING_OFF, g, S, E);
            SEAM(pb0 + 2);
        }
        if (IN(pb0 + 3)) {
            pg8::Gemm g{(const pb*)(F.ws + WS_XB), (const pb*)(F.ws + WS_WGU + (size_t)l * 11 * MiB), SEQ, NGU, DM}; pg8::StaticOrder S; S.init(SEQ, NGU, F.G, (int)blockIdx.x);
            pg8::EpiGU E{(pb*)(F.ws + WS_H), DFF, (const float*)(F.ws + WS_SSQB)};
            pg8::gemm_phase<pg8::EpiGU, pg8::StaticOrder, true, true>(F.lds + RING_OFF, g, S, E);
            SEAM(pb0 + 3);
        }
        if (IN(pb0 + 4)) {
            pg8::Gemm g{(const pb*)(F.ws + WS_H), (const pb*)(F.ws + WS_WDN + (size_t)l * DFF * DM * 2), SEQ, DM, DFF}; pg8::StaticOrder S; S.init(SEQ, DM, F.G, (int)blockIdx.x);
            pg8::EpiRes E{(const float*)F.out, F.out, (pb*)(F.ws + WS_XB), (float*)(F.ws + WS_SSQA), DM};
            pg8::gemm_phase<pg8::EpiRes, pg8::StaticOrder, true, true>(F.lds + RING_OFF, g, S, E);
            SEAM(pb0 + 4);
        }
    }
    if (IN(N_PHASES - 1)) final_norm(F);
#undef IN
#undef SEAM
}
#if MK_PER_PHASE && MK_NAIVE
namespace nv {
__device__ __forceinline__ float bf2f(unsigned short b) { return __uint_as_float((unsigned)b << 16); }
struct GArgs { const bf16* A; const bf16* Bt; int M, N, K, mode;
    bf16* O; int ldc; const float* ssq; int nq_tiles, qm_tile; float qscale;
    const float* base; float* out; bf16* xb; };
__global__ void __launch_bounds__(256) naive_gemm(GArgs a) {
    __shared__ float As[16][65], Bs[16][65], Bs2[16][65];
    const int tx = threadIdx.x & 15, ty = threadIdx.x >> 4, bx = blockIdx.x, by = blockIdx.y;
    float acc[4][4], acc2[4][4];
#pragma unroll
    for (int i = 0; i < 4; ++i)
#pragma unroll
        for (int j = 0; j < 4; ++j) { acc[i][j] = 0.f; acc2[i][j] = 0.f; }
    const int lr = threadIdx.x >> 2, lk = (threadIdx.x & 3) * 4;
    const int jc = bx * 64 + lr;
    const size_t brow = (a.mode == 2) ? (size_t)((jc / 128) * 256 + (jc % 128)) : (size_t)jc;
    for (int k0 = 0; k0 < a.K; k0 += 16) {
        const bf16* ap = a.A + (size_t)(by * 64 + lr) * a.K + k0 + lk; const bf16* bp = a.Bt + brow * a.K + k0 + lk;
#pragma unroll
        for (int i = 0; i < 4; ++i) { As[lk + i][lr] = bf2f(ap[i]); Bs[lk + i][lr] = bf2f(bp[i]); if (a.mode == 2) Bs2[lk + i][lr] = bf2f(bp[(size_t)128 * a.K + i]); }
        __syncthreads();
#pragma unroll
        for (int k = 0; k < 16; ++k) {
#pragma unroll
            for (int i = 0; i < 4; ++i)
#pragma unroll
                for (int j = 0; j < 4; ++j) { acc[i][j] += As[k][ty * 4 + i] * Bs[k][tx * 4 + j]; if (a.mode == 2) acc2[i][j] += As[k][ty * 4 + i] * Bs2[k][tx * 4 + j]; }
        }
        __syncthreads();
    }
#pragma unroll
    for (int i = 0; i < 4; ++i)
#pragma unroll
        for (int j = 0; j < 4; ++j) {
            const int row = by * 64 + ty * 4 + i, col = bx * 64 + tx * 4 + j;
            if (a.mode == 0) { float rs = 1.f; if (a.ssq) { float s = 0.f; for (int q = 0; q < 16; ++q) s += a.ssq[(size_t)row * 16 + q]; rs = 1.0f / sqrtf(s * (1.0f / 1024.0f) + 1e-6f); }
                const int pn = col / 256; const float sc = (pn < a.nq_tiles || pn == a.qm_tile) ? a.qscale : 1.f;
                a.O[(size_t)row * a.ldc + col] = (bf16)f2bf(acc[i][j] * rs * sc); }
            else if (a.mode == 1) { const size_t o = (size_t)row * a.ldc + col; const float v = a.base[o] + acc[i][j]; a.out[o] = v; a.xb[o] = (bf16)f2bf(v); }
            else { float s = 0.f; for (int q = 0; q < 16; ++q) s += a.ssq[(size_t)row * 16 + q]; const float rs = 1.0f / sqrtf(s * (1.0f / 1024.0f) + 1e-6f);
                const float g = acc[i][j] * rs, u = acc2[i][j] * rs; a.O[(size_t)row * a.ldc + col] = (bf16)f2bf(g / (1.0f + expf(-g)) * u); }
        }
}
__global__ void __launch_bounds__(256) naive_ssq(const float* x, float* ssq) {
    const int row = blockIdx.x * 256 + threadIdx.x; float s = 0.f;
    for (int c = 0; c < DM; ++c) { const float v = x[(size_t)row * DM + c]; s += v * v; }
    for (int q = 0; q < 16; ++q) ssq[(size_t)row * 16 + q] = (q == 0) ? s : 0.f;
}
__device__ __forceinline__ void ld64(const bf16* p, float (&v)[64]) {
#pragma unroll
    for (int c = 0; c < 8; ++c) { const uint4 w = *(const uint4*)(p + 8 * c); const unsigned ww[4] = {w.x, w.y, w.z, w.w};
#pragma unroll
        for (int e = 0; e < 4; ++e) { v[8 * c + 2 * e] = __uint_as_float(ww[e] << 16); v[8 * c + 2 * e + 1] = __uint_as_float(ww[e] & 0xffff0000u); } }
}
__global__ void __launch_bounds__(256) naive_attn(int type, const bf16* P, int pitch, const bf16* MKV, const float* sink, const float* rpb, bf16* Y) {
    const int idx = blockIdx.x * 256 + threadIdx.x; const int nh = (type == 2) ? NMH : NQH; const int h = idx % nh, t = idx / nh;
    float q[64], o[64], kv[64];
    ld64(P + (size_t)t * pitch + (type == 2 ? (pitch - 256) : 0) + h * 64, q);
#pragma unroll
    for (int d = 0; d < 64; ++d) o[d] = 0.f;
    float m = -1e30f, l = 0.f;
    int nkeys; if (type == 0) { m = sink[h] * LOG2E; l = 1.f; nkeys = 257; } else if (type == 1) nkeys = 128; else nkeys = 256;
    const float slope2 = exp2f(-8.0f * (float)(h + 1) / 12.0f) * LOG2E;
    const int r = t / 64, c = t % 64; int rs = r - 4; rs = rs < 0 ? 0 : (rs > 248 ? 248 : rs); int cs = c - 8; cs = cs < 0 ? 0 : (cs > 48 ? 48 : cs);
    for (int i = 0; i < nkeys; ++i) {
        const bf16 *kp, *vp; float bias = 0.f;
        if (type == 0) { const int s = t - 128 + i; if (s < 0 || s >= SEQ) continue; kp = P + (size_t)s * pitch + 768 + (h / 3) * 64; vp = P + (size_t)s * pitch + 1024 + (h / 3) * 64; bias = -slope2 * fabsf((float)(t - s)); }
        else if (type == 1) { const int kr = rs + (i >> 4), kc = cs + (i & 15); const int s = kr * 64 + kc; kp = P + (size_t)s * pitch + 768 + h * 64; vp = P + (size_t)s * pitch + 1536 + h * 64;
            bias = rpb[(size_t)h * 15 * 31 + (kr - r + 7) * 31 + (kc - c + 15)] * LOG2E; }
        else { kp = MKV + (size_t)i * 2048 + h * 64; vp = MKV + (size_t)i * 2048 + 256 + h * 64; }
        ld64(kp, kv); float dot = 0.f;
#pragma unroll
        for (int d = 0; d < 64; ++d) dot += q[d] * kv[d];
        const float sc = dot + bias, mn = fmaxf(m, sc), al = exp2f(m - mn), p = exp2f(sc - mn);
        ld64(vp, kv); l = l * al + p;
#pragma unroll
        for (int d = 0; d < 64; ++d) o[d] = o[d] * al + p * kv[d];
        m = mn;
    }
    const float il = 1.0f / l; bf16* yp = Y + (size_t)t * DM + (type == 2 ? 768 : 0) + h * 64;
#pragma unroll
    for (int d = 0; d < 64; ++d) yp[d] = (bf16)f2bf(o[d] * il);
}
}
#endif
extern "C" void kernel_launch(void* const* d_in, const int* in_sizes, int n_in, void* d_out, int out_size, void* d_ws, size_t ws_size, hipStream_t stream) {
    static int grid = 0;
    if (grid == 0) {
        if (n_in != 14 || in_sizes[0] != SEQ * DM || out_size != SEQ * DM || ws_size < WS_END) { fprintf(stderr, "kernel_launch: unexpected shapes (n_in %d, in0 %d, out %d, ws %zu); nothing launched\n", n_in, n_in > 0 ? in_sizes[0] : -1, out_size, ws_size); grid = -1; return; }
        int dev = 0, cus = 0, per_cu = 0;
        if (hipGetDevice(&dev) != hipSuccess || hipDeviceGetAttribute(&cus, hipDeviceAttributeMultiprocessorCount, dev) != hipSuccess) { grid = -1; return; }
        if (hipFuncSetAttribute((const void*)skel_fwd, hipFuncAttributeMaxDynamicSharedMemorySize, LDS_BYTES) != hipSuccess) { fprintf(stderr, "kernel_launch: hipFuncSetAttribute failed\n"); grid = -1; return; }
        if (hipOccupancyMaxActiveBlocksPerMultiprocessor(&per_cu, (const void*)skel_fwd, NWAVES * 64, LDS_BYTES) != hipSuccess || per_cu < 1)
            fprintf(stderr, "kernel_launch: note: occupancy query reports %d workgroups per CU\n", per_cu);
        (void)hipGetLastError();
        grid = cus;
    }
    if (grid < 0) return;
    if (hipMemsetAsync((char*)d_ws + WS_CTL, 0, CTL_ZERO_BYTES, stream) != hipSuccess) return;
    Args a{};
    for (int i = 0; i < 14; ++i) a.in[i] = (const float*)d_in[i];
    a.out = (float*)d_out; a.ws = (unsigned char*)d_ws; a.amask = 3;
#if MK_PER_PHASE
    unsigned char* ws = (unsigned char*)d_ws; const float* const* in = (const float* const*)d_in;
    for (int p = 0; p < N_PHASES; ++p) {
        const int l = (p - 1) / 5, k = (p - 1) % 5; const bool mid = (p > 0 && p < N_PHASES - 1);
        (void)l; (void)k; (void)ws; (void)in;
#if MK_NAIVE
        if (mid && (MK_NAIVE & 1) && k != 1) {
            const int nin = (l & 1) ? WIN_B : WIN_A;
            nv::GArgs g{};
            if (k == 0) { g.A = (const bf16*)(ws + WS_XB); g.Bt = (const bf16*)(ws + WS_WIN + win_off(l)); g.M = SEQ; g.N = nin; g.K = DM; g.mode = 0; g.O = (bf16*)(ws + WS_PROJ); g.ldc = nin; g.ssq = (const float*)(ws + WS_SSQA);
                g.nq_tiles = 3; g.qm_tile = nin / 256 - 1; g.qscale = C2;
                hipLaunchKernelGGL(nv::naive_gemm, dim3(g.N / 64, g.M / 64), dim3(256), 0, stream, g);
                if (l == 0) { nv::GArgs m{}; m.A = (const bf16*)(ws + WS_MEMN); m.Bt = (const bf16*)(ws + WS_WMKV); m.M = NMEM; m.N = 2048; m.K = DM; m.mode = 0; m.O = (bf16*)(ws + WS_MKV); m.ldc = 2048; m.ssq = nullptr; m.nq_tiles = 0; m.qm_tile = -1; m.qscale = 1.f;
                    hipLaunchKernelGGL(nv::naive_gemm, dim3(m.N / 64, m.M / 64), dim3(256), 0, stream, m); } }
            else if (k == 2) { g.A = (const bf16*)(ws + WS_Y); g.Bt = (const bf16*)(ws + WS_WOUT + (size_t)l * 2 * MiB); g.M = SEQ; g.N = DM; g.K = DM; g.mode = 1; g.ldc = DM; g.base = (l == 0) ? in[0] : (const float*)d_out; g.out = (float*)d_out; g.xb = (bf16*)(ws + WS_XB);
                hipLaunchKernelGGL(nv::naive_gemm, dim3(g.N / 64, g.M / 64), dim3(256), 0, stream, g);
                hipLaunchKernelGGL(nv::naive_ssq, dim3(SEQ / 256), dim3(256), 0, stream, (const float*)d_out, (float*)(ws + WS_SSQB)); }
            else if (k == 3) { g.A = (const bf16*)(ws + WS_XB); g.Bt = (const bf16*)(ws + WS_WGU + (size_t)l * 11 * MiB); g.M = SEQ; g.N = DFF; g.K = DM; g.mode = 2; g.O = (bf16*)(ws + WS_H); g.ldc = DFF; g.ssq = (const float*)(ws + WS_SSQB);
                hipLaunchKernelGGL(nv::naive_gemm, dim3(g.N / 64, g.M / 64), dim3(256), 0, stream, g); }
            else { g.A = (const bf16*)(ws + WS_H); g.Bt = (const bf16*)(ws + WS_WDN + (size_t)l * DFF * DM * 2); g.M = SEQ; g.N = DM; g.K = DFF; g.mode = 1; g.ldc = DM; g.base = (const float*)d_out; g.out = (float*)d_out; g.xb = (bf16*)(ws + WS_XB);
                hipLaunchKernelGGL(nv::naive_gemm, dim3(g.N / 64, g.M / 64), dim3(256), 0, stream, g);
                hipLaunchKernelGGL(nv::naive_ssq, dim3(SEQ / 256), dim3(256), 0, stream, (const float*)d_out, (float*)(ws + WS_SSQA)); }
            continue;
        }
        a.amask = 3;
        if (mid && k == 1) {
            const int pitch = (l & 1) ? WIN_B : WIN_A; const bf16* P = (const bf16*)(ws + WS_PROJ); const bf16* MKV = (const bf16*)(ws + WS_MKV) + l * 512; bf16* Y = (bf16*)(ws + WS_Y);
            if (MK_NAIVE & ((l & 1) ? 4 : 2)) { a.amask &= ~1;
                hipLaunchKernelGGL(nv::naive_attn, dim3(SEQ * NQH / 256), dim3(256), 0, stream, (l & 1), P, pitch, MKV, in[7] + (l >> 1) * NQH, in[9] + (size_t)(l >> 1) * NQH * 15 * 31, Y); }
            if (MK_NAIVE & 8) { a.amask &= ~2;
                hipLaunchKernelGGL(nv::naive_attn, dim3(SEQ * NMH / 256), dim3(256), 0, stream, 2, P, pitch, MKV, in[7], in[9], Y); }
            if (a.amask == 0) continue;
        }
#endif
        a.ph_lo = p; a.ph_hi = p + 1; a.li = p;
        hipLaunchKernelGGL(skel_fwd, dim3(grid), dim3(NWAVES * 64), LDS_BYTES, stream, a);
    }
#else
    a.ph_lo = 0; a.ph_hi = N_PHASES; a.li = 0;
    hipLaunchKernelGGL(skel_fwd, dim3(grid), dim3(NWAVES * 64), LDS_BYTES, stream, a);
#endif
    const hipError_t le = hipPeekAtLastError();
    if (le != hipSuccess) fprintf(stderr, "kernel_launch: launch failed: %s\n", hipGetErrorName(le));
}
```

```cpp
#define MK_PER_PHASE 0
#define MK_NAIVE 0
#include <hip/hip_runtime.h>
#include <cstdio>
#include <cstdint>
namespace pg8 {
#define PG8_LAS __attribute__((address_space(3)))
typedef unsigned short bf16_t;
typedef short bf16x8 __attribute__((ext_vector_type(8)));
typedef float f32x4 __attribute__((ext_vector_type(4)));
typedef unsigned u32x4 __attribute__((ext_vector_type(4)));
constexpr int BM = 256, BK = 64, HALF = 128, HTB = HALF * BK * 2  , STAGE_BYTES = 8 * HTB, NXCD = 8, WGM = 8;

__host__ __device__ __forceinline__ int lds_byte(int r, int c) { const int st = (r >> 4) * 2 + (c >> 5), rr = r & 15, cc = c & 31, ob = rr * 64 + cc * 2; return st * 1024 + (ob ^ (((ob >> 9) & 1) << 5)); }
__host__ __device__ __forceinline__ void stage_rc(int b, int& R, int& C) { const int st = b / 1024, sb = b % 1024, swz = sb ^ (((sb >> 9) & 1) << 5); R = (st >> 1) * 16 + swz / 64; C = (st & 1) * 32 + (swz % 64) / 2; }
__host__ __device__ __forceinline__ int perm32(int rho) { const int n = rho >> 4, i = rho & 15; return 8 * (i >> 2) + 4 * n + (i & 3); }

struct Unit { int pm, pn; };
struct Gemm { const bf16_t* A; const bf16_t* Bt; int M, N, K; };

struct StaticOrder {
    int nM, nN, nwg, G, c;
    __host__ __device__ void init(int M, int N, int G_, int c_) { nM = M / BM; nN = N / BM; nwg = nM * nN; G = G_; c = c_; }
    __host__ __device__ bool next(int i, Unit& u) const {
        const long L = (long)i * G + c; if (L >= nwg) return false;
        int wgid = (int)L; { const int q = nwg / NXCD, r = nwg % NXCD, xcd = wgid % NXCD, off = wgid / NXCD; wgid = (xcd < r ? xcd * (q + 1) : r * (q + 1) + (xcd - r) * q) + off; }
        const int nig = WGM * nN, gid = wgid / nig, fm = gid * WGM, gsz = (nM - fm) < WGM ? (nM - fm) : WGM;
        u.pm = fm + ((wgid % nig) % gsz); u.pn = (wgid % nig) / gsz; return true;
    }
    __device__ __forceinline__ void a_ready(const Unit&) const {}
    __device__ __forceinline__ void done(const Unit&) const {}
};

__device__ __forceinline__ unsigned cvt_pk_bf16(float lo, float hi) { unsigned r; asm volatile("v_cvt_pk_bf16_f32 %0, %1, %2" : "=v"(r) : "v"(lo), "v"(hi)); return r; }
typedef float f32x2 __attribute__((ext_vector_type(2)));
__device__ __forceinline__ float row_rstd(const float* ssq, int row) {
    const f32x4* p = (const f32x4*)(ssq + (size_t)row * 16);
    const f32x4 a = p[0], b = p[1], c = p[2], d = p[3];
    const float s = (((a[0] + a[1]) + (a[2] + a[3])) + ((b[0] + b[1]) + (b[2] + b[3]))) + (((c[0] + c[1]) + (c[2] + c[3])) + ((d[0] + d[1]) + (d[2] + d[3])));
    return __builtin_amdgcn_rsqf(s * (1.0f / 1024.0f) + 1e-6f);
}
struct EpiProj {
    static constexpr bool PERM = true, AFTER_DRAIN = false;
    bf16_t* O; int ldc; const float* ssq; int nq_tiles, qm_tile; float qscale;
    __device__ __forceinline__ void operator()(const f32x4 (&acc)[2][2][4][2], const Unit& u, int wr, int wc, int fr, int fq) const {
        const int row0 = u.pm * BM + wr * 64 + fr;
        const float sc = (u.pn < nq_tiles || u.pn == qm_tile) ? qscale : 1.f;
        const int col0 = u.pn * BM + wc * 32 + 8 * fq;
#pragma unroll
        for (int ai = 0; ai < 2; ++ai)
#pragma unroll
            for (int m = 0; m < 4; ++m) { const int row = row0 + ai * HALF + m * 16; const float rs = ssq ? row_rstd(ssq, row) * sc : sc;
                bf16_t* rowp = O + (size_t)row * ldc + col0;
#pragma unroll
                for (int bj = 0; bj < 2; ++bj) { const f32x4 v0 = acc[ai][bj][m][0] * rs, v1 = acc[ai][bj][m][1] * rs;
                    u32x4 w; w.x = cvt_pk_bf16(v0[0], v0[1]); w.y = cvt_pk_bf16(v0[2], v0[3]); w.z = cvt_pk_bf16(v1[0], v1[1]); w.w = cvt_pk_bf16(v1[2], v1[3]);
                    *(u32x4*)(rowp + bj * HALF) = w; } }
    }
};
struct EpiRes {
    static constexpr bool PERM = true, AFTER_DRAIN = false;
    const float* base; float* out; bf16_t* xb; float* ssq_out; int ldc;
    __device__ __forceinline__ void operator()(const f32x4 (&acc)[2][2][4][2], const Unit& u, int wr, int wc, int fr, int fq) const {
        const int row0 = u.pm * BM + wr * 64 + fr;
        const int col0 = u.pn * BM + wc * 32 + 8 * fq;
#pragma unroll
        for (int ai = 0; ai < 2; ++ai)
#pragma unroll
            for (int m = 0; m < 4; ++m) { const int row = row0 + ai * HALF + m * 16; const size_t off = (size_t)row * ldc + col0; float ss = 0.f;
#pragma unroll
                for (int bj = 0; bj < 2; ++bj) { const f32x4 b0 = *(const f32x4*)(base + off + bj * HALF), b1 = *(const f32x4*)(base + off + bj * HALF + 4);
                    const f32x4 v0 = b0 + acc[ai][bj][m][0], v1 = b1 + acc[ai][bj][m][1];
                    *(f32x4*)(out + off + bj * HALF) = v0; *(f32x4*)(out + off + bj * HALF + 4) = v1;
                    u32x4 w; w.x = cvt_pk_bf16(v0[0], v0[1]); w.y = cvt_pk_bf16(v0[2], v0[3]); w.z = cvt_pk_bf16(v1[0], v1[1]); w.w = cvt_pk_bf16(v1[2], v1[3]);
                    *(u32x4*)(xb + off + bj * HALF) = w;
                    ss += ((v0[0] * v0[0] + v0[1] * v0[1]) + (v0[2] * v0[2] + v0[3] * v0[3])) + ((v1[0] * v1[0] + v1[1] * v1[1]) + (v1[2] * v1[2] + v1[3] * v1[3])); }
                ss += __shfl_xor(ss, 16); ss += __shfl_xor(ss, 32);
                if (fq == 0) ssq_out[(size_t)row * 16 + u.pn * 4 + wc] = ss; }
    }
};
struct EpiGU {
    static constexpr bool PERM = true, AFTER_DRAIN = false;
    bf16_t* H; int ldh; const float* ssq;
    static __device__ __forceinline__ float swi(float g, float u) { return g * u * __builtin_amdgcn_rcpf(1.0f + __builtin_amdgcn_exp2f(-1.4426950408889634f * g)); }
    __device__ __forceinline__ void operator()(const f32x4 (&acc)[2][2][4][2], const Unit& u, int wr, int wc, int fr, int fq) const {
        const int row0 = u.pm * BM + wr * 64 + fr;
        const int col0 = u.pn * HALF + wc * 32 + 8 * fq;
#pragma unroll
        for (int ai = 0; ai < 2; ++ai)
#pragma unroll
            for (int m = 0; m < 4; ++m) { const int row = row0 + ai * HALF + m * 16; const float rs = row_rstd(ssq, row);
                const f32x4 g0 = acc[ai][0][m][0] * rs, g1 = acc[ai][0][m][1] * rs, u0 = acc[ai][1][m][0] * rs, u1 = acc[ai][1][m][1] * rs;
                u32x4 w; w.x = cvt_pk_bf16(swi(g0[0], u0[0]), swi(g0[1], u0[1])); w.y = cvt_pk_bf16(swi(g0[2], u0[2]), swi(g0[3], u0[3]));
                w.z = cvt_pk_bf16(swi(g1[0], u1[0]), swi(g1[1], u1[1])); w.w = cvt_pk_bf16(swi(g1[2], u1[2]), swi(g1[3], u1[3]));
                *(u32x4*)(H + (size_t)row * ldh + col0) = w; }
    }
};
template <class Epi, class Sched, bool ALIGN_EPI = false, bool SP2 = false>
__device__ __forceinline__ void gemm_phase(PG8_LAS unsigned char* lds, const Gemm g, const Sched& S, const Epi& E) {
    int tid_ = threadIdx.x; asm volatile("" : "+v"(tid_));
    const int tid = tid_, wid = __builtin_amdgcn_readfirstlane(tid >> 6), lane = tid & 63, wr = wid >> 2, wc = wid & 3, fr = lane & 15, fq = lane >> 4;
    const int K = g.K, nt = K / BK;
    unsigned voffA[2], voffB[2];
#pragma unroll
    for (int i = 0; i < 2; ++i) { int R, C; stage_rc(tid * 16 + i * 8192, R, C); const int Rb = Epi::PERM ? ((R & ~31) + perm32(R & 31)) : R;
        voffA[i] = (unsigned)(R * K + C) * 2u; voffB[i] = (unsigned)(Rb * K + C) * 2u; }
    const size_t kstep = (size_t)(BK * 2);
    const size_t hstep = (size_t)HALF * K * 2;
    const size_t tstep = 2 * hstep;
    const unsigned ldsw = (unsigned)wid * 1024u;
    const int aoff = lds_byte(wr * 64 + fr, fq * 8), boff = lds_byte(wc * 32 + fr, fq * 8);
#define PG8_SA(b, h) (((b) * 2 + (h)) * HTB)
#define PG8_SB(b, h) ((4 + (b) * 2 + (h)) * HTB)
#define PG8_STAGE(bufoff, gbase, voff) do { _Pragma("unroll") for (int _i = 0; _i < 2; ++_i) \
        __builtin_amdgcn_global_load_lds((const unsigned*)((const char*)(gbase) + (voff)[_i]), (PG8_LAS unsigned*)(lds + (bufoff) + ldsw + _i * 8192), 16, 0, 0); } while (0)
#define PG8_LDA(dst, b, h) do { _Pragma("unroll") for (int m = 0; m < 4; ++m) _Pragma("unroll") for (int k = 0; k < 2; ++k) dst[m][k] = *(const PG8_LAS bf16x8*)(lds + PG8_SA(b, h) + aoff + m * 2048 + k * 1024); } while (0)
#define PG8_LDB(dst, b, h) do { _Pragma("unroll") for (int n = 0; n < 2; ++n) _Pragma("unroll") for (int k = 0; k < 2; ++k) dst[n][k] = *(const PG8_LAS bf16x8*)(lds + PG8_SB(b, h) + boff + n * 2048 + k * 1024); } while (0)
#define PG8_MMA(ai, bj, At, Bt) do { __builtin_amdgcn_s_setprio(1); _Pragma("unroll") for (int m = 0; m < 4; ++m) _Pragma("unroll") for (int n = 0; n < 2; ++n) _Pragma("unroll") for (int k = 0; k < 2; ++k) \
        acc[ai][bj][m][n] = __builtin_amdgcn_mfma_f32_16x16x32_bf16(Bt[n][k], At[m][k], acc[ai][bj][m][n], 0, 0, 0); __builtin_amdgcn_s_setprio(0); } while (0)
#define PG8_WAIT_V(n) asm volatile("s_waitcnt vmcnt(" #n ")" ::: "memory")
#define PG8_WAIT_L(n) asm volatile("s_waitcnt lgkmcnt(" #n ")" ::: "memory")
#define PG8_BAR __builtin_amdgcn_s_barrier()
#define PG8_SCHED __builtin_amdgcn_sched_barrier(0)
    Unit cur, nxt; int ui = 0;
    if (!S.next(0, cur)) return;
    f32x4 acc[2][2][4][2];
#pragma unroll
    for (int a = 0; a < 2; ++a)
#pragma unroll
        for (int b = 0; b < 2; ++b)
#pragma unroll
            for (int m = 0; m < 4; ++m)
#pragma unroll
                for (int n = 0; n < 2; ++n) acc[a][b][m][n] = (f32x4){0.f, 0.f, 0.f, 0.f};
    bf16x8 At[4][2], B0[2][2], B1[2][2];
    const char* cA = (const char*)g.A + (size_t)cur.pm * tstep; const char* cB = (const char*)g.Bt + (size_t)cur.pn * tstep;
    S.a_ready(cur);
    if constexpr (SP2) {
        PG8_STAGE(PG8_SB(0, 0), cB, voffB); PG8_STAGE(PG8_SB(0, 1), cB + hstep, voffB); PG8_STAGE(PG8_SA(0, 0), cA, voffA); PG8_STAGE(PG8_SA(0, 1), cA + hstep, voffA);
        if (wr == 1) PG8_BAR;
        PG8_WAIT_V(2); PG8_BAR;
        PG8_STAGE(PG8_SB(1, 0), cB + kstep, voffB); PG8_STAGE(PG8_SA(1, 0), cA + kstep, voffA); PG8_STAGE(PG8_SB(1, 1), cB + hstep + kstep, voffB);
        PG8_WAIT_V(6); PG8_BAR;
    } else {
        PG8_STAGE(PG8_SB(0, 0), cB, voffB); PG8_STAGE(PG8_SA(0, 0), cA, voffA); PG8_STAGE(PG8_SB(0, 1), cB + hstep, voffB); PG8_STAGE(PG8_SA(0, 1), cA + hstep, voffA);
        if (wr == 1) PG8_BAR;
        PG8_WAIT_V(4); PG8_BAR;
        PG8_STAGE(PG8_SB(1, 0), cB + kstep, voffB); PG8_STAGE(PG8_SA(1, 0), cA + kstep, voffA); PG8_STAGE(PG8_SB(1, 1), cB + hstep + kstep, voffB);
        PG8_WAIT_V(6); PG8_BAR;
    }
    for (;;) {
        const bool has_next = S.next(ui + 1, nxt);
        const char* nA = has_next ? (const char*)g.A + (size_t)nxt.pm * tstep : cA; const char* nB = has_next ? (const char*)g.Bt + (size_t)nxt.pn * tstep : cB;
        for (int t = 0; t < nt; t += 2) {
            const bool last = (t == nt - 2);
            const char* a1 = cA + (size_t)(t + 1) * kstep;
            const char* a2 = last ? nA : cA + (size_t)(t + 2) * kstep; const char* b2 = last ? nB : cB + (size_t)(t + 2) * kstep;
            const char* a3 = a2 + kstep; const char* b3 = b2 + kstep;
            if (last && has_next) S.a_ready(nxt);
            if constexpr (SP2) {
            PG8_LDB(B0, 0, 0); PG8_LDB(B1, 0, 1); PG8_SCHED; PG8_LDA(At, 0, 0); PG8_STAGE(PG8_SA(1, 1), a1 + hstep, voffA);
            PG8_WAIT_V(8); PG8_WAIT_L(0); PG8_BAR; PG8_MMA(0, 0, At, B0); PG8_MMA(0, 1, At, B1); PG8_BAR; PG8_SCHED;
            PG8_LDA(At, 0, 1); PG8_STAGE(PG8_SB(0, 0), b2, voffB); PG8_STAGE(PG8_SB(0, 1), b2 + hstep, voffB); PG8_STAGE(PG8_SA(0, 0), a2, voffA);
            PG8_WAIT_V(8); PG8_WAIT_L(0); PG8_BAR; PG8_MMA(1, 0, At, B0); PG8_MMA(1, 1, At, B1); PG8_BAR; PG8_SCHED;
            PG8_LDB(B0, 1, 0); PG8_LDB(B1, 1, 1); PG8_SCHED; PG8_LDA(At, 1, 0); PG8_STAGE(PG8_SA(0, 1), a2 + hstep, voffA);
            PG8_WAIT_V(8); PG8_WAIT_L(0); PG8_BAR; PG8_MMA(0, 0, At, B0); PG8_MMA(0, 1, At, B1); PG8_BAR; PG8_SCHED;
            PG8_LDA(At, 1, 1); PG8_STAGE(PG8_SB(1, 0), b3, voffB); PG8_STAGE(PG8_SB(1, 1), b3 + hstep, voffB); PG8_STAGE(PG8_SA(1, 0), a3, voffA);
            PG8_WAIT_V(8); PG8_WAIT_L(0); PG8_BAR; PG8_MMA(1, 0, At, B0); PG8_MMA(1, 1, At, B1); PG8_BAR; PG8_SCHED;
            } else {
            PG8_LDB(B0, 0, 0); PG8_SCHED; PG8_LDA(At, 0, 0); PG8_STAGE(PG8_SA(1, 1), a1 + hstep, voffA);
            PG8_WAIT_L(8); PG8_BAR; PG8_WAIT_L(0); PG8_MMA(0, 0, At, B0); PG8_BAR; PG8_SCHED;
            PG8_LDB(B1, 0, 1); PG8_STAGE(PG8_SB(0, 0), b2, voffB);
            PG8_BAR; PG8_WAIT_L(0); PG8_MMA(0, 1, At, B1); PG8_BAR;
            PG8_LDA(At, 0, 1); PG8_STAGE(PG8_SA(0, 0), a2, voffA);
            PG8_BAR; PG8_WAIT_L(0); PG8_MMA(1, 0, At, B0); PG8_BAR; PG8_SCHED;
            PG8_STAGE(PG8_SB(0, 1), b2 + hstep, voffB);
            PG8_WAIT_V(6); PG8_BAR; PG8_MMA(1, 1, At, B1); PG8_BAR;
            PG8_LDB(B0, 1, 0); PG8_SCHED; PG8_LDA(At, 1, 0); PG8_STAGE(PG8_SA(0, 1), a2 + hstep, voffA);
            PG8_WAIT_L(8); PG8_BAR; PG8_WAIT_L(0); PG8_MMA(0, 0, At, B0); PG8_BAR; PG8_SCHED;
            PG8_LDB(B1, 1, 1); PG8_STAGE(PG8_SB(1, 0), b3, voffB);
            PG8_BAR; PG8_WAIT_L(0); PG8_MMA(0, 1, At, B1); PG8_BAR;
            PG8_LDA(At, 1, 1); PG8_STAGE(PG8_SA(1, 0), a3, voffA);
            PG8_BAR; PG8_WAIT_L(0); PG8_MMA(1, 0, At, B0); PG8_BAR; PG8_SCHED;
            PG8_STAGE(PG8_SB(1, 1), b3 + hstep, voffB);
            PG8_WAIT_V(6); PG8_BAR; PG8_MMA(1, 1, At, B1); PG8_BAR;
            }
        }
        if constexpr (ALIGN_EPI) { if (wr == 0) PG8_BAR; }
        if constexpr (!Epi::AFTER_DRAIN) { E(acc, cur, wr, wc, fr, fq); S.done(cur); }
        if (!has_next) break;
#pragma unroll
        for (int a = 0; a < 2; ++a)
#pragma unroll
            for (int b = 0; b < 2; ++b)
#pragma unroll
                for (int m = 0; m < 4; ++m)
#pragma unroll
                    for (int n = 0; n < 2; ++n) acc[a][b][m][n] = (f32x4){0.f, 0.f, 0.f, 0.f};
        cur = nxt; cA = nA; cB = nB; ++ui;
        if constexpr (ALIGN_EPI) { if (wr == 1) PG8_BAR; }
    }
    PG8_WAIT_V(0);
    if constexpr (!ALIGN_EPI) { if (wr == 0) PG8_BAR; }
    PG8_BAR;
    if constexpr (Epi::AFTER_DRAIN) { E.fused(acc, cur, wr, wc, fr, fq, lds, wid, lane); S.done(cur); }
#undef PG8_SA
#undef PG8_SB
#undef PG8_STAGE
#undef PG8_LDA
#undef PG8_LDB
#undef PG8_MMA
#undef PG8_WAIT_V
#undef PG8_WAIT_L
#undef PG8_BAR
#undef PG8_SCHED
}
}
namespace att {
typedef unsigned short bf16_t;
using bf16x8 = __attribute__((ext_vector_type(8))) short;
using s16x4 = __attribute__((ext_vector_type(4))) short;
using f32x16 = __attribute__((ext_vector_type(16))) float;
using u32x4 = __attribute__((ext_vector_type(4))) unsigned;
#define ATT_LAS __attribute__((address_space(3)))
constexpr int NW = 8, NSLOT = 3, SLOTB = 16384, VOFF = 8192;
constexpr int LDS_WS = NSLOT * SLOTB, LDS_OST = LDS_WS + NW * 256, LDS_TAB = LDS_OST + NW * 4096, TAB_PAD = 64, LDS_END = LDS_TAB + 4096;
constexpr float NEG_INF = -__builtin_inff();
__device__ __forceinline__ constexpr int crow(int r, int hi) { return (r & 3) + 8 * (r >> 2) + 4 * hi; }
__device__ __forceinline__ void glds16(const void* gsrc, unsigned lds_dst) { unsigned keep;
    asm volatile("s_mov_b32 %0, m0\n\ts_mov_b32 m0, %2\n\ts_nop 0\n\tglobal_load_lds_dwordx4 %1, off\n\ts_mov_b32 m0, %0" : "=&s"(keep) : "v"(gsrc), "s"(lds_dst) : "memory"); }
__device__ __forceinline__ float max3f(float a, float b, float c) { return __builtin_fmaxf(__builtin_fmaxf(a, b), c); }
typedef float f32x2_t __attribute__((ext_vector_type(2))); typedef __bf16 bf16x2_t __attribute__((ext_vector_type(2)));
__device__ __forceinline__ unsigned cvtpk_s(float lo, float hi) { f32x2_t v = {lo, hi}; bf16x2_t b = __builtin_convertvector(v, bf16x2_t); return __builtin_bit_cast(unsigned, b); }

__device__ __forceinline__ void qkt(f32x16& p0, f32x16& p1, const ATT_LAS char* kp, const bf16x8* qr) {
    const f32x16 z = f32x16{};
#pragma unroll
    for (int d0 = 0; d0 < 4; ++d0) {
        const bf16x8 b0 = *(const ATT_LAS bf16x8*)(kp + d0 * 2048);
        const bf16x8 b1 = *(const ATT_LAS bf16x8*)(kp + d0 * 2048 + 512);
        if (d0 == 0) { p0 = __builtin_amdgcn_mfma_f32_32x32x16_bf16(b0, qr[0], z, 0, 0, 0); p1 = __builtin_amdgcn_mfma_f32_32x32x16_bf16(b1, qr[0], z, 0, 0, 0); }
        else { p0 = __builtin_amdgcn_mfma_f32_32x32x16_bf16(b0, qr[d0], p0, 0, 0, 0); p1 = __builtin_amdgcn_mfma_f32_32x32x16_bf16(b1, qr[d0], p1, 0, 0, 0); } }
}
__device__ __forceinline__ float rowmax(const f32x16& p0, const f32x16& p1) {
    float a = max3f(p0[0], p0[1], p1[0]), b = max3f(p0[2], p0[3], p1[1]); a = max3f(a, p1[2], p1[3]);
#pragma unroll
    for (int r = 4; r < 16; r += 4) { a = max3f(a, p0[r], p0[r + 1]); b = max3f(b, p0[r + 2], p0[r + 3]); a = max3f(a, p1[r], p1[r + 1]); b = max3f(b, p1[r + 2], p1[r + 3]); }
    const float m = __builtin_fmaxf(a, b);
    auto rr = __builtin_amdgcn_permlane32_swap(__float_as_uint(m), __float_as_uint(m), false, false);
    return __builtin_fmaxf(__uint_as_float(rr[0]), __uint_as_float(rr[1]));
}
__device__ __forceinline__ void pv(f32x16* o, int vb, bf16x8 pa0, bf16x8 pa1, bf16x8 pa2, bf16x8 pa3) {
#pragma unroll
    for (int d0 = 0; d0 < 2; ++d0) { s16x4 lo[4], hi[4];
#pragma unroll
        for (int ks = 0; ks < 4; ++ks) {
            asm volatile("ds_read_b64_tr_b16 %0,%1 offset:%c2" : "=&v"(lo[ks]) : "v"(vb), "i"(d0 * 4096 + ks * 1024) : "memory");
            asm volatile("ds_read_b64_tr_b16 %0,%1 offset:%c2" : "=&v"(hi[ks]) : "v"(vb), "i"(d0 * 4096 + ks * 1024 + 512) : "memory"); }
        asm volatile("s_waitcnt lgkmcnt(0)" ::: "memory"); __builtin_amdgcn_sched_barrier(0);
#define ATT_PK(k) (bf16x8){lo[k][0], lo[k][1], lo[k][2], lo[k][3], hi[k][0], hi[k][1], hi[k][2], hi[k][3]}
        o[d0] = __builtin_amdgcn_mfma_f32_32x32x16_bf16(pa0, ATT_PK(0), o[d0], 0, 0, 0);
        o[d0] = __builtin_amdgcn_mfma_f32_32x32x16_bf16(pa1, ATT_PK(1), o[d0], 0, 0, 0);
        o[d0] = __builtin_amdgcn_mfma_f32_32x32x16_bf16(pa2, ATT_PK(2), o[d0], 0, 0, 0);
        o[d0] = __builtin_amdgcn_mfma_f32_32x32x16_bf16(pa3, ATT_PK(3), o[d0], 0, 0, 0);
#undef ATT_PK
    }
}

struct UnitP {
    const bf16_t* Q; int qpitch;
    const bf16_t* K; const bf16_t* V; int kvpitch, kvmax;
    int row0, ntiles;
    bf16_t* O; int opitch;
    int tok0;
    float slope2, m0, l0;
    const float* rpb;
    int seqlen;
};
template <int TYPE>
__device__ __forceinline__ void attn_unit(const UnitP& U, ATT_LAS unsigned char* lds) {
    int tid_ = threadIdx.x; asm volatile("" : "+v"(tid_));
    const int tid = tid_, lane = tid & 63, r32 = lane & 31, hi = lane >> 5; const int wid = __builtin_amdgcn_readfirstlane(tid >> 6);
    const unsigned lds0 = (unsigned)(uintptr_t)lds;
    const ATT_LAS char* shm3 = (const ATT_LAS char*)lds;
    ATT_LAS float* wsf = (ATT_LAS float*)(lds + LDS_WS) + wid * 64;
    ATT_LAS float* tab = (ATT_LAS float*)(lds + LDS_TAB);
    if (TYPE == 1) { for (int i = tid; i < 15 * 31; i += NW * 64) tab[TAB_PAD + i] = U.rpb[i] * 1.4426950408889634f; }
    const int NT = U.ntiles;
    const int krow = lane, vrow = 16 * (wid & 3) + (lane >> 2);
    const bf16_t* kcol = U.K + wid * 8; const bf16_t* vcol = U.V + (wid >> 2) * 32 + (lane & 3) * 8;
    const unsigned kdst = lds0 + wid * 1024, vdst = lds0 + VOFF + wid * 1024;
#define ATT_CLAMP(r) ((r) < 0 ? 0 : ((r) > U.kvmax ? U.kvmax : (r)))
#define ATT_DMA(t, slot) do { const int rb_ = U.row0 + 64 * (t); const int kr_ = ATT_CLAMP(rb_ + krow), vr_ = ATT_CLAMP(rb_ + vrow); \
        glds16(kcol + (size_t)kr_ * U.kvpitch, (unsigned)__builtin_amdgcn_readfirstlane(kdst + (slot) * SLOTB)); \
        glds16(vcol + (size_t)vr_ * U.kvpitch, (unsigned)__builtin_amdgcn_readfirstlane(vdst + (slot) * SLOTB)); } while (0)
    ATT_DMA(0, 0);
    bf16x8 qr[4];
    { const bf16_t* Qw = U.Q + (size_t)(wid * 32 + r32) * U.qpitch + hi * 8;
#pragma unroll
      for (int d0 = 0; d0 < 4; ++d0) qr[d0] = *(const bf16x8*)(Qw + d0 * 16); }
    float m = U.m0, l = (hi == 0) ? U.l0 : 0.f;
    f32x16 o[2]; o[0] = f32x16{}; o[1] = f32x16{};
    const int vb0 = (int)(lds0 + VOFF) + ((lane >> 4) & 1) * 32 + (lane & 3) * 8 + (4 * hi + ((lane & 15) >> 2)) * 64;
    const ATT_LAS char* kp0 = shm3 + hi * 1024 + r32 * 16;
    int t_lo, t_hi;
    if (TYPE == 0) { t_lo = wid >> 1; t_hi = t_lo + 4; }
    else if (TYPE == 1) { const int r = U.tok0 + (wid >> 1); int rs = r - 4; rs = rs < 0 ? 0 : (rs > 248 ? 248 : rs); const int T0 = U.row0 >> 6; t_lo = rs - T0; t_hi = t_lo + 7; }
    else { t_lo = 0; t_hi = NT - 1; }
    int slot = 0;
    for (int t = 0; t < NT; ++t) {
        const int nslot = (slot == NSLOT - 1) ? 0 : slot + 1;
        if (t + 1 < NT) { ATT_DMA(t + 1, nslot); asm volatile("s_waitcnt vmcnt(2) lgkmcnt(0)\n\ts_barrier" ::: "memory"); }
        else { asm volatile("s_waitcnt vmcnt(0) lgkmcnt(0)\n\ts_barrier" ::: "memory"); }
        bool rel = (t >= t_lo) && (t <= t_hi);
        if (TYPE == 0) { const int rb = U.row0 + 64 * t; rel = rel && (rb >= 0) && (rb < U.seqlen); }
        if (rel) {
            f32x16 p0, p1;
            qkt(p0, p1, kp0 + slot * SLOTB, qr);
            if (TYPE == 0) {
                const int dq = (U.tok0 + wid * 32 + r32) - (U.row0 + 64 * t + 4 * hi);
#pragma unroll
                for (int r = 0; r < 16; ++r) { const int cr = (r & 3) + 8 * (r >> 2); const int d0_ = dq - cr, d1_ = dq - cr - 32;
                    const int a0 = d0_ < 0 ? -d0_ : d0_, a1 = d1_ < 0 ? -d1_ : d1_;
                    p0[r] = (a0 <= 128) ? p0[r] - U.slope2 * (float)a0 : NEG_INF; p1[r] = (a1 <= 128) ? p1[r] - U.slope2 * (float)a1 : NEG_INF; }
            } else if (TYPE == 1) {
                const int rq = U.tok0 + (wid >> 1), c = 32 * (wid & 1) + r32; int cs = c - 8; cs = cs < 0 ? 0 : (cs > 48 ? 48 : cs);
                const int kr = (U.row0 >> 6) + t;
                const ATT_LAS float* tb = tab + TAB_PAD + (kr - rq + 7) * 31 + 15 - c + 4 * hi;
                const int kc = 4 * hi - cs;
#pragma unroll
                for (int r = 0; r < 16; ++r) { const int cr = (r & 3) + 8 * (r >> 2);
                    const float b0 = tb[cr], b1 = tb[cr + 32];
                    p0[r] = ((unsigned)(kc + cr) < 16u) ? p0[r] + b0 : NEG_INF; p1[r] = ((unsigned)(kc + cr + 32) < 16u) ? p1[r] + b1 : NEG_INF; }
            }
            const float rm = rowmax(p0, p1);
            const float mn = __builtin_fmaxf(m, rm);
            if (__any(mn > m)) {
                const float alpha = __builtin_amdgcn_exp2f(m - mn); l *= alpha;
                if (hi == 0) wsf[r32] = alpha;
                asm volatile("s_waitcnt lgkmcnt(0)" ::: "memory");
#pragma unroll
                for (int r = 0; r < 16; ++r) { const float f = wsf[crow(r, hi)]; o[0][r] *= f; o[1][r] *= f; }
                asm volatile("" ::: "memory");
            }
            m = mn;
            float sacc = 0.f;
#pragma unroll
            for (int r = 0; r < 16; ++r) { p0[r] = __builtin_amdgcn_exp2f(p0[r] - m); p1[r] = __builtin_amdgcn_exp2f(p1[r] - m); sacc += p0[r] + p1[r]; }
            l += sacc;
            u32x4 pw0, pw1, pw2, pw3;
            pw0 = (u32x4){cvtpk_s(p0[0], p0[1]), cvtpk_s(p0[2], p0[3]), cvtpk_s(p0[4], p0[5]), cvtpk_s(p0[6], p0[7])};
            pw1 = (u32x4){cvtpk_s(p0[8], p0[9]), cvtpk_s(p0[10], p0[11]), cvtpk_s(p0[12], p0[13]), cvtpk_s(p0[14], p0[15])};
            pw2 = (u32x4){cvtpk_s(p1[0], p1[1]), cvtpk_s(p1[2], p1[3]), cvtpk_s(p1[4], p1[5]), cvtpk_s(p1[6], p1[7])};
            pw3 = (u32x4){cvtpk_s(p1[8], p1[9]), cvtpk_s(p1[10], p1[11]), cvtpk_s(p1[12], p1[13]), cvtpk_s(p1[14], p1[15])};
            __builtin_amdgcn_sched_barrier(0);
            pv(o, vb0 + slot * SLOTB, __builtin_bit_cast(bf16x8, pw0), __builtin_bit_cast(bf16x8, pw1), __builtin_bit_cast(bf16x8, pw2), __builtin_bit_cast(bf16x8, pw3));
        }
        slot = nslot;
    }
    { auto rr = __builtin_amdgcn_permlane32_swap(__float_as_uint(l), __float_as_uint(l), false, false); l = __uint_as_float(rr[0]) + __uint_as_float(rr[1]); }
    asm volatile("" ::: "memory");
    if (hi == 0) wsf[32 + r32] = l;
    asm volatile("s_waitcnt lgkmcnt(0)" ::: "memory");
    float rli[16];
#pragma unroll
    for (int r = 0; r < 16; ++r) rli[r] = __builtin_amdgcn_rcpf(wsf[32 + crow(r, hi)]);
    { ATT_LAS bf16_t* stg = (ATT_LAS bf16_t*)(lds + LDS_OST) + wid * 2048;
#pragma unroll
      for (int r = 0; r < 16; ++r) { const int orow = crow(r, hi);
#pragma unroll
          for (int d0 = 0; d0 < 2; ++d0) { const unsigned pk = cvtpk_s(o[d0][r] * rli[r], 0.f); stg[orow * 64 + d0 * 32 + r32] = (bf16_t)(pk & 0xffffu); } }
      asm volatile("s_waitcnt lgkmcnt(0)" ::: "memory");
      bf16_t* Ow = U.O + (size_t)(wid * 32) * U.opitch;
#pragma unroll
      for (int i = 0; i < 4; ++i) { const int row = i * 8 + (lane >> 3), ch = lane & 7; const u32x4 v = *(const ATT_LAS u32x4*)(stg + row * 64 + ch * 8); *(u32x4*)(Ow + (size_t)row * U.opitch + ch * 8) = v; } }
    asm volatile("s_waitcnt vmcnt(0) lgkmcnt(0)\n\ts_barrier" ::: "memory");
#undef ATT_DMA
#undef ATT_CLAMP
}
}
constexpr int NWAVES = 8;
constexpr int SEQ = 16384, DM = 1024, DEPTH = 4, NQH = 12, NMH = 4, NMEM = 256, WIN_A = 1536, WIN_B = 2560, DFF = 2816, NGU = 2 * DFF;
constexpr float LOG2E = 1.4426950408889634f, C2 = 0.125f * LOG2E;
constexpr int N_PHASES = 2 + 5 * DEPTH;
#ifndef MK_PER_PHASE
#define MK_PER_PHASE 0
#endif
#ifndef MK_NAIVE
#define MK_NAIVE 0
#endif

constexpr size_t MiB = 1u << 20;
constexpr size_t WS_CTL = 0, CTL_ZERO_BYTES = 1 * MiB;
constexpr size_t WS_SSQA = 1 * MiB, WS_SSQB = 2 * MiB;
constexpr size_t WS_MEMN = 3 * MiB;
constexpr size_t WS_MKV = 4 * MiB;
constexpr size_t WS_WIN = 6 * MiB;
constexpr size_t WS_WOUT = WS_WIN + 16 * MiB, WS_WGU = WS_WOUT + 8 * MiB, WS_WDN = WS_WGU + 44 * MiB, WS_WMKV = WS_WDN + 22 * MiB;
constexpr size_t WS_XB = WS_WMKV + 4 * MiB;
constexpr size_t WS_PROJ = WS_XB + 32 * MiB;
constexpr size_t WS_Y = WS_PROJ + 80 * MiB;
constexpr size_t WS_H = WS_PROJ;
constexpr size_t WS_END = WS_Y + 32 * MiB;
static_assert(WS_END <= 256 * MiB, "d_ws map");
__host__ __device__ constexpr size_t win_off(int l) { return (size_t)((l >> 1) * 8 + (l & 1) * 3) * MiB; }
constexpr int CW_BAR = 4096;

constexpr int RING_OFF = 0, RING_BYTES = 131072, LDSCTL_OFF = RING_BYTES, MISC_OFF = LDSCTL_OFF + 320, LDS_BYTES = 147456;
static_assert(att::LDS_END <= RING_BYTES, "attention scratch inside the ring region");

#define GAS __attribute__((address_space(1)))
#define LAS __attribute__((address_space(3)))
typedef unsigned short bf16;
typedef unsigned v4u __attribute__((ext_vector_type(4)));
typedef float f32x4 __attribute__((ext_vector_type(4)));
typedef short bf16x8 __attribute__((ext_vector_type(8)));
typedef GAS unsigned gu32;
typedef GAS unsigned long long gu64;
#define RLX_AGENT __ATOMIC_RELAXED, __HIP_MEMORY_SCOPE_AGENT
#define LDS_WAIT() asm volatile("s_waitcnt lgkmcnt(0)" ::: "memory")
#define VM_WAIT() asm volatile("s_waitcnt vmcnt(0)" ::: "memory")
__device__ __forceinline__ unsigned long long rt() { return __builtin_amdgcn_s_memrealtime(); }
__device__ __forceinline__ unsigned f2bf(float f) { unsigned u = __builtin_bit_cast(unsigned, f); return (u + 0x7fffu + ((u >> 16) & 1u)) >> 16; }
__device__ __forceinline__ unsigned pk2(float lo, float hi) { return f2bf(lo) | (f2bf(hi) << 16); }

#define XB_TMO      128
#define XB_XCNT(j)  (256  + 64 * (j))
#define XB_XSUB(j)  (1280 + 64 * (j))
#define XB_XGEN(j)  (2304 + 64 * (j))
#define XB_TOP      3328
#define XB_TOPGEN   3392
#define XCD_BAR_WORDS 3456
#define XB_SPIN_CAP (1u << 18)

__device__ __forceinline__ unsigned xb_ld(unsigned* p)              { return __hip_atomic_load(p, __ATOMIC_RELAXED, __HIP_MEMORY_SCOPE_AGENT); }
__device__ __forceinline__ unsigned xb_add(unsigned* p, unsigned v) { return __hip_atomic_fetch_add(p, v, __ATOMIC_RELAXED, __HIP_MEMORY_SCOPE_AGENT); }
__device__ __forceinline__ unsigned xb_xcc_id() { return (unsigned)__builtin_amdgcn_s_getreg((3 << 11) | 20) & 0xFu; }
#define XB_SPIN(cond, bar) do { unsigned _sp = 0; while (cond) { __builtin_amdgcn_s_sleep(1); \
    if ((++_sp & 255u) == 0u) { if (xb_ld(&(bar)[XB_TMO])) break; if (_sp > XB_SPIN_CAP) { atomicAdd(&(bar)[XB_TMO], 1u); break; } } } } while (0)

struct XcdBarrier {
    unsigned* bar; unsigned x;
    volatile LAS unsigned* st;
};

__device__ __forceinline__ XcdBarrier xcd_barrier_post(unsigned* bar, volatile LAS unsigned* st) {
    XcdBarrier b; b.bar = bar; b.x = xb_xcc_id(); b.st = st;
    if (threadIdx.x == 0) (void)xb_add(&bar[XB_XCNT(b.x)], 1u);
    return b;
}
__device__ __forceinline__ void xcd_barrier_complete(unsigned* bar, unsigned x, unsigned& nloc, unsigned& nx) {
    const unsigned G = gridDim.x * gridDim.y * gridDim.z;
    unsigned sum, cnt, mine, sp = 0u;
    for (;;) {
        sum = 0u; cnt = 0u; mine = 0u;
#pragma unroll
        for (unsigned j = 0; j < 16; ++j) { const unsigned c = xb_ld(&bar[XB_XCNT(j)]); sum += c; cnt += (c > 0u) ? 1u : 0u; mine = (j == x) ? c : mine; }
        if (sum == G) break;
        __builtin_amdgcn_s_sleep(1);
        if ((++sp & 255u) == 0u) { if (xb_ld(&bar[XB_TMO])) break; if (sp > XB_SPIN_CAP) { atomicAdd(&bar[XB_TMO], 1u); break; } }
    }
    nloc = mine > 0u ? mine : 1u; nx = cnt > 0u ? cnt : 1u;
}

__device__ __forceinline__ void xcd_barrier(const XcdBarrier& b) {
    asm volatile("s_waitcnt vmcnt(0)" ::: "memory");
    __syncthreads();
    if (threadIdx.x == 0) {
        unsigned* bar = b.bar;
        __builtin_amdgcn_s_waitcnt(0);
        unsigned nloc = b.st[0], nx = b.st[1];
        if (nloc == 0u) { xcd_barrier_complete(bar, b.x, nloc, nx); b.st[0] = nloc; b.st[1] = nx; }
        const unsigned old = xb_add(&bar[XB_XSUB(b.x)], 1u);
        const unsigned gen = old / nloc;
        if (old + 1u == (gen + 1u) * nloc) {
            __builtin_amdgcn_fence(__ATOMIC_RELEASE, "agent");
            asm volatile("s_waitcnt vmcnt(0)" ::: "memory");
            const unsigned og = xb_add(&bar[XB_TOP], 1u);
            const unsigned tg = og / nx;
            if (og + 1u == (tg + 1u) * nx) xb_add(&bar[XB_TOPGEN], 1u);
            else XB_SPIN(xb_ld(&bar[XB_TOPGEN]) == tg, bar);
            __builtin_amdgcn_fence(__ATOMIC_ACQUIRE, "agent");
            xb_add(&bar[XB_XGEN(b.x)], 1u);
            asm volatile("s_waitcnt vmcnt(0)" ::: "memory");
        } else {
            XB_SPIN(xb_ld(&bar[XB_XGEN(b.x)]) == gen, bar);
            __builtin_amdgcn_fence(__ATOMIC_ACQUIRE, "agent");
            asm volatile("s_waitcnt vmcnt(0)" ::: "memory");
        }
    }
    __syncthreads();
}
struct Frame {
    LAS unsigned char* lds;
    volatile LAS unsigned* MISC;
    gu32* ctl;
    int tid, lane, wave;
    int vcu, G;
    const float *x, *mem, *norm_mix, *norm_ffn, *norm_mem, *norm_final, *w_in_a, *sink_a, *w_in_b, *rpb_b, *w_mem_kv, *w_out, *w_gate_up, *w_down;
    float* out; unsigned char* ws;
};
__device__ __forceinline__ float wave_sum(float v) {
#pragma unroll
    for (int o = 1; o < 64; o <<= 1) v += __shfl_xor(v, o);
    return v;
}
__device__ __forceinline__ void transpose_item(const float* W, int K, int N, bf16* WT, int mode, const float* g, LAS float* scr, int item, int lane) {
    const int nblk = N / 32, kb = item / nblk, nb = item % nblk, k0 = 64 * kb, n0 = 32 * nb;
#pragma unroll 8
    for (int i = 0; i < 32; ++i) { const int kk = 2 * i + (lane >> 5); const float gv = g ? g[k0 + kk] : 1.f; scr[kk * 33 + (lane & 31)] = W[(size_t)(k0 + kk) * N + n0 + (lane & 31)] * gv; }
    LDS_WAIT(); asm volatile("" ::: "memory");
    int rbase = n0;
    if (mode == 1) { rbase = (n0 < DFF) ? ((n0 / 128) * 256 + (n0 % 128)) : (((n0 - DFF) / 128) * 256 + 128 + ((n0 - DFF) % 128)); }
    const int c = lane & 7;
#pragma unroll
    for (int j = 0; j < 4; ++j) { const int n = (lane >> 3) + 8 * j; const LAS float* s = scr + (8 * c) * 33 + n;
        v4u o; o.x = pk2(s[0 * 33], s[1 * 33]); o.y = pk2(s[2 * 33], s[3 * 33]); o.z = pk2(s[4 * 33], s[5 * 33]); o.w = pk2(s[6 * 33], s[7 * 33]);
        *(GAS v4u*)(WT + (size_t)(rbase + n) * K + k0 + 8 * c) = o; }
    LDS_WAIT(); asm volatile("" ::: "memory");
}
__device__ __forceinline__ int items_in(int l) { return 16 * (((l & 1) ? WIN_B : WIN_A) / 32); }
constexpr int IT_OUT = 16 * 32, IT_GU = 16 * (NGU / 32), IT_DN = (DFF / 64) * 32, IT_MKV = 16 * 16;
__device__ __forceinline__ void p0_prologue(Frame& F) {
    LAS float* scr = (LAS float*)(F.lds + RING_OFF + F.wave * 16384);
    const int gw = F.vcu * NWAVES + F.wave, NGW = F.G * NWAVES;
    const int per_a = 16 * (WIN_A / 32) + IT_OUT + IT_GU + IT_DN + IT_MKV, per_b = 16 * (WIN_B / 32) + IT_OUT + IT_GU + IT_DN + IT_MKV;
    const int NITEMS = 2 * (per_a + per_b);
    for (int it = gw; it < NITEMS; it += NGW) {
        int r = it, l = 0;
        { const int pair = per_a + per_b; l = 2 * (r / pair); r = r % pair; if (r >= per_a) { r -= per_a; l += 1; } }
        const int nin = (l & 1) ? WIN_B : WIN_A, iin = 16 * (nin / 32);
        if (r < iin) { const float* W = (l & 1) ? F.w_in_b + (size_t)(l >> 1) * DM * WIN_B : F.w_in_a + (size_t)(l >> 1) * DM * WIN_A;
            transpose_item(W, DM, nin, (bf16*)(F.ws + WS_WIN + win_off(l)), 0, F.norm_mix + l * DM, scr, r, F.lane); continue; } r -= iin;
        if (r < IT_OUT) { transpose_item(F.w_out + (size_t)l * DM * DM, DM, DM, (bf16*)(F.ws + WS_WOUT + (size_t)l * 2 * MiB), 0, nullptr, scr, r, F.lane); continue; } r -= IT_OUT;
        if (r < IT_GU) { transpose_item(F.w_gate_up + (size_t)l * DM * NGU, DM, NGU, (bf16*)(F.ws + WS_WGU + (size_t)l * 11 * MiB), 1, F.norm_ffn + l * DM, scr, r, F.lane); continue; } r -= IT_GU;
        if (r < IT_DN) { transpose_item(F.w_down + (size_t)l * DFF * DM, DFF, DM, (bf16*)(F.ws + WS_WDN + (size_t)l * DFF * DM * 2), 0, nullptr, scr, r, F.lane); continue; } r -= IT_DN;
        transpose_item(F.w_mem_kv + (size_t)l * DM * 512, DM, 512, (bf16*)(F.ws + WS_WMKV + (size_t)l * MiB), 0, nullptr, scr, r, F.lane);
    }
    for (int m = gw; m < SEQ; m += NGW) {
        const GAS f32x4* xr = (const GAS f32x4*)(F.x + (size_t)m * DM) + F.lane; f32x4 v[4]; float s = 0.f;
#pragma unroll
        for (int j = 0; j < 4; ++j) { v[j] = xr[64 * j]; s += (v[j].x * v[j].x + v[j].y * v[j].y) + (v[j].z * v[j].z + v[j].w * v[j].w); }
        s = wave_sum(s);
        GAS unsigned long long* o8 = (GAS unsigned long long*)(F.ws + WS_XB + (size_t)m * DM * 2) + F.lane;
#pragma unroll
        for (int j = 0; j < 4; ++j) o8[64 * j] = (unsigned long long)pk2(v[j].x, v[j].y) | ((unsigned long long)pk2(v[j].z, v[j].w) << 32);
        if (F.lane < 16) ((GAS float*)(F.ws + WS_SSQA))[(size_t)m * 16 + F.lane] = (F.lane == 0) ? s : 0.f;
    }
    for (int m = gw; m < NMEM; m += NGW) {
        const GAS f32x4* xr = (const GAS f32x4*)(F.mem + (size_t)m * DM) + F.lane; const GAS f32x4* gr = (const GAS f32x4*)F.norm_mem + F.lane; f32x4 v[4]; float s = 0.f;
#pragma unroll
        for (int j = 0; j < 4; ++j) { v[j] = xr[64 * j]; s += (v[j].x * v[j].x + v[j].y * v[j].y) + (v[j].z * v[j].z + v[j].w * v[j].w); }
        const float rstd = 1.0f / sqrtf(wave_sum(s) * (1.0f / DM) + 1e-6f);
        GAS unsigned long long* o8 = (GAS unsigned long long*)(F.ws + WS_MEMN + (size_t)m * DM * 2) + F.lane;
#pragma unroll
        for (int j = 0; j < 4; ++j) { const f32x4 g = gr[64 * j]; const f32x4 y = v[j] * rstd * g; o8[64 * j] = (unsigned long long)pk2(y.x, y.y) | ((unsigned long long)pk2(y.z, y.w) << 32); }
    }
}
__device__ __forceinline__ void final_norm(Frame& F) {
    const int gw = F.vcu * NWAVES + F.wave, NGW = F.G * NWAVES;
    const GAS f32x4* gr = (const GAS f32x4*)F.norm_final + F.lane;
    for (int m = gw; m < SEQ; m += NGW) {
        GAS f32x4* xr = (GAS f32x4*)(F.out + (size_t)m * DM) + F.lane;
        const float rstd = pg8::row_rstd((const float*)(F.ws + WS_SSQA), m);
#pragma unroll
        for (int j = 0; j < 4; ++j) { const f32x4 v = xr[64 * j], g = gr[64 * j]; xr[64 * j] = v * rstd * g; }
    }
}
__device__ __forceinline__ void attn_phase(Frame& F, int l, int amask) {
    const bool isA = (l & 1) == 0; const int pitch = isA ? WIN_A : WIN_B;
    const att::bf16_t* P = (const att::bf16_t*)(F.ws + WS_PROJ); att::bf16_t* Y = (att::bf16_t*)(F.ws + WS_Y);
    const att::bf16_t* MKV = (const att::bf16_t*)(F.ws + WS_MKV) + l * 512;
    for (int u = F.vcu; u < 1024; u += F.G) {
        att::UnitP U; U.seqlen = SEQ; U.rpb = nullptr; U.slope2 = 0.f; U.m0 = -1e30f; U.l0 = 0.f;
        if (u < 768) {
            if (!(amask & 1)) continue;
            const int h = u % NQH, blk = u / NQH, tok0 = blk * 256;
            U.Q = P + (size_t)tok0 * pitch + h * 64; U.qpitch = pitch; U.O = Y + (size_t)tok0 * DM + h * 64; U.opitch = DM; U.kvpitch = pitch; U.kvmax = SEQ - 1;
            if (isA) {
                U.K = P + 768 + (h / 3) * 64; U.V = P + 1024 + (h / 3) * 64; U.row0 = tok0 - 128; U.ntiles = 8; U.tok0 = tok0;
                U.slope2 = exp2f(-8.0f * (float)(h + 1) / 12.0f) * LOG2E; U.m0 = F.sink_a[(l >> 1) * NQH + h] * LOG2E; U.l0 = 1.f;
                att::attn_unit<0>(U, F.lds + RING_OFF);
            } else {
                const int R0 = blk * 4; int T0 = R0 - 4; T0 = T0 < 0 ? 0 : (T0 > 248 ? 248 : T0); int T1 = R0 - 1; T1 = T1 < 0 ? 0 : (T1 > 248 ? 248 : T1); T1 += 7;
                U.K = P + 768 + h * 64; U.V = P + 1536 + h * 64; U.row0 = T0 * 64; U.ntiles = T1 - T0 + 1; U.tok0 = R0;
                U.rpb = F.rpb_b + ((size_t)(l >> 1) * NQH + h) * 15 * 31;
                att::attn_unit<1>(U, F.lds + RING_OFF);
            }
        } else {
            if (!(amask & 2)) continue;
            const int v = u - 768, hm = v % NMH, blk = v / NMH, tok0 = blk * 256;
            U.Q = P + (size_t)tok0 * pitch + (pitch - 256) + hm * 64; U.qpitch = pitch; U.O = Y + (size_t)tok0 * DM + 768 + hm * 64; U.opitch = DM;
            U.K = MKV + hm * 64; U.V = MKV + 256 + hm * 64; U.kvpitch = 2048; U.kvmax = NMEM - 1; U.row0 = 0; U.ntiles = 4; U.tok0 = tok0;
            att::attn_unit<2>(U, F.lds + RING_OFF);
        }
    }
}

struct Args { const float* in[14]; float* out; unsigned char* ws; int ph_lo, ph_hi, li, amask; };
__global__ void __launch_bounds__(NWAVES * 64, 2) skel_fwd(Args args) {
    extern __shared__ __attribute__((aligned(16))) unsigned char lds[];
    Frame F;
    F.lds = (LAS unsigned char*)lds;
    F.MISC = (volatile LAS unsigned*)(F.lds + MISC_OFF);
    F.tid = threadIdx.x; F.lane = F.tid & 63; F.wave = __builtin_amdgcn_readfirstlane(F.tid >> 6);
    F.G = gridDim.x; { const int bx = blockIdx.x; F.vcu = (F.G % 8 == 0) ? (bx % 8) * (F.G / 8) + bx / 8 : bx; }
    F.ws = args.ws; F.out = args.out; F.ctl = (gu32*)(args.ws + WS_CTL);
    F.x = args.in[0]; F.mem = args.in[1]; F.norm_mix = args.in[2]; F.norm_ffn = args.in[3]; F.norm_mem = args.in[4]; F.norm_final = args.in[5]; F.w_in_a = args.in[6]; F.sink_a = args.in[7];
    F.w_in_b = args.in[8]; F.rpb_b = args.in[9]; F.w_mem_kv = args.in[10]; F.w_out = args.in[11]; F.w_gate_up = args.in[12]; F.w_down = args.in[13];
    for (int u = F.tid; u < (LDS_BYTES - LDSCTL_OFF) / 4; u += NWAVES * 64) ((LAS unsigned*)(F.lds + LDSCTL_OFF))[u] = 0u;
    __syncthreads();
    XcdBarrier bar; bar.bar = (unsigned*)(F.ctl + CW_BAR) + args.li * XCD_BAR_WORDS; bar.x = 0; bar.st = nullptr;
    if (!MK_PER_PHASE) bar = xcd_barrier_post((unsigned*)(F.ctl + CW_BAR) + args.li * XCD_BAR_WORDS, F.MISC + 8);
    const int lo = args.ph_lo, hi = args.ph_hi;
#define IN(k) (lo <= (k) && (k) < hi)
#define SEAM(k) do { if (IN((k) + 1)) xcd_barrier(bar); } while (0)
    typedef pg8::bf16_t pb;
    if (IN(0)) { p0_prologue(F); SEAM(0); }
    for (int l = 0; l < DEPTH; ++l) {
        const int pb0 = 1 + 5 * l; const bool isA = (l & 1) == 0; const int nin = isA ? WIN_A : WIN_B;
        if (IN(pb0)) {
            { pg8::Gemm g{(const pb*)(F.ws + WS_XB), (const pb*)(F.ws + WS_WIN + win_off(l)), SEQ, nin, DM}; pg8::StaticOrder S; S.init(SEQ, nin, F.G, (int)blockIdx.x);
              pg8::EpiProj E{(pb*)(F.ws + WS_PROJ), nin, (const float*)(F.ws + WS_SSQA), 3, nin / 256 - 1, C2};
              pg8::gemm_phase<pg8::EpiProj, pg8::StaticOrder, true, true>(F.lds + RING_OFF, g, S, E); }
            if (l == 0) { pg8::Gemm g{(const pb*)(F.ws + WS_MEMN), (const pb*)(F.ws + WS_WMKV), NMEM, 2048, DM}; pg8::StaticOrder S; S.init(NMEM, 2048, F.G, (int)((blockIdx.x + F.G - 8) % F.G));
              pg8::EpiProj E{(pb*)(F.ws + WS_MKV), 2048, nullptr, 0, -1, 1.f};
              pg8::gemm_phase<pg8::EpiProj, pg8::StaticOrder, true, true>(F.lds + RING_OFF, g, S, E); }
            SEAM(pb0);
        }
        if (IN(pb0 + 1)) { attn_phase(F, l, args.amask); SEAM(pb0 + 1); }
        if (IN(pb0 + 2)) {
            pg8::Gemm g{(const pb*)(F.ws + WS_Y), (const pb*)(F.ws + WS_WOUT + (size_t)l * 2 * MiB), SEQ, DM, DM}; pg8::StaticOrder S; S.init(SEQ, DM, F.G, (int)blockIdx.x);
            pg8::EpiRes E{l == 0 ? F.x : (const float*)F.out, F.out, (pb*)(F.ws + WS_XB), (float*)(F.ws + WS_SSQB), DM};
            pg8::gemm_phase<pg8::EpiRes, pg8::StaticOrder, true, true>(F.lds + RING_OFF, g, S, E);
            SEAM(pb0 + 2);
        }
        if (IN(pb0 + 3)) {
            pg8::Gemm g{(const pb*)(F.ws + WS_XB), (const pb*)(F.ws + WS_WGU + (size_t)l * 11 * MiB), SEQ, NGU, DM}; pg8::StaticOrder S; S.init(SEQ, NGU, F.G, (int)blockIdx.x);
            pg8::EpiGU E{(pb*)(F.ws + WS_H), DFF, (const float*)(F.ws + WS_SSQB)};
            pg8::gemm_phase<pg8::EpiGU, pg8::StaticOrder, true, true>(F.lds + RING_OFF, g, S, E);
            SEAM(pb0 + 3);
        }
        if (IN(pb0 + 4)) {
            pg8::Gemm g{(const pb*)(F.ws + WS_H), (const pb*)(F.ws + WS_WDN + (size_t)l * DFF * DM * 2), SEQ, DM, DFF}; pg8::StaticOrder S; S.init(SEQ, DM, F.G, (int)blockIdx.x);
            pg8::EpiRes E{(const float*)F.out, F.out, (pb*)(F.ws + WS_XB), (float*)(F.ws + WS_SSQA), DM};
            pg8::gemm_phase<pg8::EpiRes, pg8::StaticOrder, true, true>(F.lds + RING_OFF, g, S, E);
            SEAM(pb0 + 4);
        }
    }
    if (IN(N_PHASES - 1)) final_norm(F);
#undef IN
#undef SEAM
}
#if MK_PER_PHASE && MK_NAIVE
namespace nv {
__device__ __forceinline__ float bf2f(unsigned short b) { return __uint_as_float((unsigned)b << 16); }
struct GArgs { const bf16* A; const bf16* Bt; int M, N, K, mode;
    bf16* O; int ldc; const float* ssq; int nq_tiles, qm_tile; float qscale;
    const float* base; float* out; bf16* xb; };
__global__ void __launch_bounds__(256) naive_gemm(GArgs a) {
    __shared__ float As[16][65], Bs[16][65], Bs2[16][65];
    const int tx = threadIdx.x & 15, ty = threadIdx.x >> 4, bx = blockIdx.x, by = blockIdx.y;
    float acc[4][4], acc2[4][4];
#pragma unroll
    for (int i = 0; i < 4; ++i)
#pragma unroll
        for (int j = 0; j < 4; ++j) { acc[i][j] = 0.f; acc2[i][j] = 0.f; }
    const int lr = threadIdx.x >> 2, lk = (threadIdx.x & 3) * 4;
    const int jc = bx * 64 + lr;
    const size_t brow = (a.mode == 2) ? (size_t)((jc / 128) * 256 + (jc % 128)) : (size_t)jc;
    for (int k0 = 0; k0 < a.K; k0 += 16) {
        const bf16* ap = a.A + (size_t)(by * 64 + lr) * a.K + k0 + lk; const bf16* bp = a.Bt + brow * a.K + k0 + lk;
#pragma unroll
        for (int i = 0; i < 4; ++i) { As[lk + i][lr] = bf2f(ap[i]); Bs[lk + i][lr] = bf2f(bp[i]); if (a.mode == 2) Bs2[lk + i][lr] = bf2f(bp[(size_t)128 * a.K + i]); }
        __syncthreads();
#pragma unroll
        for (int k = 0; k < 16; ++k) {
#pragma unroll
            for (int i = 0; i < 4; ++i)
#pragma unroll
                for (int j = 0; j < 4; ++j) { acc[i][j] += As[k][ty * 4 + i] * Bs[k][tx * 4 + j]; if (a.mode == 2) acc2[i][j] += As[k][ty * 4 + i] * Bs2[k][tx * 4 + j]; }
        }
        __syncthreads();
    }
#pragma unroll
    for (int i = 0; i < 4; ++i)
#pragma unroll
        for (int j = 0; j < 4; ++j) {
            const int row = by * 64 + ty * 4 + i, col = bx * 64 + tx * 4 + j;
            if (a.mode == 0) { float rs = 1.f; if (a.ssq) { float s = 0.f; for (int q = 0; q < 16; ++q) s += a.ssq[(size_t)row * 16 + q]; rs = 1.0f / sqrtf(s * (1.0f / 1024.0f) + 1e-6f); }
                const int pn = col / 256; const float sc = (pn < a.nq_tiles || pn == a.qm_tile) ? a.qscale : 1.f;
                a.O[(size_t)row * a.ldc + col] = (bf16)f2bf(acc[i][j] * rs * sc); }
            else if (a.mode == 1) { const size_t o = (size_t)row * a.ldc + col; const float v = a.base[o] + acc[i][j]; a.out[o] = v; a.xb[o] = (bf16)f2bf(v); }
            else { float s = 0.f; for (int q = 0; q < 16; ++q) s += a.ssq[(size_t)row * 16 + q]; const float rs = 1.0f / sqrtf(s * (1.0f / 1024.0f) + 1e-6f);
                const float g = acc[i][j] * rs, u = acc2[i][j] * rs; a.O[(size_t)row * a.ldc + col] = (bf16)f2bf(g / (1.0f + expf(-g)) * u); }
        }
}
__global__ void __launch_bounds__(256) naive_ssq(const float* x, float* ssq) {
    const int row = blockIdx.x * 256 + threadIdx.x; float s = 0.f;
    for (int c = 0; c < DM; ++c) { const float v = x[(size_t)row * DM + c]; s += v * v; }
    for (int q = 0; q < 16; ++q) ssq[(size_t)row * 16 + q] = (q == 0) ? s : 0.f;
}
__device__ __forceinline__ void ld64(const bf16* p, float (&v)[64]) {
#pragma unroll
    for (int c = 0; c < 8; ++c) { const uint4 w = *(const uint4*)(p + 8 * c); const unsigned ww[4] = {w.x, w.y, w.z, w.w};
#pragma unroll
        for (int e = 0; e < 4; ++e) { v[8 * c + 2 * e] = __uint_as_float(ww[e] << 16); v[8 * c + 2 * e + 1] = __uint_as_float(ww[e] & 0xffff0000u); } }
}
__global__ void __launch_bounds__(256) naive_attn(int type, const bf16* P, int pitch, const bf16* MKV, const float* sink, const float* rpb, bf16* Y) {
    const int idx = blockIdx.x * 256 + threadIdx.x; const int nh = (type == 2) ? NMH : NQH; const int h = idx % nh, t = idx / nh;
    float q[64], o[64], kv[64];
    ld64(P + (size_t)t * pitch + (type == 2 ? (pitch - 256) : 0) + h * 64, q);
#pragma unroll
    for (int d = 0; d < 64; ++d) o[d] = 0.f;
    float m = -1e30f, l = 0.f;
    int nkeys; if (type == 0) { m = sink[h] * LOG2E; l = 1.f; nkeys = 257; } else if (type == 1) nkeys = 128; else nkeys = 256;
    const float slope2 = exp2f(-8.0f * (float)(h + 1) / 12.0f) * LOG2E;
    const int r = t / 64, c = t % 64; int rs = r - 4; rs = rs < 0 ? 0 : (rs > 248 ? 248 : rs); int cs = c - 8; cs = cs < 0 ? 0 : (cs > 48 ? 48 : cs);
    for (int i = 0; i < nkeys; ++i) {
        const bf16 *kp, *vp; float bias = 0.f;
        if (type == 0) { const int s = t - 128 + i; if (s < 0 || s >= SEQ) continue; kp = P + (size_t)s * pitch + 768 + (h / 3) * 64; vp = P + (size_t)s * pitch + 1024 + (h / 3) * 64; bias = -slope2 * fabsf((float)(t - s)); }
        else if (type == 1) { const int kr = rs + (i >> 4), kc = cs + (i & 15); const int s = kr * 64 + kc; kp = P + (size_t)s * pitch + 768 + h * 64; vp = P + (size_t)s * pitch + 1536 + h * 64;
            bias = rpb[(size_t)h * 15 * 31 + (kr - r + 7) * 31 + (kc - c + 15)] * LOG2E; }
        else { kp = MKV + (size_t)i * 2048 + h * 64; vp = MKV + (size_t)i * 2048 + 256 + h * 64; }
        ld64(kp, kv); float dot = 0.f;
#pragma unroll
        for (int d = 0; d < 64; ++d) dot += q[d] * kv[d];
        const float sc = dot + bias, mn = fmaxf(m, sc), al = exp2f(m - mn), p = exp2f(sc - mn);
        ld64(vp, kv); l = l * al + p;
#pragma unroll
        for (int d = 0; d < 64; ++d) o[d] = o[d] * al + p * kv[d];
        m = mn;
    }
    const float il = 1.0f / l; bf16* yp = Y + (size_t)t * DM + (type == 2 ? 768 : 0) + h * 64;
#pragma unroll
    for (int d = 0; d < 64; ++d) yp[d] = (bf16)f2bf(o[d] * il);
}
}
#endif
extern "C" void kernel_launch(void* const* d_in, const int* in_sizes, int n_in, void* d_out, int out_size, void* d_ws, size_t ws_size, hipStream_t stream) {
    static int grid = 0;
    if (grid == 0) {
        if (n_in != 14 || in_sizes[0] != SEQ * DM || out_size != SEQ * DM || ws_size < WS_END) { fprintf(stderr, "kernel_launch: unexpected shapes (n_in %d, in0 %d, out %d, ws %zu); nothing launched\n", n_in, n_in > 0 ? in_sizes[0] : -1, out_size, ws_size); grid = -1; return; }
        int dev = 0, cus = 0, per_cu = 0;
        if (hipGetDevice(&dev) != hipSuccess || hipDeviceGetAttribute(&cus, hipDeviceAttributeMultiprocessorCount, dev) != hipSuccess) { grid = -1; return; }
        if (hipFuncSetAttribute((const void*)skel_fwd, hipFuncAttributeMaxDynamicSharedMemorySize, LDS_BYTES) != hipSuccess) { fprintf(stderr, "kernel_launch: hipFuncSetAttribute failed\n"); grid = -1; return; }
        if (hipOccupancyMaxActiveBlocksPerMultiprocessor(&per_cu, (const void*)skel_fwd, NWAVES * 64, LDS_BYTES) != hipSuccess || per_cu < 1)
            fprintf(stderr, "kernel_launch: note: occupancy query reports %d workgroups per CU\n", per_cu);
        (void)hipGetLastError();
        grid = cus;
    }
    if (grid < 0) return;
    if (hipMemsetAsync((char*)d_ws + WS_CTL, 0, CTL_ZERO_BYTES, stream) != hipSuccess) return;
    Args a{};
    for (int i = 0; i < 14; ++i) a.in[i] = (const float*)d_in[i];
    a.out = (float*)d_out; a.ws = (unsigned char*)d_ws; a.amask = 3;
#if MK_PER_PHASE
    unsigned char* ws = (unsigned char*)d_ws; const float* const* in = (const float* const*)d_in;
    for (int p = 0; p < N_PHASES; ++p) {
        const int l = (p - 1) / 5, k = (p - 1) % 5; const bool mid = (p > 0 && p < N_PHASES - 1);
        (void)l; (void)k; (void)ws; (void)in;
#if MK_NAIVE
        if (mid && (MK_NAIVE & 1) && k != 1) {
            const int nin = (l & 1) ? WIN_B : WIN_A;
            nv::GArgs g{};
            if (k == 0) { g.A = (const bf16*)(ws + WS_XB); g.Bt = (const bf16*)(ws + WS_WIN + win_off(l)); g.M = SEQ; g.N = nin; g.K = DM; g.mode = 0; g.O = (bf16*)(ws + WS_PROJ); g.ldc = nin; g.ssq = (const float*)(ws + WS_SSQA);
                g.nq_tiles = 3; g.qm_tile = nin / 256 - 1; g.qscale = C2;
                hipLaunchKernelGGL(nv::naive_gemm, dim3(g.N / 64, g.M / 64), dim3(256), 0, stream, g);
                if (l == 0) { nv::GArgs m{}; m.A = (const bf16*)(ws + WS_MEMN); m.Bt = (const bf16*)(ws + WS_WMKV); m.M = NMEM; m.N = 2048; m.K = DM; m.mode = 0; m.O = (bf16*)(ws + WS_MKV); m.ldc = 2048; m.ssq = nullptr; m.nq_tiles = 0; m.qm_tile = -1; m.qscale = 1.f;
                    hipLaunchKernelGGL(nv::naive_gemm, dim3(m.N / 64, m.M / 64), dim3(256), 0, stream, m); } }
            else if (k == 2) { g.A = (const bf16*)(ws + WS_Y); g.Bt = (const bf16*)(ws + WS_WOUT + (size_t)l * 2 * MiB); g.M = SEQ; g.N = DM; g.K = DM; g.mode = 1; g.ldc = DM; g.base = (l == 0) ? in[0] : (const float*)d_out; g.out = (float*)d_out; g.xb = (bf16*)(ws + WS_XB);
                hipLaunchKernelGGL(nv::naive_gemm, dim3(g.N / 64, g.M / 64), dim3(256), 0, stream, g);
                hipLaunchKernelGGL(nv::naive_ssq, dim3(SEQ / 256), dim3(256), 0, stream, (const float*)d_out, (float*)(ws + WS_SSQB)); }
            else if (k == 3) { g.A = (const bf16*)(ws + WS_XB); g.Bt = (const bf16*)(ws + WS_WGU + (size_t)l * 11 * MiB); g.M = SEQ; g.N = DFF; g.K = DM; g.mode = 2; g.O = (bf16*)(ws + WS_H); g.ldc = DFF; g.ssq = (const float*)(ws + WS_SSQB);
                hipLaunchKernelGGL(nv::naive_gemm, dim3(g.N / 64, g.M / 64), dim3(256), 0, stream, g); }
            else { g.A = (const bf16*)(ws + WS_H); g.Bt = (const bf16*)(ws + WS_WDN + (size_t)l * DFF * DM * 2); g.M = SEQ; g.N = DM; g.K = DFF; g.mode = 1; g.ldc = DM; g.base = (const float*)d_out; g.out = (float*)d_out; g.xb = (bf16*)(ws + WS_XB);
                hipLaunchKernelGGL(nv::naive_gemm, dim3(g.N / 64, g.M / 64), dim3(256), 0, stream, g);
                hipLaunchKernelGGL(nv::naive_ssq, dim3(SEQ / 256), dim3(256), 0, stream, (const float*)d_out, (float*)(ws + WS_SSQA)); }
            continue;
        }
        a.amask = 3;
        if (mid && k == 1) {
            const int pitch = (l & 1) ? WIN_B : WIN_A; const bf16* P = (const bf16*)(ws + WS_PROJ); const bf16* MKV = (const bf16*)(ws + WS_MKV) + l * 512; bf16* Y = (bf16*)(ws + WS_Y);
            if (MK_NAIVE & ((l & 1) ? 4 : 2)) { a.amask &= ~1;
                hipLaunchKernelGGL(nv::naive_attn, dim3(SEQ * NQH / 256), dim3(256), 0, stream, (l & 1), P, pitch, MKV, in[7] + (l >> 1) * NQH, in[9] + (size_t)(l >> 1) * NQH * 15 * 31, Y); }
            if (MK_NAIVE & 8) { a.amask &= ~2;
                hipLaunchKernelGGL(nv::naive_attn, dim3(SEQ * NMH / 256), dim3(256), 0, stream, 2, P, pitch, MKV, in[7], in[9], Y); }
            if (a.amask == 0) continue;
        }
#endif
        a.ph_lo = p; a.ph_hi = p + 1; a.li = p;
        hipLaunchKernelGGL(skel_fwd, dim3(grid), dim3(NWAVES * 64), LDS_BYTES, stream, a);
    }
#else
    a.ph_lo = 0; a.ph_hi = N_PHASES; a.li = 0;
    hipLaunchKernelGGL(skel_fwd, dim3(grid), dim3(NWAVES * 64), LDS_BYTES, stream, a);
#endif
    const hipError_t le = hipPeekAtLastError();
    if (le != hipSuccess) fprintf(stderr, "kernel_launch: launch failed: %s\n", hipGetErrorName(le));
}
```

```cpp
#define MK_PER_PHASE 0
#define MK_NAIVE 0
#include <hip/hip_runtime.h>
#include <cstdio>
#include <cstdint>
namespace pg8 {
#define PG8_LAS __attribute__((address_space(3)))
typedef unsigned short bf16_t;
typedef short bf16x8 __attribute__((ext_vector_type(8)));
typedef float f32x4 __attribute__((ext_vector_type(4)));
typedef unsigned u32x4 __attribute__((ext_vector_type(4)));
constexpr int BM = 256, BK = 64, HALF = 128, HTB = HALF * BK * 2  , STAGE_BYTES = 8 * HTB, NXCD = 8, WGM = 8;

__host__ __device__ __forceinline__ int lds_byte(int r, int c) { const int st = (r >> 4) * 2 + (c >> 5), rr = r & 15, cc = c & 31, ob = rr * 64 + cc * 2; return st * 1024 + (ob ^ (((ob >> 9) & 1) << 5)); }
__host__ __device__ __forceinline__ void stage_rc(int b, int& R, int& C) { const int st = b / 1024, sb = b % 1024, swz = sb ^ (((sb >> 9) & 1) << 5); R = (st >> 1) * 16 + swz / 64; C = (st & 1) * 32 + (swz % 64) / 2; }
__host__ __device__ __forceinline__ int perm32(int rho) { const int n = rho >> 4, i = rho & 15; return 8 * (i >> 2) + 4 * n + (i & 3); }

struct Unit { int pm, pn; };
struct Gemm { const bf16_t* A; const bf16_t* Bt; int M, N, K; };

struct StaticOrder {
    int nM, nN, nwg, G, c;
    __host__ __device__ void init(int M, int N, int G_, int c_) { nM = M / BM; nN = N / BM; nwg = nM * nN; G = G_; c = c_; }
    __host__ __device__ bool next(int i, Unit& u) const {
        const long L = (long)i * G + c; if (L >= nwg) return false;
        int wgid = (int)L; { const int q = nwg / NXCD, r = nwg % NXCD, xcd = wgid % NXCD, off = wgid / NXCD; wgid = (xcd < r ? xcd * (q + 1) : r * (q + 1) + (xcd - r) * q) + off; }
        const int nig = WGM * nN, gid = wgid / nig, fm = gid * WGM, gsz = (nM - fm) < WGM ? (nM - fm) : WGM;
        u.pm = fm + ((wgid % nig) % gsz); u.pn = (wgid % nig) / gsz; return true;
    }
    __device__ __forceinline__ void a_ready(const Unit&) const {}
    __device__ __forceinline__ void done(const Unit&) const {}
};

__device__ __forceinline__ unsigned cvt_pk_bf16(float lo, float hi) { unsigned r; asm volatile("v_cvt_pk_bf16_f32 %0, %1, %2" : "=v"(r) : "v"(lo), "v"(hi)); return r; }
typedef float f32x2 __attribute__((ext_vector_type(2)));
__device__ __forceinline__ float row_rstd(const float* ssq, int row) {
    const f32x4* p = (const f32x4*)(ssq + (size_t)row * 16);
    const f32x4 a = p[0], b = p[1], c = p[2], d = p[3];
    const float s = (((a[0] + a[1]) + (a[2] + a[3])) + ((b[0] + b[1]) + (b[2] + b[3]))) + (((c[0] + c[1]) + (c[2] + c[3])) + ((d[0] + d[1]) + (d[2] + d[3])));
    return __builtin_amdgcn_rsqf(s * (1.0f / 1024.0f) + 1e-6f);
}
struct EpiProj {
    static constexpr bool PERM = true, AFTER_DRAIN = false;
    bf16_t* O; int ldc; const float* ssq; int nq_tiles, qm_tile; float qscale;
    __device__ __forceinline__ void operator()(const f32x4 (&acc)[2][2][4][2], const Unit& u, int wr, int wc, int fr, int fq) const {
        const int row0 = u.pm * BM + wr * 64 + fr;
        const float sc = (u.pn < nq_tiles || u.pn == qm_tile) ? qscale : 1.f;
        const int col0 = u.pn * BM + wc * 32 + 8 * fq;
#pragma unroll
        for (int ai = 0; ai < 2; ++ai)
#pragma unroll
            for (int m = 0; m < 4; ++m) { const int row = row0 + ai * HALF + m * 16; const float rs = ssq ? row_rstd(ssq, row) * sc : sc;
                bf16_t* rowp = O + (size_t)row * ldc + col0;
#pragma unroll
                for (int bj = 0; bj < 2; ++bj) { const f32x4 v0 = acc[ai][bj][m][0] * rs, v1 = acc[ai][bj][m][1] * rs;
                    u32x4 w; w.x = cvt_pk_bf16(v0[0], v0[1]); w.y = cvt_pk_bf16(v0[2], v0[3]); w.z = cvt_pk_bf16(v1[0], v1[1]); w.w = cvt_pk_bf16(v1[2], v1[3]);
                    *(u32x4*)(rowp + bj * HALF) = w; } }
    }
};
struct EpiRes {
    static constexpr bool PERM = true, AFTER_DRAIN = false;
    const float* base; float* out; bf16_t* xb; float* ssq_out; int ldc;
    __device__ __forceinline__ void operator()(const f32x4 (&acc)[2][2][4][2], const Unit& u, int wr, int wc, int fr, int fq) const {
        const int row0 = u.pm * BM + wr * 64 + fr;
        const int col0 = u.pn * BM + wc * 32 + 8 * fq;
#pragma unroll
        for (int ai = 0; ai < 2; ++ai)
#pragma unroll
            for (int m = 0; m < 4; ++m) { const int row = row0 + ai * HALF + m * 16; const size_t off = (size_t)row * ldc + col0; float ss = 0.f;
#pragma unroll
                for (int bj = 0; bj < 2; ++bj) { const f32x4 b0 = *(const f32x4*)(base + off + bj * HALF), b1 = *(const f32x4*)(base + off + bj * HALF + 4);
                    const f32x4 v0 = b0 + acc[ai][bj][m][0], v1 = b1 + acc[ai][bj][m][1];
                    *(f32x4*)(out + off + bj * HALF) = v0; *(f32x4*)(out + off + bj * HALF + 4) = v1;
                    u32x4 w; w.x = cvt_pk_bf16(v0[0], v0[1]); w.y = cvt_pk_bf16(v0[2], v0[3]); w.z = cvt_pk_bf16(v1[0], v1[1]); w.w = cvt_pk_bf16(v1[2], v1[3]);
                    *(u32x4*)(xb + off + bj * HALF) = w;
                    ss += ((v0[0] * v0[0] + v0[1] * v0[1]) + (v0[2] * v0[2] + v0[3] * v0[3])) + ((v1[0] * v1[0] + v1[1] * v1[1]) + (v1[2] * v1[2] + v1[3] * v1[3])); }
                ss += __shfl_xor(ss, 16); ss += __shfl_xor(ss, 32);
                if (fq == 0) ssq_out[(size_t)row * 16 + u.pn * 4 + wc] = ss; }
    }
};
struct EpiGU {
    static constexpr bool PERM = true, AFTER_DRAIN = false;
    bf16_t* H; int ldh; const float* ssq;
    static __device__ __forceinline__ float swi(float g, float u) { return g * u * __builtin_amdgcn_rcpf(1.0f + __builtin_amdgcn_exp2f(-1.4426950408889634f * g)); }
    __device__ __forceinline__ void operator()(const f32x4 (&acc)[2][2][4][2], const Unit& u, int wr, int wc, int fr, int fq) const {
        const int row0 = u.pm * BM + wr * 64 + fr;
        const int col0 = u.pn * HALF + wc * 32 + 8 * fq;
#pragma unroll
        for (int ai = 0; ai < 2; ++ai)
#pragma unroll
            for (int m = 0; m < 4; ++m) { const int row = row0 + ai * HALF + m * 16; const float rs = row_rstd(ssq, row);
                const f32x4 g0 = acc[ai][0][m][0] * rs, g1 = acc[ai][0][m][1] * rs, u0 = acc[ai][1][m][0] * rs, u1 = acc[ai][1][m][1] * rs;
                u32x4 w; w.x = cvt_pk_bf16(swi(g0[0], u0[0]), swi(g0[1], u0[1])); w.y = cvt_pk_bf16(swi(g0[2], u0[2]), swi(g0[3], u0[3]));
                w.z = cvt_pk_bf16(swi(g1[0], u1[0]), swi(g1[1], u1[1])); w.w = cvt_pk_bf16(swi(g1[2], u1[2]), swi(g1[3], u1[3]));
                *(u32x4*)(H + (size_t)row * ldh + col0) = w; }
    }
};
template <class Epi, class Sched, bool ALIGN_EPI = false, bool SP2 = false>
__device__ __forceinline__ void gemm_phase(PG8_LAS unsigned char* lds, const Gemm g, const Sched& S, const Epi& E) {
    int tid_ = threadIdx.x; asm volatile("" : "+v"(tid_));
    const int tid = tid_, wid = __builtin_amdgcn_readfirstlane(tid >> 6), lane = tid & 63, wr = wid >> 2, wc = wid & 3, fr = lane & 15, fq = lane >> 4;
    const int K = g.K, nt = K / BK;
    unsigned voffA[2], voffB[2];
#pragma unroll
    for (int i = 0; i < 2; ++i) { int R, C; stage_rc(tid * 16 + i * 8192, R, C); const int Rb = Epi::PERM ? ((R & ~31) + perm32(R & 31)) : R;
        voffA[i] = (unsigned)(R * K + C) * 2u; voffB[i] = (unsigned)(Rb * K + C) * 2u; }
    const size_t kstep = (size_t)(BK * 2);
    const size_t hstep = (size_t)HALF * K * 2;
    const size_t tstep = 2 * hstep;
    const unsigned ldsw = (unsigned)wid * 1024u;
    const int aoff = lds_byte(wr * 64 + fr, fq * 8), boff = lds_byte(wc * 32 + fr, fq * 8);
#define PG8_SA(b, h) (((b) * 2 + (h)) * HTB)
#define PG8_SB(b, h) ((4 + (b) * 2 + (h)) * HTB)
#define PG8_STAGE(bufoff, gbase, voff) do { _Pragma("unroll") for (int _i = 0; _i < 2; ++_i) \
        __builtin_amdgcn_global_load_lds((const unsigned*)((const char*)(gbase) + (voff)[_i]), (PG8_LAS unsigned*)(lds + (bufoff) + ldsw + _i * 8192), 16, 0, 0); } while (0)
#define PG8_LDA(dst, b, h) do { _Pragma("unroll") for (int m = 0; m < 4; ++m) _Pragma("unroll") for (int k = 0; k < 2; ++k) dst[m][k] = *(const PG8_LAS bf16x8*)(lds + PG8_SA(b, h) + aoff + m * 2048 + k * 1024); } while (0)
#define PG8_LDB(dst, b, h) do { _Pragma("unroll") for (int n = 0; n < 2; ++n) _Pragma("unroll") for (int k = 0; k < 2; ++k) dst[n][k] = *(const PG8_LAS bf16x8*)(lds + PG8_SB(b, h) + boff + n * 2048 + k * 1024); } while (0)
#define PG8_MMA(ai, bj, At, Bt) do { __builtin_amdgcn_s_setprio(1); _Pragma("unroll") for (int m = 0; m < 4; ++m) _Pragma("unroll") for (int n = 0; n < 2; ++n) _Pragma("unroll") for (int k = 0; k < 2; ++k) \
        acc[ai][bj][m][n] = __builtin_amdgcn_mfma_f32_16x16x32_bf16(Bt[n][k], At[m][k], acc[ai][bj][m][n], 0, 0, 0); __builtin_amdgcn_s_setprio(0); } while (0)
#define PG8_WAIT_V(n) asm volatile("s_waitcnt vmcnt(" #n ")" ::: "memory")
#define PG8_WAIT_L(n) asm volatile("s_waitcnt lgkmcnt(" #n ")" ::: "memory")
#define PG8_BAR __builtin_amdgcn_s_barrier()
#define PG8_SCHED __builtin_amdgcn_sched_barrier(0)
    Unit cur, nxt; int ui = 0;
    if (!S.next(0, cur)) return;
    f32x4 acc[2][2][4][2];
#pragma unroll
    for (int a = 0; a < 2; ++a)
#pragma unroll
        for (int b = 0; b < 2; ++b)
#pragma unroll
            for (int m = 0; m < 4; ++m)
#pragma unroll
                for (int n = 0; n < 2; ++n) acc[a][b][m][n] = (f32x4){0.f, 0.f, 0.f, 0.f};
    bf16x8 At[4][2], B0[2][2], B1[2][2];
    const char* cA = (const char*)g.A + (size_t)cur.pm * tstep; const char* cB = (const char*)g.Bt + (size_t)cur.pn * tstep;
    S.a_ready(cur);
    if constexpr (SP2) {
        PG8_STAGE(PG8_SB(0, 0), cB, voffB); PG8_STAGE(PG8_SB(0, 1), cB + hstep, voffB); PG8_STAGE(PG8_SA(0, 0), cA, voffA); PG8_STAGE(PG8_SA(0, 1), cA + hstep, voffA);
        if (wr == 1) PG8_BAR;
        PG8_WAIT_V(2); PG8_BAR;
        PG8_STAGE(PG8_SB(1, 0), cB + kstep, voffB); PG8_STAGE(PG8_SA(1, 0), cA + kstep, voffA); PG8_STAGE(PG8_SB(1, 1), cB + hstep + kstep, voffB);
        PG8_WAIT_V(6); PG8_BAR;
    } else {
        PG8_STAGE(PG8_SB(0, 0), cB, voffB); PG8_STAGE(PG8_SA(0, 0), cA, voffA); PG8_STAGE(PG8_SB(0, 1), cB + hstep, voffB); PG8_STAGE(PG8_SA(0, 1), cA + hstep, voffA);
        if (wr == 1) PG8_BAR;
        PG8_WAIT_V(4); PG8_BAR;
        PG8_STAGE(PG8_SB(1, 0), cB + kstep, voffB); PG8_STAGE(PG8_SA(1, 0), cA + kstep, voffA); PG8_STAGE(PG8_SB(1, 1), cB + hstep + kstep, voffB);
        PG8_WAIT_V(6); PG8_BAR;
    }
    for (;;) {
        const bool has_next = S.next(ui + 1, nxt);
        const char* nA = has_next ? (const char*)g.A + (size_t)nxt.pm * tstep : cA; const char* nB = has_next ? (const char*)g.Bt + (size_t)nxt.pn * tstep : cB;
        for (int t = 0; t < nt; t += 2) {
            const bool last = (t == nt - 2);
            const char* a1 = cA + (size_t)(t + 1) * kstep;
            const char* a2 = last ? nA : cA + (size_t)(t + 2) * kstep; const char* b2 = last ? nB : cB + (size_t)(t + 2) * kstep;
            const char* a3 = a2 + kstep; const char* b3 = b2 + kstep;
            if (last && has_next) S.a_ready(nxt);
            if constexpr (SP2) {
            PG8_LDB(B0, 0, 0); PG8_LDB(B1, 0, 1); PG8_SCHED; PG8_LDA(At, 0, 0); PG8_STAGE(PG8_SA(1, 1), a1 + hstep, voffA);
            PG8_WAIT_V(8); PG8_WAIT_L(0); PG8_BAR; PG8_MMA(0, 0, At, B0); PG8_MMA(0, 1, At, B1); PG8_BAR; PG8_SCHED;
            PG8_LDA(At, 0, 1); PG8_STAGE(PG8_SB(0, 0), b2, voffB); PG8_STAGE(PG8_SB(0, 1), b2 + hstep, voffB); PG8_STAGE(PG8_SA(0, 0), a2, voffA);
            PG8_WAIT_V(8); PG8_WAIT_L(0); PG8_BAR; PG8_MMA(1, 0, At, B0); PG8_MMA(1, 1, At, B1); PG8_BAR; PG8_SCHED;
            PG8_LDB(B0, 1, 0); PG8_LDB(B1, 1, 1); PG8_SCHED; PG8_LDA(At, 1, 0); PG8_STAGE(PG8_SA(0, 1), a2 + hstep, voffA);
            PG8_WAIT_V(8); PG8_WAIT_L(0); PG8_BAR; PG8_MMA(0, 0, At, B0); PG8_MMA(0, 1, At, B1); PG8_BAR; PG8_SCHED;
            PG8_LDA(At, 1, 1); PG8_STAGE(PG8_SB(1, 0), b3, voffB); PG8_STAGE(PG8_SB(1, 1), b3 + hstep, voffB); PG8_STAGE(PG8_SA(1, 0), a3, voffA);
            PG8_WAIT_V(8); PG8_WAIT_L(0); PG8_BAR; PG8_MMA(1, 0, At, B0); PG8_MMA(1, 1, At, B1); PG8_BAR; PG8_SCHED;
            } else {
            PG8_LDB(B0, 0, 0); PG8_SCHED; PG8_LDA(At, 0, 0); PG8_STAGE(PG8_SA(1, 1), a1 + hstep, voffA);
            PG8_WAIT_L(8); PG8_BAR; PG8_WAIT_L(0); PG8_MMA(0, 0, At, B0); PG8_BAR; PG8_SCHED;
            PG8_LDB(B1, 0, 1); PG8_STAGE(PG8_SB(0, 0), b2, voffB);
            PG8_BAR; PG8_WAIT_L(0); PG8_MMA(0, 1, At, B1); PG8_BAR;
            PG8_LDA(At, 0, 1); PG8_STAGE(PG8_SA(0, 0), a2, voffA);
            PG8_BAR; PG8_WAIT_L(0); PG8_MMA(1, 0, At, B0); PG8_BAR; PG8_SCHED;
            PG8_STAGE(PG8_SB(0, 1), b2 + hstep, voffB);
            PG8_WAIT_V(6); PG8_BAR; PG8_MMA(1, 1, At, B1); PG8_BAR;
            PG8_LDB(B0, 1, 0); PG8_SCHED; PG8_LDA(At, 1, 0); PG8_STAGE(PG8_SA(0, 1), a2 + hstep, voffA);
            PG8_WAIT_L(8); PG8_BAR; PG8_WAIT_L(0); PG8_MMA(0, 0, At, B0); PG8_BAR; PG8_SCHED;
            PG8_LDB(B1, 1, 1); PG8_STAGE(PG8_SB(1, 0), b3, voffB);
            PG8_BAR; PG8_WAIT_L(0); PG8_MMA(0, 1, At, B1); PG8_BAR;
            PG8_LDA(At, 1, 1); PG8_STAGE(PG8_SA(1, 0), a3, voffA);
            PG8_BAR; PG8_WAIT_L(0); PG8_MMA(1, 0, At, B0); PG8_BAR; PG8_SCHED;
            PG8_STAGE(PG8_SB(1, 1), b3 + hstep, voffB);
            PG8_WAIT_V(6); PG8_BAR; PG8_MMA(1, 1, At, B1); PG8_BAR;
            }
        }
        if constexpr (ALIGN_EPI) { if (wr == 0) PG8_BAR; }
        if constexpr (!Epi::AFTER_DRAIN) { E(acc, cur, wr, wc, fr, fq); S.done(cur); }
        if (!has_next) break;
#pragma unroll
        for (int a = 0; a < 2; ++a)
#pragma unroll
            for (int b = 0; b < 2; ++b)
#pragma unroll
                for (int m = 0; m < 4; ++m)
#pragma unroll
                    for (int n = 0; n < 2; ++n) acc[a][b][m][n] = (f32x4){0.f, 0.f, 0.f, 0.f};
        cur = nxt; cA = nA; cB = nB; ++ui;
        if constexpr (ALIGN_EPI) { if (wr == 1) PG8_BAR; }
    }
    PG8_WAIT_V(0);
    if constexpr (!ALIGN_EPI) { if (wr == 0) PG8_BAR; }
    PG8_BAR;
    if constexpr (Epi::AFTER_DRAIN) { E.fused(acc, cur, wr, wc, fr, fq, lds, wid, lane); S.done(cur); }
#undef PG8_SA
#undef PG8_SB
#undef PG8_STAGE
#undef PG8_LDA
#undef PG8_LDB
#undef PG8_MMA
#undef PG8_WAIT_V
#undef PG8_WAIT_L
#undef PG8_BAR
#undef PG8_SCHED
}
}
namespace att {
typedef unsigned short bf16_t;
using bf16x8 = __attribute__((ext_vector_type(8))) short;
using s16x4 = __attribute__((ext_vector_type(4))) short;
using f32x16 = __attribute__((ext_vector_type(16))) float;
using u32x4 = __attribute__((ext_vector_type(4))) unsigned;
#define ATT_LAS __attribute__((address_space(3)))
constexpr int NW = 8, NSLOT = 3, SLOTB = 16384, VOFF = 8192;
constexpr int LDS_WS = NSLOT * SLOTB, LDS_OST = LDS_WS + NW * 256, LDS_TAB = LDS_OST + NW * 4096, TAB_PAD = 64, LDS_END = LDS_TAB + 4096;
constexpr float NEG_INF = -__builtin_inff();
__device__ __forceinline__ constexpr int crow(int r, int hi) { return (r & 3) + 8 * (r >> 2) + 4 * hi; }
__device__ __forceinline__ void glds16(const void* gsrc, unsigned lds_dst) { unsigned keep;
    asm volatile("s_mov_b32 %0, m0\n\ts_mov_b32 m0, %2\n\ts_nop 0\n\tglobal_load_lds_dwordx4 %1, off\n\ts_mov_b32 m0, %0" : "=&s"(keep) : "v"(gsrc), "s"(lds_dst) : "memory"); }
__device__ __forceinline__ float max3f(float a, float b, float c) { return __builtin_fmaxf(__builtin_fmaxf(a, b), c); }
typedef float f32x2_t __attribute__((ext_vector_type(2))); typedef __bf16 bf16x2_t __attribute__((ext_vector_type(2)));
__device__ __forceinline__ unsigned cvtpk_s(float lo, float hi) { f32x2_t v = {lo, hi}; bf16x2_t b = __builtin_convertvector(v, bf16x2_t); return __builtin_bit_cast(unsigned, b); }

__device__ __forceinline__ void qkt(f32x16& p0, f32x16& p1, const ATT_LAS char* kp, const bf16x8* qr) {
    const f32x16 z = f32x16{};
#pragma unroll
    for (int d0 = 0; d0 < 4; ++d0) {
        const bf16x8 b0 = *(const ATT_LAS bf16x8*)(kp + d0 * 2048);
        const bf16x8 b1 = *(const ATT_LAS bf16x8*)(kp + d0 * 2048 + 512);
        if (d0 == 0) { p0 = __builtin_amdgcn_mfma_f32_32x32x16_bf16(b0, qr[0], z, 0, 0, 0); p1 = __builtin_amdgcn_mfma_f32_32x32x16_bf16(b1, qr[0], z, 0, 0, 0); }
        else { p0 = __builtin_amdgcn_mfma_f32_32x32x16_bf16(b0, qr[d0], p0, 0, 0, 0); p1 = __builtin_amdgcn_mfma_f32_32x32x16_bf16(b1, qr[d0], p1, 0, 0, 0); } }
}
__device__ __forceinline__ float rowmax(const f32x16& p0, const f32x16& p1) {
    float a = max3f(p0[0], p0[1], p1[0]), b = max3f(p0[2], p0[3], p1[1]); a = max3f(a, p1[2], p1[3]);
#pragma unroll
    for (int r = 4; r < 16; r += 4) { a = max3f(a, p0[r], p0[r + 1]); b = max3f(b, p0[r + 2], p0[r + 3]); a = max3f(a, p1[r], p1[r + 1]); b = max3f(b, p1[r + 2], p1[r + 3]); }
    const float m = __builtin_fmaxf(a, b);
    auto rr = __builtin_amdgcn_permlane32_swap(__float_as_uint(m), __float_as_uint(m), false, false);
    return __builtin_fmaxf(__uint_as_float(rr[0]), __uint_as_float(rr[1]));
}
__device__ __forceinline__ void pv(f32x16* o, int vb, bf16x8 pa0, bf16x8 pa1, bf16x8 pa2, bf16x8 pa3) {
#pragma unroll
    for (int d0 = 0; d0 < 2; ++d0) { s16x4 lo[4], hi[4];
#pragma unroll
        for (int ks = 0; ks < 4; ++ks) {
            asm volatile("ds_read_b64_tr_b16 %0,%1 offset:%c2" : "=&v"(lo[ks]) : "v"(vb), "i"(d0 * 4096 + ks * 1024) : "memory");
            asm volatile("ds_read_b64_tr_b16 %0,%1 offset:%c2" : "=&v"(hi[ks]) : "v"(vb), "i"(d0 * 4096 + ks * 1024 + 512) : "memory"); }
        asm volatile("s_waitcnt lgkmcnt(0)" ::: "memory"); __builtin_amdgcn_sched_barrier(0);
#define ATT_PK(k) (bf16x8){lo[k][0], lo[k][1], lo[k][2], lo[k][3], hi[k][0], hi[k][1], hi[k][2], hi[k][3]}
        o[d0] = __builtin_amdgcn_mfma_f32_32x32x16_bf16(pa0, ATT_PK(0), o[d0], 0, 0, 0);
        o[d0] = __builtin_amdgcn_mfma_f32_32x32x16_bf16(pa1, ATT_PK(1), o[d0], 0, 0, 0);
        o[d0] = __builtin_amdgcn_mfma_f32_32x32x16_bf16(pa2, ATT_PK(2), o[d0], 0, 0, 0);
        o[d0] = __builtin_amdgcn_mfma_f32_32x32x16_bf16(pa3, ATT_PK(3), o[d0], 0, 0, 0);
#undef ATT_PK
    }
}

struct UnitP {
    const bf16_t* Q; int qpitch;
    const bf16_t* K; const bf16_t* V; int kvpitch, kvmax;
    int row0, ntiles;
    bf16_t* O; int opitch;
    int tok0;
    float slope2, m0, l0;
    const float* rpb;
    int seqlen;
};
#define ATT_SOFTMAX_PV(ACT) do { \
    float a_ = NEG_INF, b_ = NEG_INF; \
    _Pragma("unroll") for (int r = 0; r < 16; r += 2) { if (ACT(0, r)) a_ = max3f(a_, p0[r], p0[r + 1]); if (ACT(1, r)) b_ = max3f(b_, p1[r], p1[r + 1]); } \
    float rm = __builtin_fmaxf(a_, b_); \
    { auto rr = __builtin_amdgcn_permlane32_swap(__float_as_uint(rm), __float_as_uint(rm), false, false); rm = __builtin_fmaxf(__uint_as_float(rr[0]), __uint_as_float(rr[1])); } \
    const float mn = __builtin_fmaxf(m, rm); \
    if (__any(mn > m)) { \
        const float alpha = __builtin_amdgcn_exp2f(m - mn); l *= alpha; \
        if (hi == 0) wsf[r32] = alpha; \
        asm volatile("s_waitcnt lgkmcnt(0)" ::: "memory"); \
        _Pragma("unroll") for (int r = 0; r < 16; ++r) { const float f = wsf[crow(r, hi)]; o[0][r] *= f; o[1][r] *= f; } \
        asm volatile("" ::: "memory"); \
    } \
    m = mn; \
    float sacc = 0.f; \
    _Pragma("unroll") for (int r = 0; r < 16; ++r) { \
        if (ACT(0, r)) { p0[r] = __builtin_amdgcn_exp2f(p0[r] - m); sacc += p0[r]; } else p0[r] = 0.f; \
        if (ACT(1, r)) { p1[r] = __builtin_amdgcn_exp2f(p1[r] - m); sacc += p1[r]; } else p1[r] = 0.f; } \
    l += sacc; \
    u32x4 pw0, pw1, pw2, pw3; \
    pw0 = (u32x4){cvtpk_s(p0[0], p0[1]), cvtpk_s(p0[2], p0[3]), cvtpk_s(p0[4], p0[5]), cvtpk_s(p0[6], p0[7])}; \
    pw1 = (u32x4){cvtpk_s(p0[8], p0[9]), cvtpk_s(p0[10], p0[11]), cvtpk_s(p0[12], p0[13]), cvtpk_s(p0[14], p0[15])}; \
    pw2 = (u32x4){cvtpk_s(p1[0], p1[1]), cvtpk_s(p1[2], p1[3]), cvtpk_s(p1[4], p1[5]), cvtpk_s(p1[6], p1[7])}; \
    pw3 = (u32x4){cvtpk_s(p1[8], p1[9]), cvtpk_s(p1[10], p1[11]), cvtpk_s(p1[12], p1[13]), cvtpk_s(p1[14], p1[15])}; \
    __builtin_amdgcn_sched_barrier(0); \
    pv(o, vb0 + slot * SLOTB, __builtin_bit_cast(bf16x8, pw0), __builtin_bit_cast(bf16x8, pw1), __builtin_bit_cast(bf16x8, pw2), __builtin_bit_cast(bf16x8, pw3)); \
} while (0)
#define ATT_ACT_ALL(half, r) true
#define ATT_ACT_C0(half, r) ((half) == 0 || (r) < 4)
#define ATT_ACT_C1(half, r) ((half) == 1 || (r) >= 12)

template <int TYPE>
__device__ __forceinline__ void attn_unit(const UnitP& U, ATT_LAS unsigned char* lds) {
    int tid_ = threadIdx.x; asm volatile("" : "+v"(tid_));
    const int tid = tid_, lane = tid & 63, r32 = lane & 31, hi = lane >> 5; const int wid = __builtin_amdgcn_readfirstlane(tid >> 6);
    const unsigned lds0 = (unsigned)(uintptr_t)lds;
    const ATT_LAS char* shm3 = (const ATT_LAS char*)lds;
    ATT_LAS float* wsf = (ATT_LAS float*)(lds + LDS_WS) + wid * 64;
    ATT_LAS float* tab = (ATT_LAS float*)(lds + LDS_TAB);
    if (TYPE == 1) { for (int i = tid; i < 15 * 31; i += NW * 64) tab[TAB_PAD + i] = U.rpb[i] * 1.4426950408889634f; }
    const int NT = U.ntiles;
    const int krow = lane, vrow = 16 * (wid & 3) + (lane >> 2);
    const bf16_t* kcol = U.K + wid * 8; const bf16_t* vcol = U.V + (wid >> 2) * 32 + (lane & 3) * 8;
    const unsigned kdst = lds0 + wid * 1024, vdst = lds0 + VOFF + wid * 1024;
#define ATT_CLAMP(r) ((r) < 0 ? 0 : ((r) > U.kvmax ? U.kvmax : (r)))
#define ATT_DMA(t, slot) do { const int rb_ = U.row0 + 64 * (t); const int kr_ = ATT_CLAMP(rb_ + krow), vr_ = ATT_CLAMP(rb_ + vrow); \
        glds16(kcol + (size_t)kr_ * U.kvpitch, (unsigned)__builtin_amdgcn_readfirstlane(kdst + (slot) * SLOTB)); \
        glds16(vcol + (size_t)vr_ * U.kvpitch, (unsigned)__builtin_amdgcn_readfirstlane(vdst + (slot) * SLOTB)); } while (0)
    bf16x8 qr[4];
    { const bf16_t* Qw = U.Q + (size_t)(wid * 32 + r32) * U.qpitch + hi * 8;
#pragma unroll
      for (int d0 = 0; d0 < 4; ++d0) qr[d0] = *(const bf16x8*)(Qw + d0 * 16); }
    ATT_DMA(0, 0); ATT_DMA(1, 1);
    asm volatile("" : "+v"(qr[0]), "+v"(qr[1]), "+v"(qr[2]), "+v"(qr[3]));
    float m = U.m0, l = (hi == 0) ? U.l0 : 0.f;
    f32x16 o[2]; o[0] = f32x16{}; o[1] = f32x16{};
    const int vb0 = (int)(lds0 + VOFF) + ((lane >> 4) & 1) * 32 + (lane & 3) * 8 + (4 * hi + ((lane & 15) >> 2)) * 64;
    const ATT_LAS char* kp0 = shm3 + hi * 1024 + r32 * 16;
    int t_lo, t_hi;
    if (TYPE == 0) { t_lo = wid >> 1; t_hi = t_lo + 4; }
    else if (TYPE == 1) { const int r = U.tok0 + (wid >> 1); int rs = r - 4; rs = rs < 0 ? 0 : (rs > 248 ? 248 : rs); const int T0 = U.row0 >> 6; t_lo = rs - T0; t_hi = t_lo + 7; }
    else { t_lo = 0; t_hi = NT - 1; }
    int slot = 0;
    for (int t = 0; t < NT; ++t) {
        if (t + 1 < NT) asm volatile("s_waitcnt vmcnt(2) lgkmcnt(0)\n\ts_barrier" ::: "memory");
        else asm volatile("s_waitcnt vmcnt(0) lgkmcnt(0)\n\ts_barrier" ::: "memory");
        const int nslot = (slot == NSLOT - 1) ? 0 : slot + 1, pslot = (slot == 0) ? NSLOT - 1 : slot - 1;
        if (t + 2 < NT) ATT_DMA(t + 2, pslot);
        bool rel = (t >= t_lo) && (t <= t_hi);
        if (TYPE == 0) { const int rb = U.row0 + 64 * t; rel = rel && (rb >= 0) && (rb < U.seqlen); }
        if (rel) {
            f32x16 p0, p1;
            qkt(p0, p1, kp0 + slot * SLOTB, qr);
            if (TYPE == 0) {
                const float dqf = (float)((U.tok0 + wid * 32 + r32) - (U.row0 + 64 * t + 4 * hi));
                if (t == t_lo || t == t_hi) {
#pragma unroll
                    for (int r = 0; r < 16; ++r) { const float cr = (float)((r & 3) + 8 * (r >> 2)); const float a0 = __builtin_fabsf(dqf - cr), a1 = __builtin_fabsf(dqf - (cr + 32.f));
                        p0[r] = (a0 <= 128.f) ? __builtin_fmaf(-U.slope2, a0, p0[r]) : NEG_INF; p1[r] = (a1 <= 128.f) ? __builtin_fmaf(-U.slope2, a1, p1[r]) : NEG_INF; }
                } else {
#pragma unroll
                    for (int r = 0; r < 16; ++r) { const float cr = (float)((r & 3) + 8 * (r >> 2)); const float a0 = __builtin_fabsf(dqf - cr), a1 = __builtin_fabsf(dqf - (cr + 32.f));
                        p0[r] = __builtin_fmaf(-U.slope2, a0, p0[r]); p1[r] = __builtin_fmaf(-U.slope2, a1, p1[r]); }
                }
                ATT_SOFTMAX_PV(ATT_ACT_ALL);
            } else if (TYPE == 1) {
                const int rq = U.tok0 + (wid >> 1), c = 32 * (wid & 1) + r32; int cs = c - 8; cs = cs < 0 ? 0 : (cs > 48 ? 48 : cs);
                const int kr = (U.row0 >> 6) + t;
                const ATT_LAS float* tb = tab + TAB_PAD + (kr - rq + 7) * 31 + 15 - c + 4 * hi;
                const int kc = 4 * hi - cs;
#define ATT_BIAS_B(ACT) do { _Pragma("unroll") for (int r = 0; r < 16; ++r) { const int cr = (r & 3) + 8 * (r >> 2); \
                    if (ACT(0, r)) { float b0 = tb[cr]; asm volatile("" : "+v"(b0)); p0[r] = ((unsigned)(kc + cr) < 16u) ? p0[r] + b0 : NEG_INF; } \
                    if (ACT(1, r)) { float b1 = tb[cr + 32]; asm volatile("" : "+v"(b1)); p1[r] = ((unsigned)(kc + cr + 32) < 16u) ? p1[r] + b1 : NEG_INF; } } } while (0)
                if ((wid & 1) == 0) { ATT_BIAS_B(ATT_ACT_C0); ATT_SOFTMAX_PV(ATT_ACT_C0); }
                else { ATT_BIAS_B(ATT_ACT_C1); ATT_SOFTMAX_PV(ATT_ACT_C1); }
#undef ATT_BIAS_B
            } else {
                ATT_SOFTMAX_PV(ATT_ACT_ALL);
            }
        }
        slot = nslot;
    }
    { auto rr = __builtin_amdgcn_permlane32_swap(__float_as_uint(l), __float_as_uint(l), false, false); l = __uint_as_float(rr[0]) + __uint_as_float(rr[1]); }
    asm volatile("" ::: "memory");
    if (hi == 0) wsf[32 + r32] = l;
    asm volatile("s_waitcnt lgkmcnt(0)" ::: "memory");
    float rli[16];
#pragma unroll
    for (int r = 0; r < 16; ++r) rli[r] = __builtin_amdgcn_rcpf(wsf[32 + crow(r, hi)]);
    { ATT_LAS bf16_t* stg = (ATT_LAS bf16_t*)(lds + LDS_OST) + wid * 2048;
#pragma unroll
      for (int r = 0; r < 16; ++r) { const int orow = crow(r, hi);
#pragma unroll
          for (int d0 = 0; d0 < 2; ++d0) { const unsigned pk = cvtpk_s(o[d0][r] * rli[r], 0.f); stg[orow * 64 + d0 * 32 + r32] = (bf16_t)(pk & 0xffffu); } }
      asm volatile("s_waitcnt lgkmcnt(0)" ::: "memory");
      bf16_t* Ow = U.O + (size_t)(wid * 32) * U.opitch;
#pragma unroll
      for (int i = 0; i < 4; ++i) { const int row = i * 8 + (lane >> 3), ch = lane & 7; const u32x4 v = *(const ATT_LAS u32x4*)(stg + row * 64 + ch * 8); *(u32x4*)(Ow + (size_t)row * U.opitch + ch * 8) = v; } }
    asm volatile("s_waitcnt vmcnt(0) lgkmcnt(0)\n\ts_barrier" ::: "memory");
#undef ATT_DMA
#undef ATT_CLAMP
}
}
constexpr int NWAVES = 8;
constexpr int SEQ = 16384, DM = 1024, DEPTH = 4, NQH = 12, NMH = 4, NMEM = 256, WIN_A = 1536, WIN_B = 2560, DFF = 2816, NGU = 2 * DFF;
constexpr float LOG2E = 1.4426950408889634f, C2 = 0.125f * LOG2E;
constexpr int N_PHASES = 2 + 5 * DEPTH;
#ifndef MK_PER_PHASE
#define MK_PER_PHASE 0
#endif
#ifndef MK_DUP
#define MK_DUP 0
#endif
#ifndef MK_NAIVE
#define MK_NAIVE 0
#endif

constexpr size_t MiB = 1u << 20;
constexpr size_t WS_CTL = 0, CTL_ZERO_BYTES = 1 * MiB;
constexpr size_t WS_SSQA = 1 * MiB, WS_SSQB = 2 * MiB;
constexpr size_t WS_MEMN = 3 * MiB;
constexpr size_t WS_MKV = 4 * MiB;
constexpr size_t WS_WIN = 6 * MiB;
constexpr size_t WS_WOUT = WS_WIN + 16 * MiB, WS_WGU = WS_WOUT + 8 * MiB, WS_WDN = WS_WGU + 44 * MiB, WS_WMKV = WS_WDN + 22 * MiB;
constexpr size_t WS_XB = WS_WMKV + 4 * MiB;
constexpr size_t WS_PROJ = WS_XB + 32 * MiB;
constexpr size_t WS_Y = WS_PROJ + 80 * MiB;
constexpr size_t WS_H = WS_PROJ;
constexpr size_t WS_END = WS_Y + 32 * MiB;
static_assert(WS_END <= 256 * MiB, "d_ws map");
__host__ __device__ constexpr size_t win_off(int l) { return (size_t)((l >> 1) * 8 + (l & 1) * 3) * MiB; }
constexpr int CW_BAR = 4096;

constexpr int RING_OFF = 0, RING_BYTES = 131072, LDSCTL_OFF = RING_BYTES, MISC_OFF = LDSCTL_OFF + 320, LDS_BYTES = 147456;
static_assert(att::LDS_END <= RING_BYTES, "attention scratch inside the ring region");

#define GAS __attribute__((address_space(1)))
#define LAS __attribute__((address_space(3)))
typedef unsigned short bf16;
typedef unsigned v4u __attribute__((ext_vector_type(4)));
typedef float f32x4 __attribute__((ext_vector_type(4)));
typedef short bf16x8 __attribute__((ext_vector_type(8)));
typedef GAS unsigned gu32;
typedef GAS unsigned long long gu64;
#define RLX_AGENT __ATOMIC_RELAXED, __HIP_MEMORY_SCOPE_AGENT
#define LDS_WAIT() asm volatile("s_waitcnt lgkmcnt(0)" ::: "memory")
#define VM_WAIT() asm volatile("s_waitcnt vmcnt(0)" ::: "memory")
__device__ __forceinline__ unsigned long long rt() { return __builtin_amdgcn_s_memrealtime(); }
__device__ __forceinline__ unsigned f2bf(float f) { unsigned u = __builtin_bit_cast(unsigned, f); return (u + 0x7fffu + ((u >> 16) & 1u)) >> 16; }
__device__ __forceinline__ unsigned pk2(float lo, float hi) { return f2bf(lo) | (f2bf(hi) << 16); }

#define XB_TMO      128
#define XB_XCNT(j)  (256  + 64 * (j))
#define XB_XSUB(j)  (1280 + 64 * (j))
#define XB_XGEN(j)  (2304 + 64 * (j))
#define XB_TOP      3328
#define XB_TOPGEN   3392
#define XCD_BAR_WORDS 3456
#define XB_SPIN_CAP (1u << 18)

__device__ __forceinline__ unsigned xb_ld(unsigned* p)              { return __hip_atomic_load(p, __ATOMIC_RELAXED, __HIP_MEMORY_SCOPE_AGENT); }
__device__ __forceinline__ unsigned xb_add(unsigned* p, unsigned v) { return __hip_atomic_fetch_add(p, v, __ATOMIC_RELAXED, __HIP_MEMORY_SCOPE_AGENT); }
__device__ __forceinline__ unsigned xb_xcc_id() { return (unsigned)__builtin_amdgcn_s_getreg((3 << 11) | 20) & 0xFu; }
#define XB_SPIN(cond, bar) do { unsigned _sp = 0; while (cond) { __builtin_amdgcn_s_sleep(1); \
    if ((++_sp & 255u) == 0u) { if (xb_ld(&(bar)[XB_TMO])) break; if (_sp > XB_SPIN_CAP) { atomicAdd(&(bar)[XB_TMO], 1u); break; } } } } while (0)

struct XcdBarrier {
    unsigned* bar; unsigned x;
    volatile LAS unsigned* st;
};

__device__ __forceinline__ XcdBarrier xcd_barrier_post(unsigned* bar, volatile LAS unsigned* st) {
    XcdBarrier b; b.bar = bar; b.x = xb_xcc_id(); b.st = st;
    if (threadIdx.x == 0) (void)xb_add(&bar[XB_XCNT(b.x)], 1u);
    return b;
}
__device__ __forceinline__ void xcd_barrier_complete(unsigned* bar, unsigned x, unsigned& nloc, unsigned& nx) {
    const unsigned G = gridDim.x * gridDim.y * gridDim.z;
    unsigned sum, cnt, mine, sp = 0u;
    for (;;) {
        sum = 0u; cnt = 0u; mine = 0u;
#pragma unroll
        for (unsigned j = 0; j < 16; ++j) { const unsigned c = xb_ld(&bar[XB_XCNT(j)]); sum += c; cnt += (c > 0u) ? 1u : 0u; mine = (j == x) ? c : mine; }
        if (sum == G) break;
        __builtin_amdgcn_s_sleep(1);
        if ((++sp & 255u) == 0u) { if (xb_ld(&bar[XB_TMO])) break; if (sp > XB_SPIN_CAP) { atomicAdd(&bar[XB_TMO], 1u); break; } }
    }
    nloc = mine > 0u ? mine : 1u; nx = cnt > 0u ? cnt : 1u;
}

__device__ __forceinline__ void xcd_barrier(const XcdBarrier& b) {
    asm volatile("s_waitcnt vmcnt(0)" ::: "memory");
    __syncthreads();
    if (threadIdx.x == 0) {
        unsigned* bar = b.bar;
        __builtin_amdgcn_s_waitcnt(0);
        unsigned nloc = b.st[0], nx = b.st[1];
        if (nloc == 0u) { xcd_barrier_complete(bar, b.x, nloc, nx); b.st[0] = nloc; b.st[1] = nx; }
        const unsigned old = xb_add(&bar[XB_XSUB(b.x)], 1u);
        const unsigned gen = old / nloc;
        if (old + 1u == (gen + 1u) * nloc) {
            __builtin_amdgcn_fence(__ATOMIC_RELEASE, "agent");
            asm volatile("s_waitcnt vmcnt(0)" ::: "memory");
            const unsigned og = xb_add(&bar[XB_TOP], 1u);
            const unsigned tg = og / nx;
            if (og + 1u == (tg + 1u) * nx) xb_add(&bar[XB_TOPGEN], 1u);
            else XB_SPIN(xb_ld(&bar[XB_TOPGEN]) == tg, bar);
            __builtin_amdgcn_fence(__ATOMIC_ACQUIRE, "agent");
            xb_add(&bar[XB_XGEN(b.x)], 1u);
            asm volatile("s_waitcnt vmcnt(0)" ::: "memory");
        } else {
            XB_SPIN(xb_ld(&bar[XB_XGEN(b.x)]) == gen, bar);
            __builtin_amdgcn_fence(__ATOMIC_ACQUIRE, "agent");
            asm volatile("s_waitcnt vmcnt(0)" ::: "memory");
        }
    }
    __syncthreads();
}
struct Frame {
    LAS unsigned char* lds;
    volatile LAS unsigned* MISC;
    gu32* ctl;
    int tid, lane, wave;
    int vcu, G;
    const float *x, *mem, *norm_mix, *norm_ffn, *norm_mem, *norm_final, *w_in_a, *sink_a, *w_in_b, *rpb_b, *w_mem_kv, *w_out, *w_gate_up, *w_down;
    float* out; unsigned char* ws;
};
__device__ __forceinline__ float wave_sum(float v) {
#pragma unroll
    for (int o = 1; o < 64; o <<= 1) v += __shfl_xor(v, o);
    return v;
}
__device__ __forceinline__ void transpose_item(const float* W, int K, int N, bf16* WT, int mode, const float* g, LAS float* scr, int item, int lane) {
    const int nblk = N / 32, kb = item / nblk, nb = item % nblk, k0 = 64 * kb, n0 = 32 * nb;
    const float gl = g ? g[k0 + lane] : 1.f;
    const float* wp = W + (size_t)(k0 + (lane >> 5)) * N + n0 + (lane & 31);
    float wv[32];
#pragma unroll
    for (int i = 0; i < 32; ++i) wv[i] = wp[(size_t)(2 * i) * N];
#pragma unroll
    for (int i = 0; i < 32; ++i) { const float g0 = __uint_as_float(__builtin_amdgcn_readlane(__float_as_uint(gl), 2 * i)), g1 = __uint_as_float(__builtin_amdgcn_readlane(__float_as_uint(gl), 2 * i + 1));
        scr[(2 * i + (lane >> 5)) * 33 + (lane & 31)] = wv[i] * ((lane >> 5) ? g1 : g0); }
    LDS_WAIT(); asm volatile("" ::: "memory");
    int rbase = n0;
    if (mode == 1) { rbase = (n0 < DFF) ? ((n0 / 128) * 256 + (n0 % 128)) : (((n0 - DFF) / 128) * 256 + 128 + ((n0 - DFF) % 128)); }
    const int c = lane & 7;
#pragma unroll
    for (int j = 0; j < 4; ++j) { const int n = (lane >> 3) + 8 * j; const LAS float* s = scr + (8 * c) * 33 + n;
        v4u o; o.x = pk2(s[0 * 33], s[1 * 33]); o.y = pk2(s[2 * 33], s[3 * 33]); o.z = pk2(s[4 * 33], s[5 * 33]); o.w = pk2(s[6 * 33], s[7 * 33]);
        *(GAS v4u*)(WT + (size_t)(rbase + n) * K + k0 + 8 * c) = o; }
    LDS_WAIT(); asm volatile("" ::: "memory");
}
__device__ __forceinline__ int items_in(int l) { return 16 * (((l & 1) ? WIN_B : WIN_A) / 32); }
constexpr int IT_OUT = 16 * 32, IT_GU = 16 * (NGU / 32), IT_DN = (DFF / 64) * 32, IT_MKV = 16 * 16;
__device__ __forceinline__ void p0_prologue(Frame& F) {
    LAS float* scr = (LAS float*)(F.lds + RING_OFF + F.wave * 16384);
    const int gw = F.vcu * NWAVES + F.wave, NGW = F.G * NWAVES;
    const int per_a = 16 * (WIN_A / 32) + IT_OUT + IT_GU + IT_DN + IT_MKV, per_b = 16 * (WIN_B / 32) + IT_OUT + IT_GU + IT_DN + IT_MKV;
    const int NITEMS = 2 * (per_a + per_b);
    for (int it = gw; it < NITEMS; it += NGW) {
        int r = it, l = 0;
        { const int pair = per_a + per_b; l = 2 * (r / pair); r = r % pair; if (r >= per_a) { r -= per_a; l += 1; } }
        const int nin = (l & 1) ? WIN_B : WIN_A, iin = 16 * (nin / 32);
        if (r < iin) { const float* W = (l & 1) ? F.w_in_b + (size_t)(l >> 1) * DM * WIN_B : F.w_in_a + (size_t)(l >> 1) * DM * WIN_A;
            transpose_item(W, DM, nin, (bf16*)(F.ws + WS_WIN + win_off(l)), 0, F.norm_mix + l * DM, scr, r, F.lane); continue; } r -= iin;
        if (r < IT_OUT) { transpose_item(F.w_out + (size_t)l * DM * DM, DM, DM, (bf16*)(F.ws + WS_WOUT + (size_t)l * 2 * MiB), 0, nullptr, scr, r, F.lane); continue; } r -= IT_OUT;
        if (r < IT_GU) { transpose_item(F.w_gate_up + (size_t)l * DM * NGU, DM, NGU, (bf16*)(F.ws + WS_WGU + (size_t)l * 11 * MiB), 1, F.norm_ffn + l * DM, scr, r, F.lane); continue; } r -= IT_GU;
        if (r < IT_DN) { transpose_item(F.w_down + (size_t)l * DFF * DM, DFF, DM, (bf16*)(F.ws + WS_WDN + (size_t)l * DFF * DM * 2), 0, nullptr, scr, r, F.lane); continue; } r -= IT_DN;
        transpose_item(F.w_mem_kv + (size_t)l * DM * 512, DM, 512, (bf16*)(F.ws + WS_WMKV + (size_t)l * MiB), 0, nullptr, scr, r, F.lane);
    }
    for (int m = gw; m < SEQ; m += NGW) {
        const GAS f32x4* xr = (const GAS f32x4*)(F.x + (size_t)m * DM) + F.lane; f32x4 v[4]; float s = 0.f;
#pragma unroll
        for (int j = 0; j < 4; ++j) { v[j] = xr[64 * j]; s += (v[j].x * v[j].x + v[j].y * v[j].y) + (v[j].z * v[j].z + v[j].w * v[j].w); }
        s = wave_sum(s);
        GAS unsigned long long* o8 = (GAS unsigned long long*)(F.ws + WS_XB + (size_t)m * DM * 2) + F.lane;
#pragma unroll
        for (int j = 0; j < 4; ++j) o8[64 * j] = (unsigned long long)pk2(v[j].x, v[j].y) | ((unsigned long long)pk2(v[j].z, v[j].w) << 32);
        if (F.lane < 16) ((GAS float*)(F.ws + WS_SSQA))[(size_t)m * 16 + F.lane] = (F.lane == 0) ? s : 0.f;
    }
    for (int m = gw; m < NMEM; m += NGW) {
        const GAS f32x4* xr = (const GAS f32x4*)(F.mem + (size_t)m * DM) + F.lane; const GAS f32x4* gr = (const GAS f32x4*)F.norm_mem + F.lane; f32x4 v[4]; float s = 0.f;
#pragma unroll
        for (int j = 0; j < 4; ++j) { v[j] = xr[64 * j]; s += (v[j].x * v[j].x + v[j].y * v[j].y) + (v[j].z * v[j].z + v[j].w * v[j].w); }
        const float rstd = 1.0f / sqrtf(wave_sum(s) * (1.0f / DM) + 1e-6f);
        GAS unsigned long long* o8 = (GAS unsigned long long*)(F.ws + WS_MEMN + (size_t)m * DM * 2) + F.lane;
#pragma unroll
        for (int j = 0; j < 4; ++j) { const f32x4 g = gr[64 * j]; const f32x4 y = v[j] * rstd * g; o8[64 * j] = (unsigned long long)pk2(y.x, y.y) | ((unsigned long long)pk2(y.z, y.w) << 32); }
    }
}
__device__ __forceinline__ void final_norm(Frame& F) {
    const int gw = F.vcu * NWAVES + F.wave, NGW = F.G * NWAVES;
    const GAS f32x4* gr = (const GAS f32x4*)F.norm_final + F.lane;
    for (int m = gw; m < SEQ; m += NGW) {
        GAS f32x4* xr = (GAS f32x4*)(F.out + (size_t)m * DM) + F.lane;
        const float rstd = pg8::row_rstd((const float*)(F.ws + WS_SSQA), m);
#pragma unroll
        for (int j = 0; j < 4; ++j) { const f32x4 v = xr[64 * j], g = gr[64 * j]; xr[64 * j] = v * rstd * g; }
    }
}
__device__ __forceinline__ void attn_phase(Frame& F, int l, int amask) {
    const bool isA = (l & 1) == 0; const int pitch = isA ? WIN_A : WIN_B;
    const att::bf16_t* P = (const att::bf16_t*)(F.ws + WS_PROJ); att::bf16_t* Y = (att::bf16_t*)(F.ws + WS_Y);
    const att::bf16_t* MKV = (const att::bf16_t*)(F.ws + WS_MKV) + l * 512;
    for (int u = F.vcu; u < 1024; u += F.G) {
        att::UnitP U; U.seqlen = SEQ; U.rpb = nullptr; U.slope2 = 0.f; U.m0 = -1e30f; U.l0 = 0.f;
        if (u < 768) {
            if (!(amask & 1)) continue;
            const int h = u % NQH, blk = u / NQH, tok0 = blk * 256;
            U.Q = P + (size_t)tok0 * pitch + h * 64; U.qpitch = pitch; U.O = Y + (size_t)tok0 * DM + h * 64; U.opitch = DM; U.kvpitch = pitch; U.kvmax = SEQ - 1;
            if (isA) {
                U.K = P + 768 + (h / 3) * 64; U.V = P + 1024 + (h / 3) * 64; U.row0 = tok0 - 128; U.ntiles = 8; U.tok0 = tok0;
                U.slope2 = exp2f(-8.0f * (float)(h + 1) / 12.0f) * LOG2E; U.m0 = F.sink_a[(l >> 1) * NQH + h] * LOG2E; U.l0 = 1.f;
                att::attn_unit<0>(U, F.lds + RING_OFF);
            } else {
                const int R0 = blk * 4; int T0 = R0 - 4; T0 = T0 < 0 ? 0 : (T0 > 248 ? 248 : T0); int T1 = R0 - 1; T1 = T1 < 0 ? 0 : (T1 > 248 ? 248 : T1); T1 += 7;
                U.K = P + 768 + h * 64; U.V = P + 1536 + h * 64; U.row0 = T0 * 64; U.ntiles = T1 - T0 + 1; U.tok0 = R0;
                U.rpb = F.rpb_b + ((size_t)(l >> 1) * NQH + h) * 15 * 31;
                att::attn_unit<1>(U, F.lds + RING_OFF);
            }
        } else {
            if (!(amask & 2)) continue;
            const int v = u - 768, hm = v % NMH, blk = v / NMH, tok0 = blk * 256;
            U.Q = P + (size_t)tok0 * pitch + (pitch - 256) + hm * 64; U.qpitch = pitch; U.O = Y + (size_t)tok0 * DM + 768 + hm * 64; U.opitch = DM;
            U.K = MKV + hm * 64; U.V = MKV + 256 + hm * 64; U.kvpitch = 2048; U.kvmax = NMEM - 1; U.row0 = 0; U.ntiles = 4; U.tok0 = tok0;
            att::attn_unit<2>(U, F.lds + RING_OFF);
        }
    }
}

struct Args { const float* in[14]; float* out; unsigned char* ws; int ph_lo, ph_hi, li, amask; };
__global__ void __launch_bounds__(NWAVES * 64, 2) skel_fwd(Args args) {
    extern __shared__ __attribute__((aligned(16))) unsigned char lds[];
    Frame F;
    F.lds = (LAS unsigned char*)lds;
    F.MISC = (volatile LAS unsigned*)(F.lds + MISC_OFF);
    F.tid = threadIdx.x; F.lane = F.tid & 63; F.wave = __builtin_amdgcn_readfirstlane(F.tid >> 6);
    F.G = gridDim.x; { const int bx = blockIdx.x; F.vcu = (F.G % 8 == 0) ? (bx % 8) * (F.G / 8) + bx / 8 : bx; }
    F.ws = args.ws; F.out = args.out; F.ctl = (gu32*)(args.ws + WS_CTL);
    F.x = args.in[0]; F.mem = args.in[1]; F.norm_mix = args.in[2]; F.norm_ffn = args.in[3]; F.norm_mem = args.in[4]; F.norm_final = args.in[5]; F.w_in_a = args.in[6]; F.sink_a = args.in[7];
    F.w_in_b = args.in[8]; F.rpb_b = args.in[9]; F.w_mem_kv = args.in[10]; F.w_out = args.in[11]; F.w_gate_up = args.in[12]; F.w_down = args.in[13];
    for (int u = F.tid; u < (LDS_BYTES - LDSCTL_OFF) / 4; u += NWAVES * 64) ((LAS unsigned*)(F.lds + LDSCTL_OFF))[u] = 0u;
    __syncthreads();
    XcdBarrier bar; bar.bar = (unsigned*)(F.ctl + CW_BAR) + args.li * XCD_BAR_WORDS; bar.x = 0; bar.st = nullptr;
    if (!MK_PER_PHASE) bar = xcd_barrier_post((unsigned*)(F.ctl + CW_BAR) + args.li * XCD_BAR_WORDS, F.MISC + 8);
    const int lo = args.ph_lo, hi = args.ph_hi;
#define IN(k) (lo <= (k) && (k) < hi)
#define SEAM(k) do { if (IN((k) + 1)) xcd_barrier(bar); } while (0)
    typedef pg8::bf16_t pb;
    if (IN(0)) { for (int rep = 0; rep < ((MK_DUP & 1) ? 2 : 1); ++rep) { p0_prologue(F); SEAM(0); } }
    for (int l = 0; l < DEPTH; ++l) {
        const int pb0 = 1 + 5 * l; const bool isA = (l & 1) == 0; const int nin = isA ? WIN_A : WIN_B;
        if (IN(pb0)) { for (int rep = 0; rep < ((MK_DUP & 2) ? 2 : 1); ++rep) {
            { pg8::Gemm g{(const pb*)(F.ws + WS_XB), (const pb*)(F.ws + WS_WIN + win_off(l)), SEQ, nin, DM}; pg8::StaticOrder S; S.init(SEQ, nin, F.G, (int)blockIdx.x);
              pg8::EpiProj E{(pb*)(F.ws + WS_PROJ), nin, (const float*)(F.ws + WS_SSQA), 3, nin / 256 - 1, C2};
              pg8::gemm_phase<pg8::EpiProj, pg8::StaticOrder, true, true>(F.lds + RING_OFF, g, S, E); }
            if (l == 0) { pg8::Gemm g{(const pb*)(F.ws + WS_MEMN), (const pb*)(F.ws + WS_WMKV), NMEM, 2048, DM}; pg8::StaticOrder S; S.init(NMEM, 2048, F.G, (int)((blockIdx.x + F.G - 8) % F.G));
              pg8::EpiProj E{(pb*)(F.ws + WS_MKV), 2048, nullptr, 0, -1, 1.f};
              pg8::gemm_phase<pg8::EpiProj, pg8::StaticOrder, true, true>(F.lds + RING_OFF, g, S, E); }
            SEAM(pb0); }
        }
        if (IN(pb0 + 1)) { for (int rep = 0; rep < ((MK_DUP & 4) ? 2 : 1); ++rep) { attn_phase(F, l, args.amask); SEAM(pb0 + 1); } }
        if (IN(pb0 + 2)) {
            pg8::Gemm g{(const pb*)(F.ws + WS_Y), (const pb*)(F.ws + WS_WOUT + (size_t)l * 2 * MiB), SEQ, DM, DM}; pg8::StaticOrder S; S.init(SEQ, DM, F.G, (int)blockIdx.x);
            pg8::EpiRes E{l == 0 ? F.x : (const float*)F.out, F.out, (pb*)(F.ws + WS_XB), (float*)(F.ws + WS_SSQB), DM};
            pg8::gemm_phase<pg8::EpiRes, pg8::StaticOrder, true, true>(F.lds + RING_OFF, g, S, E);
            SEAM(pb0 + 2);
        }
        if (IN(pb0 + 3)) { for (int rep = 0; rep < ((MK_DUP & 8) ? 2 : 1); ++rep) {
            pg8::Gemm g{(const pb*)(F.ws + WS_XB), (const pb*)(F.ws + WS_WGU + (size_t)l * 11 * MiB), SEQ, NGU, DM}; pg8::StaticOrder S; S.init(SEQ, NGU, F.G, (int)blockIdx.x);
            pg8::EpiGU E{(pb*)(F.ws + WS_H), DFF, (const float*)(F.ws + WS_SSQB)};
            pg8::gemm_phase<pg8::EpiGU, pg8::StaticOrder, true, true>(F.lds + RING_OFF, g, S, E);
            SEAM(pb0 + 3); }
        }
        if (IN(pb0 + 4)) {
            pg8::Gemm g{(const pb*)(F.ws + WS_H), (const pb*)(F.ws + WS_WDN + (size_t)l * DFF * DM * 2), SEQ, DM, DFF}; pg8::StaticOrder S; S.init(SEQ, DM, F.G, (int)blockIdx.x);
            pg8::EpiRes E{(const float*)F.out, F.out, (pb*)(F.ws + WS_XB), (float*)(F.ws + WS_SSQA), DM};
            pg8::gemm_phase<pg8::EpiRes, pg8::StaticOrder, true, true>(F.lds + RING_OFF, g, S, E);
            SEAM(pb0 + 4);
        }
    }
    if (IN(N_PHASES - 1)) final_norm(F);
#undef IN
#undef SEAM
}
#if MK_PER_PHASE && MK_NAIVE
namespace nv {
__device__ __forceinline__ float bf2f(unsigned short b) { return __uint_as_float((unsigned)b << 16); }
struct GArgs { const bf16* A; const bf16* Bt; int M, N, K, mode;
    bf16* O; int ldc; const float* ssq; int nq_tiles, qm_tile; float qscale;
    const float* base; float* out; bf16* xb; };
__global__ void __launch_bounds__(256) naive_gemm(GArgs a) {
    __shared__ float As[16][65], Bs[16][65], Bs2[16][65];
    const int tx = threadIdx.x & 15, ty = threadIdx.x >> 4, bx = blockIdx.x, by = blockIdx.y;
    float acc[4][4], acc2[4][4];
#pragma unroll
    for (int i = 0; i < 4; ++i)
#pragma unroll
        for (int j = 0; j < 4; ++j) { acc[i][j] = 0.f; acc2[i][j] = 0.f; }
    const int lr = threadIdx.x >> 2, lk = (threadIdx.x & 3) * 4;
    const int jc = bx * 64 + lr;
    const size_t brow = (a.mode == 2) ? (size_t)((jc / 128) * 256 + (jc % 128)) : (size_t)jc;
    for (int k0 = 0; k0 < a.K; k0 += 16) {
        const bf16* ap = a.A + (size_t)(by * 64 + lr) * a.K + k0 + lk; const bf16* bp = a.Bt + brow * a.K + k0 + lk;
#pragma unroll
        for (int i = 0; i < 4; ++i) { As[lk + i][lr] = bf2f(ap[i]); Bs[lk + i][lr] = bf2f(bp[i]); if (a.mode == 2) Bs2[lk + i][lr] = bf2f(bp[(size_t)128 * a.K + i]); }
        __syncthreads();
#pragma unroll
        for (int k = 0; k < 16; ++k) {
#pragma unroll
            for (int i = 0; i < 4; ++i)
#pragma unroll
                for (int j = 0; j < 4; ++j) { acc[i][j] += As[k][ty * 4 + i] * Bs[k][tx * 4 + j]; if (a.mode == 2) acc2[i][j] += As[k][ty * 4 + i] * Bs2[k][tx * 4 + j]; }
        }
        __syncthreads();
    }
#pragma unroll
    for (int i = 0; i < 4; ++i)
#pragma unroll
        for (int j = 0; j < 4; ++j) {
            const int row = by * 64 + ty * 4 + i, col = bx * 64 + tx * 4 + j;
            if (a.mode == 0) { float rs = 1.f; if (a.ssq) { float s = 0.f; for (int q = 0; q < 16; ++q) s += a.ssq[(size_t)row * 16 + q]; rs = 1.0f / sqrtf(s * (1.0f / 1024.0f) + 1e-6f); }
                const int pn = col / 256; const float sc = (pn < a.nq_tiles || pn == a.qm_tile) ? a.qscale : 1.f;
                a.O[(size_t)row * a.ldc + col] = (bf16)f2bf(acc[i][j] * rs * sc); }
            else if (a.mode == 1) { const size_t o = (size_t)row * a.ldc + col; const float v = a.base[o] + acc[i][j]; a.out[o] = v; a.xb[o] = (bf16)f2bf(v); }
            else { float s = 0.f; for (int q = 0; q < 16; ++q) s += a.ssq[(size_t)row * 16 + q]; const float rs = 1.0f / sqrtf(s * (1.0f / 1024.0f) + 1e-6f);
                const float g = acc[i][j] * rs, u = acc2[i][j] * rs; a.O[(size_t)row * a.ldc + col] = (bf16)f2bf(g / (1.0f + expf(-g)) * u); }
        }
}
__global__ void __launch_bounds__(256) naive_ssq(const float* x, float* ssq) {
    const int row = blockIdx.x * 256 + threadIdx.x; float s = 0.f;
    for (int c = 0; c < DM; ++c) { const float v = x[(size_t)row * DM + c]; s += v * v; }
    for (int q = 0; q < 16; ++q) ssq[(size_t)row * 16 + q] = (q == 0) ? s : 0.f;
}
__device__ __forceinline__ void ld64(const bf16* p, float (&v)[64]) {
#pragma unroll
    for (int c = 0; c < 8; ++c) { const uint4 w = *(const uint4*)(p + 8 * c); const unsigned ww[4] = {w.x, w.y, w.z, w.w};
#pragma unroll
        for (int e = 0; e < 4; ++e) { v[8 * c + 2 * e] = __uint_as_float(ww[e] << 16); v[8 * c + 2 * e + 1] = __uint_as_float(ww[e] & 0xffff0000u); } }
}
__global__ void __launch_bounds__(256) naive_attn(int type, const bf16* P, int pitch, const bf16* MKV, const float* sink, const float* rpb, bf16* Y) {
    const int idx = blockIdx.x * 256 + threadIdx.x; const int nh = (type == 2) ? NMH : NQH; const int h = idx % nh, t = idx / nh;
    float q[64], o[64], kv[64];
    ld64(P + (size_t)t * pitch + (type == 2 ? (pitch - 256) : 0) + h * 64, q);
#pragma unroll
    for (int d = 0; d < 64; ++d) o[d] = 0.f;
    float m = -1e30f, l = 0.f;
    int nkeys; if (type == 0) { m = sink[h] * LOG2E; l = 1.f; nkeys = 257; } else if (type == 1) nkeys = 128; else nkeys = 256;
    const float slope2 = exp2f(-8.0f * (float)(h + 1) / 12.0f) * LOG2E;
    const int r = t / 64, c = t % 64; int rs = r - 4; rs = rs < 0 ? 0 : (rs > 248 ? 248 : rs); int cs = c - 8; cs = cs < 0 ? 0 : (cs > 48 ? 48 : cs);
    for (int i = 0; i < nkeys; ++i) {
        const bf16 *kp, *vp; float bias = 0.f;
        if (type == 0) { const int s = t - 128 + i; if (s < 0 || s >= SEQ) continue; kp = P + (size_t)s * pitch + 768 + (h / 3) * 64; vp = P + (size_t)s * pitch + 1024 + (h / 3) * 64; bias = -slope2 * fabsf((float)(t - s)); }
        else if (type == 1) { const int kr = rs + (i >> 4), kc = cs + (i & 15); const int s = kr * 64 + kc; kp = P + (size_t)s * pitch + 768 + h * 64; vp = P + (size_t)s * pitch + 1536 + h * 64;
            bias = rpb[(size_t)h * 15 * 31 + (kr - r + 7) * 31 + (kc - c + 15)] * LOG2E; }
        else { kp = MKV + (size_t)i * 2048 + h * 64; vp = MKV + (size_t)i * 2048 + 256 + h * 64; }
        ld64(kp, kv); float dot = 0.f;
#pragma unroll
        for (int d = 0; d < 64; ++d) dot += q[d] * kv[d];
        const float sc = dot + bias, mn = fmaxf(m, sc), al = exp2f(m - mn), p = exp2f(sc - mn);
        ld64(vp, kv); l = l * al + p;
#pragma unroll
        for (int d = 0; d < 64; ++d) o[d] = o[d] * al + p * kv[d];
        m = mn;
    }
    const float il = 1.0f / l; bf16* yp = Y + (size_t)t * DM + (type == 2 ? 768 : 0) + h * 64;
#pragma unroll
    for (int d = 0; d < 64; ++d) yp[d] = (bf16)f2bf(o[d] * il);
}
}
#endif
extern "C" void kernel_launch(void* const* d_in, const int* in_sizes, int n_in, void* d_out, int out_size, void* d_ws, size_t ws_size, hipStream_t stream) {
    static int grid = 0;
    if (grid == 0) {
        if (n_in != 14 || in_sizes[0] != SEQ * DM || out_size != SEQ * DM || ws_size < WS_END) { fprintf(stderr, "kernel_launch: unexpected shapes (n_in %d, in0 %d, out %d, ws %zu); nothing launched\n", n_in, n_in > 0 ? in_sizes[0] : -1, out_size, ws_size); grid = -1; return; }
        int dev = 0, cus = 0, per_cu = 0;
        if (hipGetDevice(&dev) != hipSuccess || hipDeviceGetAttribute(&cus, hipDeviceAttributeMultiprocessorCount, dev) != hipSuccess) { grid = -1; return; }
        if (hipFuncSetAttribute((const void*)skel_fwd, hipFuncAttributeMaxDynamicSharedMemorySize, LDS_BYTES) != hipSuccess) { fprintf(stderr, "kernel_launch: hipFuncSetAttribute failed\n"); grid = -1; return; }
        if (hipOccupancyMaxActiveBlocksPerMultiprocessor(&per_cu, (const void*)skel_fwd, NWAVES * 64, LDS_BYTES) != hipSuccess || per_cu < 1)
            fprintf(stderr, "kernel_launch: note: occupancy query reports %d workgroups per CU\n", per_cu);
        (void)hipGetLastError();
        grid = cus;
    }
    if (grid < 0) return;
    if (hipMemsetAsync((char*)d_ws + WS_CTL, 0, CTL_ZERO_BYTES, stream) != hipSuccess) return;
    Args a{};
    for (int i = 0; i < 14; ++i) a.in[i] = (const float*)d_in[i];
    a.out = (float*)d_out; a.ws = (unsigned char*)d_ws; a.amask = 3;
#if MK_PER_PHASE
    unsigned char* ws = (unsigned char*)d_ws; const float* const* in = (const float* const*)d_in;
    for (int p = 0; p < N_PHASES; ++p) {
        const int l = (p - 1) / 5, k = (p - 1) % 5; const bool mid = (p > 0 && p < N_PHASES - 1);
        (void)l; (void)k; (void)ws; (void)in;
#if MK_NAIVE
        if (mid && (MK_NAIVE & 1) && k != 1) {
            const int nin = (l & 1) ? WIN_B : WIN_A;
            nv::GArgs g{};
            if (k == 0) { g.A = (const bf16*)(ws + WS_XB); g.Bt = (const bf16*)(ws + WS_WIN + win_off(l)); g.M = SEQ; g.N = nin; g.K = DM; g.mode = 0; g.O = (bf16*)(ws + WS_PROJ); g.ldc = nin; g.ssq = (const float*)(ws + WS_SSQA);
                g.nq_tiles = 3; g.qm_tile = nin / 256 - 1; g.qscale = C2;
                hipLaunchKernelGGL(nv::naive_gemm, dim3(g.N / 64, g.M / 64), dim3(256), 0, stream, g);
                if (l == 0) { nv::GArgs m{}; m.A = (const bf16*)(ws + WS_MEMN); m.Bt = (const bf16*)(ws + WS_WMKV); m.M = NMEM; m.N = 2048; m.K = DM; m.mode = 0; m.O = (bf16*)(ws + WS_MKV); m.ldc = 2048; m.ssq = nullptr; m.nq_tiles = 0; m.qm_tile = -1; m.qscale = 1.f;
                    hipLaunchKernelGGL(nv::naive_gemm, dim3(m.N / 64, m.M / 64), dim3(256), 0, stream, m); } }
            else if (k == 2) { g.A = (const bf16*)(ws + WS_Y); g.Bt = (const bf16*)(ws + WS_WOUT + (size_t)l * 2 * MiB); g.M = SEQ; g.N = DM; g.K = DM; g.mode = 1; g.ldc = DM; g.base = (l == 0) ? in[0] : (const float*)d_out; g.out = (float*)d_out; g.xb = (bf16*)(ws + WS_XB);
                hipLaunchKernelGGL(nv::naive_gemm, dim3(g.N / 64, g.M / 64), dim3(256), 0, stream, g);
                hipLaunchKernelGGL(nv::naive_ssq, dim3(SEQ / 256), dim3(256), 0, stream, (const float*)d_out, (float*)(ws + WS_SSQB)); }
            else if (k == 3) { g.A = (const bf16*)(ws + WS_XB); g.Bt = (const bf16*)(ws + WS_WGU + (size_t)l * 11 * MiB); g.M = SEQ; g.N = DFF; g.K = DM; g.mode = 2; g.O = (bf16*)(ws + WS_H); g.ldc = DFF; g.ssq = (const float*)(ws + WS_SSQB);
                hipLaunchKernelGGL(nv::naive_gemm, dim3(g.N / 64, g.M / 64), dim3(256), 0, stream, g); }
            else { g.A = (const bf16*)(ws + WS_H); g.Bt = (const bf16*)(ws + WS_WDN + (size_t)l * DFF * DM * 2); g.M = SEQ; g.N = DM; g.K = DFF; g.mode = 1; g.ldc = DM; g.base = (const float*)d_out; g.out = (float*)d_out; g.xb = (bf16*)(ws + WS_XB);
                hipLaunchKernelGGL(nv::naive_gemm, dim3(g.N / 64, g.M / 64), dim3(256), 0, stream, g);
                hipLaunchKernelGGL(nv::naive_ssq, dim3(SEQ / 256), dim3(256), 0, stream, (const float*)d_out, (float*)(ws + WS_SSQA)); }
            continue;
        }
        a.amask = 3;
        if (mid && k == 1) {
            const int pitch = (l & 1) ? WIN_B : WIN_A; const bf16* P = (const bf16*)(ws + WS_PROJ); const bf16* MKV = (const bf16*)(ws + WS_MKV) + l * 512; bf16* Y = (bf16*)(ws + WS_Y);
            if (MK_NAIVE & ((l & 1) ? 4 : 2)) { a.amask &= ~1;
                hipLaunchKernelGGL(nv::naive_attn, dim3(SEQ * NQH / 256), dim3(256), 0, stream, (l & 1), P, pitch, MKV, in[7] + (l >> 1) * NQH, in[9] + (size_t)(l >> 1) * NQH * 15 * 31, Y); }
            if (MK_NAIVE & 8) { a.amask &= ~2;
                hipLaunchKernelGGL(nv::naive_attn, dim3(SEQ * NMH / 256), dim3(256), 0, stream, 2, P, pitch, MKV, in[7], in[9], Y); }
            if (a.amask == 0) continue;
        }
#endif
        a.ph_lo = p; a.ph_hi = p + 1; a.li = p;
        hipLaunchKernelGGL(skel_fwd, dim3(grid), dim3(NWAVES * 64), LDS_BYTES, stream, a);
    }
#else
    a.ph_lo = 0; a.ph_hi = N_PHASES; a.li = 0;
    hipLaunchKernelGGL(skel_fwd, dim3(grid), dim3(NWAVES * 64), LDS_BYTES, stream, a);
#endif
    const hipError_t le = hipPeekAtLastError();
    if (le != hipSuccess) fprintf(stderr, "kernel_launch: launch failed: %s\n", hipGetErrorName(le));
}
```

```cpp
#define MK_PER_PHASE 0
#define MK_NAIVE 0
#include <hip/hip_runtime.h>
#include <cstdio>
#include <cstdint>
namespace pg8 {
#define PG8_LAS __attribute__((address_space(3)))
typedef unsigned short bf16_t;
typedef short bf16x8 __attribute__((ext_vector_type(8)));
typedef float f32x4 __attribute__((ext_vector_type(4)));
typedef unsigned u32x4 __attribute__((ext_vector_type(4)));
constexpr int BM = 256, BK = 64, HALF = 128, HTB = HALF * BK * 2  , STAGE_BYTES = 8 * HTB, NXCD = 8, WGM = 8;

__host__ __device__ __forceinline__ int lds_byte(int r, int c) { const int st = (r >> 4) * 2 + (c >> 5), rr = r & 15, cc = c & 31, ob = rr * 64 + cc * 2; return st * 1024 + (ob ^ (((ob >> 9) & 1) << 5)); }
__host__ __device__ __forceinline__ void stage_rc(int b, int& R, int& C) { const int st = b / 1024, sb = b % 1024, swz = sb ^ (((sb >> 9) & 1) << 5); R = (st >> 1) * 16 + swz / 64; C = (st & 1) * 32 + (swz % 64) / 2; }
__host__ __device__ __forceinline__ int perm32(int rho) { const int n = rho >> 4, i = rho & 15; return 8 * (i >> 2) + 4 * n + (i & 3); }

struct Unit { int pm, pn; };
struct Gemm { const bf16_t* A; const bf16_t* Bt; int M, N, K; };

struct StaticOrder {
    int nM, nN, nwg, G, c;
    __host__ __device__ void init(int M, int N, int G_, int c_) { nM = M / BM; nN = N / BM; nwg = nM * nN; G = G_; c = c_; }
    __host__ __device__ bool next(int i, Unit& u) const {
        const long L = (long)i * G + c; if (L >= nwg) return false;
        int wgid = (int)L; { const int q = nwg / NXCD, r = nwg % NXCD, xcd = wgid % NXCD, off = wgid / NXCD; wgid = (xcd < r ? xcd * (q + 1) : r * (q + 1) + (xcd - r) * q) + off; }
        const int nig = WGM * nN, gid = wgid / nig, fm = gid * WGM, gsz = (nM - fm) < WGM ? (nM - fm) : WGM;
        u.pm = fm + ((wgid % nig) % gsz); u.pn = (wgid % nig) / gsz; return true;
    }
    __device__ __forceinline__ void a_ready(const Unit&) const {}
    __device__ __forceinline__ void done(const Unit&) const {}
};

__device__ __forceinline__ unsigned cvt_pk_bf16(float lo, float hi) { unsigned r; asm volatile("v_cvt_pk_bf16_f32 %0, %1, %2" : "=v"(r) : "v"(lo), "v"(hi)); return r; }
typedef float f32x2 __attribute__((ext_vector_type(2)));
__device__ __forceinline__ float row_rstd(const float* ssq, int row) {
    const f32x4* p = (const f32x4*)(ssq + (size_t)row * 16);
    const f32x4 a = p[0], b = p[1], c = p[2], d = p[3];
    const float s = (((a[0] + a[1]) + (a[2] + a[3])) + ((b[0] + b[1]) + (b[2] + b[3]))) + (((c[0] + c[1]) + (c[2] + c[3])) + ((d[0] + d[1]) + (d[2] + d[3])));
    return __builtin_amdgcn_rsqf(s * (1.0f / 1024.0f) + 1e-6f);
}
struct EpiProj {
    static constexpr bool PERM = true, AFTER_DRAIN = false;
    bf16_t* O; int ldc; const float* ssq; int nq_tiles, qm_tile; float qscale;
    __device__ __forceinline__ void operator()(const f32x4 (&acc)[2][2][4][2], const Unit& u, int wr, int wc, int fr, int fq) const {
        const int row0 = u.pm * BM + wr * 64 + fr;
        const float sc = (u.pn < nq_tiles || u.pn == qm_tile) ? qscale : 1.f;
        const int col0 = u.pn * BM + wc * 32 + 8 * fq;
#pragma unroll
        for (int ai = 0; ai < 2; ++ai)
#pragma unroll
            for (int m = 0; m < 4; ++m) { const int row = row0 + ai * HALF + m * 16; const float rs = ssq ? row_rstd(ssq, row) * sc : sc;
                bf16_t* rowp = O + (size_t)row * ldc + col0;
#pragma unroll
                for (int bj = 0; bj < 2; ++bj) { const f32x4 v0 = acc[ai][bj][m][0] * rs, v1 = acc[ai][bj][m][1] * rs;
                    u32x4 w; w.x = cvt_pk_bf16(v0[0], v0[1]); w.y = cvt_pk_bf16(v0[2], v0[3]); w.z = cvt_pk_bf16(v1[0], v1[1]); w.w = cvt_pk_bf16(v1[2], v1[3]);
                    *(u32x4*)(rowp + bj * HALF) = w; } }
    }
};
struct EpiRes {
    static constexpr bool PERM = true, AFTER_DRAIN = false;
    const float* base; float* out; bf16_t* xb; float* ssq_out; int ldc;
    __device__ __forceinline__ void operator()(const f32x4 (&acc)[2][2][4][2], const Unit& u, int wr, int wc, int fr, int fq) const {
        const int row0 = u.pm * BM + wr * 64 + fr;
        const int col0 = u.pn * BM + wc * 32 + 8 * fq;
#pragma unroll
        for (int ai = 0; ai < 2; ++ai)
#pragma unroll
            for (int m = 0; m < 4; ++m) { const int row = row0 + ai * HALF + m * 16; const size_t off = (size_t)row * ldc + col0; float ss = 0.f;
#pragma unroll
                for (int bj = 0; bj < 2; ++bj) { const f32x4 b0 = *(const f32x4*)(base + off + bj * HALF), b1 = *(const f32x4*)(base + off + bj * HALF + 4);
                    const f32x4 v0 = b0 + acc[ai][bj][m][0], v1 = b1 + acc[ai][bj][m][1];
                    *(f32x4*)(out + off + bj * HALF) = v0; *(f32x4*)(out + off + bj * HALF + 4) = v1;
                    u32x4 w; w.x = cvt_pk_bf16(v0[0], v0[1]); w.y = cvt_pk_bf16(v0[2], v0[3]); w.z = cvt_pk_bf16(v1[0], v1[1]); w.w = cvt_pk_bf16(v1[2], v1[3]);
                    *(u32x4*)(xb + off + bj * HALF) = w;
                    ss += ((v0[0] * v0[0] + v0[1] * v0[1]) + (v0[2] * v0[2] + v0[3] * v0[3])) + ((v1[0] * v1[0] + v1[1] * v1[1]) + (v1[2] * v1[2] + v1[3] * v1[3])); }
                ss += __shfl_xor(ss, 16); ss += __shfl_xor(ss, 32);
                if (fq == 0) ssq_out[(size_t)row * 16 + u.pn * 4 + wc] = ss; }
    }
};
struct EpiGU {
    static constexpr bool PERM = true, AFTER_DRAIN = false;
    bf16_t* H; int ldh; const float* ssq;
    static __device__ __forceinline__ float swi(float g, float u) { return g * u * __builtin_amdgcn_rcpf(1.0f + __builtin_amdgcn_exp2f(-1.4426950408889634f * g)); }
    __device__ __forceinline__ void operator()(const f32x4 (&acc)[2][2][4][2], const Unit& u, int wr, int wc, int fr, int fq) const {
        const int row0 = u.pm * BM + wr * 64 + fr;
        const int col0 = u.pn * HALF + wc * 32 + 8 * fq;
#pragma unroll
        for (int ai = 0; ai < 2; ++ai)
#pragma unroll
            for (int m = 0; m < 4; ++m) { const int row = row0 + ai * HALF + m * 16; const float rs = row_rstd(ssq, row);
                const f32x4 g0 = acc[ai][0][m][0] * rs, g1 = acc[ai][0][m][1] * rs, u0 = acc[ai][1][m][0] * rs, u1 = acc[ai][1][m][1] * rs;
                u32x4 w; w.x = cvt_pk_bf16(swi(g0[0], u0[0]), swi(g0[1], u0[1])); w.y = cvt_pk_bf16(swi(g0[2], u0[2]), swi(g0[3], u0[3]));
                w.z = cvt_pk_bf16(swi(g1[0], u1[0]), swi(g1[1], u1[1])); w.w = cvt_pk_bf16(swi(g1[2], u1[2]), swi(g1[3], u1[3]));
                *(u32x4*)(H + (size_t)row * ldh + col0) = w; }
    }
};
template <class Epi, class Sched, bool ALIGN_EPI = false, bool SP2 = false>
__device__ __forceinline__ void gemm_phase(PG8_LAS unsigned char* lds, const Gemm g, const Sched& S, const Epi& E) {
    int tid_ = threadIdx.x; asm volatile("" : "+v"(tid_));
    const int tid = tid_, wid = __builtin_amdgcn_readfirstlane(tid >> 6), lane = tid & 63, wr = wid >> 2, wc = wid & 3, fr = lane & 15, fq = lane >> 4;
    const int K = g.K, nt = K / BK;
    unsigned voffA[2], voffB[2];
#pragma unroll
    for (int i = 0; i < 2; ++i) { int R, C; stage_rc(tid * 16 + i * 8192, R, C); const int Rb = Epi::PERM ? ((R & ~31) + perm32(R & 31)) : R;
        voffA[i] = (unsigned)(R * K + C) * 2u; voffB[i] = (unsigned)(Rb * K + C) * 2u; }
    const size_t kstep = (size_t)(BK * 2);
    const size_t hstep = (size_t)HALF * K * 2;
    const size_t tstep = 2 * hstep;
    const unsigned ldsw = (unsigned)wid * 1024u;
    const int aoff = lds_byte(wr * 64 + fr, fq * 8), boff = lds_byte(wc * 32 + fr, fq * 8);
#define PG8_SA(b, h) (((b) * 2 + (h)) * HTB)
#define PG8_SB(b, h) ((4 + (b) * 2 + (h)) * HTB)
#define PG8_STAGE(bufoff, gbase, voff) do { _Pragma("unroll") for (int _i = 0; _i < 2; ++_i) \
        __builtin_amdgcn_global_load_lds((const unsigned*)((const char*)(gbase) + (voff)[_i]), (PG8_LAS unsigned*)(lds + (bufoff) + ldsw + _i * 8192), 16, 0, 0); } while (0)
#define PG8_LDA(dst, b, h) do { _Pragma("unroll") for (int m = 0; m < 4; ++m) _Pragma("unroll") for (int k = 0; k < 2; ++k) dst[m][k] = *(const PG8_LAS bf16x8*)(lds + PG8_SA(b, h) + aoff + m * 2048 + k * 1024); } while (0)
#define PG8_LDB(dst, b, h) do { _Pragma("unroll") for (int n = 0; n < 2; ++n) _Pragma("unroll") for (int k = 0; k < 2; ++k) dst[n][k] = *(const PG8_LAS bf16x8*)(lds + PG8_SB(b, h) + boff + n * 2048 + k * 1024); } while (0)
#define PG8_MMA(ai, bj, At, Bt) do { __builtin_amdgcn_s_setprio(1); _Pragma("unroll") for (int m = 0; m < 4; ++m) _Pragma("unroll") for (int n = 0; n < 2; ++n) _Pragma("unroll") for (int k = 0; k < 2; ++k) \
        acc[ai][bj][m][n] = __builtin_amdgcn_mfma_f32_16x16x32_bf16(Bt[n][k], At[m][k], acc[ai][bj][m][n], 0, 0, 0); __builtin_amdgcn_s_setprio(0); } while (0)
#define PG8_WAIT_V(n) asm volatile("s_waitcnt vmcnt(" #n ")" ::: "memory")
#define PG8_WAIT_L(n) asm volatile("s_waitcnt lgkmcnt(" #n ")" ::: "memory")
#define PG8_BAR __builtin_amdgcn_s_barrier()
#define PG8_SCHED __builtin_amdgcn_sched_barrier(0)
    Unit cur, nxt; int ui = 0;
    if (!S.next(0, cur)) return;
    f32x4 acc[2][2][4][2];
#pragma unroll
    for (int a = 0; a < 2; ++a)
#pragma unroll
        for (int b = 0; b < 2; ++b)
#pragma unroll
            for (int m = 0; m < 4; ++m)
#pragma unroll
                for (int n = 0; n < 2; ++n) acc[a][b][m][n] = (f32x4){0.f, 0.f, 0.f, 0.f};
    bf16x8 At[4][2], B0[2][2], B1[2][2];
    const char* cA = (const char*)g.A + (size_t)cur.pm * tstep; const char* cB = (const char*)g.Bt + (size_t)cur.pn * tstep;
    S.a_ready(cur);
    if constexpr (SP2) {
        PG8_STAGE(PG8_SB(0, 0), cB, voffB); PG8_STAGE(PG8_SB(0, 1), cB + hstep, voffB); PG8_STAGE(PG8_SA(0, 0), cA, voffA); PG8_STAGE(PG8_SA(0, 1), cA + hstep, voffA);
        if (wr == 1) PG8_BAR;
        PG8_WAIT_V(2); PG8_BAR;
        PG8_STAGE(PG8_SB(1, 0), cB + kstep, voffB); PG8_STAGE(PG8_SA(1, 0), cA + kstep, voffA); PG8_STAGE(PG8_SB(1, 1), cB + hstep + kstep, voffB);
        PG8_WAIT_V(6); PG8_BAR;
    } else {
        PG8_STAGE(PG8_SB(0, 0), cB, voffB); PG8_STAGE(PG8_SA(0, 0), cA, voffA); PG8_STAGE(PG8_SB(0, 1), cB + hstep, voffB); PG8_STAGE(PG8_SA(0, 1), cA + hstep, voffA);
        if (wr == 1) PG8_BAR;
        PG8_WAIT_V(4); PG8_BAR;
        PG8_STAGE(PG8_SB(1, 0), cB + kstep, voffB); PG8_STAGE(PG8_SA(1, 0), cA + kstep, voffA); PG8_STAGE(PG8_SB(1, 1), cB + hstep + kstep, voffB);
        PG8_WAIT_V(6); PG8_BAR;
    }
    for (;;) {
        const bool has_next = S.next(ui + 1, nxt);
        const char* nA = has_next ? (const char*)g.A + (size_t)nxt.pm * tstep : cA; const char* nB = has_next ? (const char*)g.Bt + (size_t)nxt.pn * tstep : cB;
        for (int t = 0; t < nt; t += 2) {
            const bool last = (t == nt - 2);
            const char* a1 = cA + (size_t)(t + 1) * kstep;
            const char* a2 = last ? nA : cA + (size_t)(t + 2) * kstep; const char* b2 = last ? nB : cB + (size_t)(t + 2) * kstep;
            const char* a3 = a2 + kstep; const char* b3 = b2 + kstep;
            if (last && has_next) S.a_ready(nxt);
            if constexpr (SP2) {
            PG8_LDB(B0, 0, 0); PG8_LDB(B1, 0, 1); PG8_SCHED; PG8_LDA(At, 0, 0); PG8_STAGE(PG8_SA(1, 1), a1 + hstep, voffA);
            PG8_WAIT_V(8); PG8_WAIT_L(0); PG8_BAR; PG8_MMA(0, 0, At, B0); PG8_MMA(0, 1, At, B1); PG8_BAR; PG8_SCHED;
            PG8_LDA(At, 0, 1); PG8_STAGE(PG8_SB(0, 0), b2, voffB); PG8_STAGE(PG8_SB(0, 1), b2 + hstep, voffB); PG8_STAGE(PG8_SA(0, 0), a2, voffA);
            PG8_WAIT_V(8); PG8_WAIT_L(0); PG8_BAR; PG8_MMA(1, 0, At, B0); PG8_MMA(1, 1, At, B1); PG8_BAR; PG8_SCHED;
            PG8_LDB(B0, 1, 0); PG8_LDB(B1, 1, 1); PG8_SCHED; PG8_LDA(At, 1, 0); PG8_STAGE(PG8_SA(0, 1), a2 + hstep, voffA);
            PG8_WAIT_V(8); PG8_WAIT_L(0); PG8_BAR; PG8_MMA(0, 0, At, B0); PG8_MMA(0, 1, At, B1); PG8_BAR; PG8_SCHED;
            PG8_LDA(At, 1, 1); PG8_STAGE(PG8_SB(1, 0), b3, voffB); PG8_STAGE(PG8_SB(1, 1), b3 + hstep, voffB); PG8_STAGE(PG8_SA(1, 0), a3, voffA);
            PG8_WAIT_V(8); PG8_WAIT_L(0); PG8_BAR; PG8_MMA(1, 0, At, B0); PG8_MMA(1, 1, At, B1); PG8_BAR; PG8_SCHED;
            } else {
            PG8_LDB(B0, 0, 0); PG8_SCHED; PG8_LDA(At, 0, 0); PG8_STAGE(PG8_SA(1, 1), a1 + hstep, voffA);
            PG8_WAIT_L(8); PG8_BAR; PG8_WAIT_L(0); PG8_MMA(0, 0, At, B0); PG8_BAR; PG8_SCHED;
            PG8_LDB(B1, 0, 1); PG8_STAGE(PG8_SB(0, 0), b2, voffB);
            PG8_BAR; PG8_WAIT_L(0); PG8_MMA(0, 1, At, B1); PG8_BAR;
            PG8_LDA(At, 0, 1); PG8_STAGE(PG8_SA(0, 0), a2, voffA);
            PG8_BAR; PG8_WAIT_L(0); PG8_MMA(1, 0, At, B0); PG8_BAR; PG8_SCHED;
            PG8_STAGE(PG8_SB(0, 1), b2 + hstep, voffB);
            PG8_WAIT_V(6); PG8_BAR; PG8_MMA(1, 1, At, B1); PG8_BAR;
            PG8_LDB(B0, 1, 0); PG8_SCHED; PG8_LDA(At, 1, 0); PG8_STAGE(PG8_SA(0, 1), a2 + hstep, voffA);
            PG8_WAIT_L(8); PG8_BAR; PG8_WAIT_L(0); PG8_MMA(0, 0, At, B0); PG8_BAR; PG8_SCHED;
            PG8_LDB(B1, 1, 1); PG8_STAGE(PG8_SB(1, 0), b3, voffB);
            PG8_BAR; PG8_WAIT_L(0); PG8_MMA(0, 1, At, B1); PG8_BAR;
            PG8_LDA(At, 1, 1); PG8_STAGE(PG8_SA(1, 0), a3, voffA);
            PG8_BAR; PG8_WAIT_L(0); PG8_MMA(1, 0, At, B0); PG8_BAR; PG8_SCHED;
            PG8_STAGE(PG8_SB(1, 1), b3 + hstep, voffB);
            PG8_WAIT_V(6); PG8_BAR; PG8_MMA(1, 1, At, B1); PG8_BAR;
            }
        }
        if constexpr (ALIGN_EPI) { if (wr == 0) PG8_BAR; }
        if constexpr (!Epi::AFTER_DRAIN) { E(acc, cur, wr, wc, fr, fq); S.done(cur); }
        if (!has_next) break;
#pragma unroll
        for (int a = 0; a < 2; ++a)
#pragma unroll
            for (int b = 0; b < 2; ++b)
#pragma unroll
                for (int m = 0; m < 4; ++m)
#pragma unroll
                    for (int n = 0; n < 2; ++n) acc[a][b][m][n] = (f32x4){0.f, 0.f, 0.f, 0.f};
        cur = nxt; cA = nA; cB = nB; ++ui;
        if constexpr (ALIGN_EPI) { if (wr == 1) PG8_BAR; }
    }
    PG8_WAIT_V(0);
    if constexpr (!ALIGN_EPI) { if (wr == 0) PG8_BAR; }
    PG8_BAR;
    if constexpr (Epi::AFTER_DRAIN) { E.fused(acc, cur, wr, wc, fr, fq, lds, wid, lane); S.done(cur); }
#undef PG8_SA
#undef PG8_SB
#undef PG8_STAGE
#undef PG8_LDA
#undef PG8_LDB
#undef PG8_MMA
#undef PG8_WAIT_V
#undef PG8_WAIT_L
#undef PG8_BAR
#undef PG8_SCHED
}
}
namespace att {
typedef unsigned short bf16_t;
using bf16x8 = __attribute__((ext_vector_type(8))) short;
using s16x4 = __attribute__((ext_vector_type(4))) short;
using f32x16 = __attribute__((ext_vector_type(16))) float;
using u32x4 = __attribute__((ext_vector_type(4))) unsigned;
#define ATT_LAS __attribute__((address_space(3)))
constexpr int NW = 8, NSLOT = 6, PF = NSLOT - 1, SLOTB = 16384, VOFF = 8192;
constexpr int LDS_WS = NSLOT * SLOTB, LDS_OST = LDS_WS + NW * 256, LDS_TAB = LDS_OST + NW * 4096, TAB_PAD = 64, LDS_END = LDS_TAB + 4096;
constexpr float NEG_INF = -__builtin_inff();
__device__ __forceinline__ constexpr int crow(int r, int hi) { return (r & 3) + 8 * (r >> 2) + 4 * hi; }
__device__ __forceinline__ void glds16(const void* gsrc, unsigned lds_dst) { unsigned keep;
    asm volatile("s_mov_b32 %0, m0\n\ts_mov_b32 m0, %2\n\ts_nop 0\n\tglobal_load_lds_dwordx4 %1, off\n\ts_mov_b32 m0, %0" : "=&s"(keep) : "v"(gsrc), "s"(lds_dst) : "memory"); }
__device__ __forceinline__ float max3f(float a, float b, float c) { return __builtin_fmaxf(__builtin_fmaxf(a, b), c); }
typedef float f32x2_t __attribute__((ext_vector_type(2))); typedef __bf16 bf16x2_t __attribute__((ext_vector_type(2)));
__device__ __forceinline__ unsigned cvtpk_s(float lo, float hi) { f32x2_t v = {lo, hi}; bf16x2_t b = __builtin_convertvector(v, bf16x2_t); return __builtin_bit_cast(unsigned, b); }

__device__ __forceinline__ void qkt(f32x16& p0, f32x16& p1, const ATT_LAS char* kp, const bf16x8* qr) {
    const f32x16 z = f32x16{};
#pragma unroll
    for (int d0 = 0; d0 < 4; ++d0) {
        const bf16x8 b0 = *(const ATT_LAS bf16x8*)(kp + d0 * 2048);
        const bf16x8 b1 = *(const ATT_LAS bf16x8*)(kp + d0 * 2048 + 512);
        if (d0 == 0) { p0 = __builtin_amdgcn_mfma_f32_32x32x16_bf16(b0, qr[0], z, 0, 0, 0); p1 = __builtin_amdgcn_mfma_f32_32x32x16_bf16(b1, qr[0], z, 0, 0, 0); }
        else { p0 = __builtin_amdgcn_mfma_f32_32x32x16_bf16(b0, qr[d0], p0, 0, 0, 0); p1 = __builtin_amdgcn_mfma_f32_32x32x16_bf16(b1, qr[d0], p1, 0, 0, 0); } }
}
__device__ __forceinline__ float rowmax(const f32x16& p0, const f32x16& p1) {
    float a = max3f(p0[0], p0[1], p1[0]), b = max3f(p0[2], p0[3], p1[1]); a = max3f(a, p1[2], p1[3]);
#pragma unroll
    for (int r = 4; r < 16; r += 4) { a = max3f(a, p0[r], p0[r + 1]); b = max3f(b, p0[r + 2], p0[r + 3]); a = max3f(a, p1[r], p1[r + 1]); b = max3f(b, p1[r + 2], p1[r + 3]); }
    const float m = __builtin_fmaxf(a, b);
    auto rr = __builtin_amdgcn_permlane32_swap(__float_as_uint(m), __float_as_uint(m), false, false);
    return __builtin_fmaxf(__uint_as_float(rr[0]), __uint_as_float(rr[1]));
}
__device__ __forceinline__ void pv(f32x16* o, int vb, bf16x8 pa0, bf16x8 pa1, bf16x8 pa2, bf16x8 pa3) {
#pragma unroll
    for (int d0 = 0; d0 < 2; ++d0) { s16x4 lo[4], hi[4];
#pragma unroll
        for (int ks = 0; ks < 4; ++ks) {
            asm volatile("ds_read_b64_tr_b16 %0,%1 offset:%c2" : "=&v"(lo[ks]) : "v"(vb), "i"(d0 * 4096 + ks * 1024) : "memory");
            asm volatile("ds_read_b64_tr_b16 %0,%1 offset:%c2" : "=&v"(hi[ks]) : "v"(vb), "i"(d0 * 4096 + ks * 1024 + 512) : "memory"); }
        asm volatile("s_waitcnt lgkmcnt(0)" ::: "memory"); __builtin_amdgcn_sched_barrier(0);
#define ATT_PK(k) (bf16x8){lo[k][0], lo[k][1], lo[k][2], lo[k][3], hi[k][0], hi[k][1], hi[k][2], hi[k][3]}
        o[d0] = __builtin_amdgcn_mfma_f32_32x32x16_bf16(pa0, ATT_PK(0), o[d0], 0, 0, 0);
        o[d0] = __builtin_amdgcn_mfma_f32_32x32x16_bf16(pa1, ATT_PK(1), o[d0], 0, 0, 0);
        o[d0] = __builtin_amdgcn_mfma_f32_32x32x16_bf16(pa2, ATT_PK(2), o[d0], 0, 0, 0);
        o[d0] = __builtin_amdgcn_mfma_f32_32x32x16_bf16(pa3, ATT_PK(3), o[d0], 0, 0, 0);
#undef ATT_PK
    }
}

struct UnitP {
    const bf16_t* Q; int qpitch;
    const bf16_t* K; const bf16_t* V; int kvpitch, kvmax;
    int row0, ntiles;
    bf16_t* O; int opitch;
    int tok0;
    float slope2, m0, l0;
    const float* rpb;
    int seqlen;
};
#define ATT_SOFTMAX_PV(ACT) do { \
    float a_ = NEG_INF, b_ = NEG_INF; \
    _Pragma("unroll") for (int r = 0; r < 16; r += 2) { if (ACT(0, r)) a_ = max3f(a_, p0[r], p0[r + 1]); if (ACT(1, r)) b_ = max3f(b_, p1[r], p1[r + 1]); } \
    float rm = __builtin_fmaxf(a_, b_); \
    { auto rr = __builtin_amdgcn_permlane32_swap(__float_as_uint(rm), __float_as_uint(rm), false, false); rm = __builtin_fmaxf(__uint_as_float(rr[0]), __uint_as_float(rr[1])); } \
    const float mn = __builtin_fmaxf(m, rm); \
    if (__any(mn > m)) { \
        const float alpha = __builtin_amdgcn_exp2f(m - mn); l *= alpha; \
        if (hi == 0) wsf[r32] = alpha; \
        asm volatile("s_waitcnt lgkmcnt(0)" ::: "memory"); \
        _Pragma("unroll") for (int r = 0; r < 16; ++r) { const float f = wsf[crow(r, hi)]; o[0][r] *= f; o[1][r] *= f; } \
        asm volatile("" ::: "memory"); \
    } \
    m = mn; \
    float sacc = 0.f; \
    _Pragma("unroll") for (int r = 0; r < 16; ++r) { \
        if (ACT(0, r)) { p0[r] = __builtin_amdgcn_exp2f(p0[r] - m); sacc += p0[r]; } else p0[r] = 0.f; \
        if (ACT(1, r)) { p1[r] = __builtin_amdgcn_exp2f(p1[r] - m); sacc += p1[r]; } else p1[r] = 0.f; } \
    l += sacc; \
    u32x4 pw0, pw1, pw2, pw3; \
    pw0 = (u32x4){cvtpk_s(p0[0], p0[1]), cvtpk_s(p0[2], p0[3]), cvtpk_s(p0[4], p0[5]), cvtpk_s(p0[6], p0[7])}; \
    pw1 = (u32x4){cvtpk_s(p0[8], p0[9]), cvtpk_s(p0[10], p0[11]), cvtpk_s(p0[12], p0[13]), cvtpk_s(p0[14], p0[15])}; \
    pw2 = (u32x4){cvtpk_s(p1[0], p1[1]), cvtpk_s(p1[2], p1[3]), cvtpk_s(p1[4], p1[5]), cvtpk_s(p1[6], p1[7])}; \
    pw3 = (u32x4){cvtpk_s(p1[8], p1[9]), cvtpk_s(p1[10], p1[11]), cvtpk_s(p1[12], p1[13]), cvtpk_s(p1[14], p1[15])}; \
    __builtin_amdgcn_sched_barrier(0); \
    pv(o, vb0 + slot * SLOTB, __builtin_bit_cast(bf16x8, pw0), __builtin_bit_cast(bf16x8, pw1), __builtin_bit_cast(bf16x8, pw2), __builtin_bit_cast(bf16x8, pw3)); \
} while (0)
#define ATT_ACT_ALL(half, r) true
#define ATT_ACT_C0(half, r) ((half) == 0 || (r) < 4)
#define ATT_ACT_C1(half, r) ((half) == 1 || (r) >= 12)

template <int TYPE>
__device__ __forceinline__ void attn_unit(const UnitP& U, ATT_LAS unsigned char* lds) {
    int tid_ = threadIdx.x; asm volatile("" : "+v"(tid_));
    const int tid = tid_, lane = tid & 63, r32 = lane & 31, hi = lane >> 5; const int wid = __builtin_amdgcn_readfirstlane(tid >> 6);
    const unsigned lds0 = (unsigned)(uintptr_t)lds;
    const ATT_LAS char* shm3 = (const ATT_LAS char*)lds;
    ATT_LAS float* wsf = (ATT_LAS float*)(lds + LDS_WS) + wid * 64;
    ATT_LAS float* tab = (ATT_LAS float*)(lds + LDS_TAB);
    if (TYPE == 1) { for (int i = tid; i < 15 * 31; i += NW * 64) tab[TAB_PAD + i] = U.rpb[i] * 1.4426950408889634f; }
    const int NT = U.ntiles;
    const int krow = lane, vrow = 16 * (wid & 3) + (lane >> 2);
    const bf16_t* kcol = U.K + wid * 8; const bf16_t* vcol = U.V + (wid >> 2) * 32 + (lane & 3) * 8;
    const unsigned kdst = lds0 + wid * 1024, vdst = lds0 + VOFF + wid * 1024;
#define ATT_CLAMP(r) ((r) < 0 ? 0 : ((r) > U.kvmax ? U.kvmax : (r)))
#define ATT_DMA(t, slot) do { const int rb_ = U.row0 + 64 * (t); const int kr_ = ATT_CLAMP(rb_ + krow), vr_ = ATT_CLAMP(rb_ + vrow); \
        glds16(kcol + (size_t)kr_ * U.kvpitch, (unsigned)__builtin_amdgcn_readfirstlane(kdst + (slot) * SLOTB)); \
        glds16(vcol + (size_t)vr_ * U.kvpitch, (unsigned)__builtin_amdgcn_readfirstlane(vdst + (slot) * SLOTB)); } while (0)
    bf16x8 qr[4];
    { const bf16_t* Qw = U.Q + (size_t)(wid * 32 + r32) * U.qpitch + hi * 8;
#pragma unroll
      for (int d0 = 0; d0 < 4; ++d0) qr[d0] = *(const bf16x8*)(Qw + d0 * 16); }
#pragma unroll
    for (int j = 0; j < PF; ++j) if (j < NT) ATT_DMA(j, j);
    asm volatile("" : "+v"(qr[0]), "+v"(qr[1]), "+v"(qr[2]), "+v"(qr[3]));
    float m = U.m0, l = (hi == 0) ? U.l0 : 0.f;
    f32x16 o[2]; o[0] = f32x16{}; o[1] = f32x16{};
    const int vb0 = (int)(lds0 + VOFF) + ((lane >> 4) & 1) * 32 + (lane & 3) * 8 + (4 * hi + ((lane & 15) >> 2)) * 64;
    const ATT_LAS char* kp0 = shm3 + hi * 1024 + r32 * 16;
    int t_lo, t_hi;
    if (TYPE == 0) { t_lo = wid >> 1; t_hi = t_lo + 4; }
    else if (TYPE == 1) { const int r = U.tok0 + (wid >> 1); int rs = r - 4; rs = rs < 0 ? 0 : (rs > 248 ? 248 : rs); const int T0 = U.row0 >> 6; t_lo = rs - T0; t_hi = t_lo + 7; }
    else { t_lo = 0; t_hi = NT - 1; }
    int slot = 0;
    for (int t = 0; t < NT; ++t) {
        { const int behind = (NT - 1 - t) < (PF - 1) ? (NT - 1 - t) : (PF - 1);
          if (behind >= 4) asm volatile("s_waitcnt vmcnt(8) lgkmcnt(0)\n\ts_barrier" ::: "memory");
          else if (behind == 3) asm volatile("s_waitcnt vmcnt(6) lgkmcnt(0)\n\ts_barrier" ::: "memory");
          else if (behind == 2) asm volatile("s_waitcnt vmcnt(4) lgkmcnt(0)\n\ts_barrier" ::: "memory");
          else if (behind == 1) asm volatile("s_waitcnt vmcnt(2) lgkmcnt(0)\n\ts_barrier" ::: "memory");
          else asm volatile("s_waitcnt vmcnt(0) lgkmcnt(0)\n\ts_barrier" ::: "memory"); }
        const int nslot = (slot == NSLOT - 1) ? 0 : slot + 1, pslot = (slot == 0) ? NSLOT - 1 : slot - 1;
        if (t + PF < NT) ATT_DMA(t + PF, pslot);
        bool rel = (t >= t_lo) && (t <= t_hi);
        if (TYPE == 0) { const int rb = U.row0 + 64 * t; rel = rel && (rb >= 0) && (rb < U.seqlen); }
        if (rel) {
            f32x16 p0, p1;
            qkt(p0, p1, kp0 + slot * SLOTB, qr);
            if (TYPE == 0) {
                const float dqf = (float)((U.tok0 + wid * 32 + r32) - (U.row0 + 64 * t + 4 * hi));
                if (t == t_lo || t == t_hi) {
#pragma unroll
                    for (int r = 0; r < 16; ++r) { const float cr = (float)((r & 3) + 8 * (r >> 2)); const float a0 = __builtin_fabsf(dqf - cr), a1 = __builtin_fabsf(dqf - (cr + 32.f));
                        p0[r] = (a0 <= 128.f) ? __builtin_fmaf(-U.slope2, a0, p0[r]) : NEG_INF; p1[r] = (a1 <= 128.f) ? __builtin_fmaf(-U.slope2, a1, p1[r]) : NEG_INF; }
                } else {
#pragma unroll
                    for (int r = 0; r < 16; ++r) { const float cr = (float)((r & 3) + 8 * (r >> 2)); const float a0 = __builtin_fabsf(dqf - cr), a1 = __builtin_fabsf(dqf - (cr + 32.f));
                        p0[r] = __builtin_fmaf(-U.slope2, a0, p0[r]); p1[r] = __builtin_fmaf(-U.slope2, a1, p1[r]); }
                }
                ATT_SOFTMAX_PV(ATT_ACT_ALL);
            } else if (TYPE == 1) {
                const int rq = U.tok0 + (wid >> 1), c = 32 * (wid & 1) + r32; int cs = c - 8; cs = cs < 0 ? 0 : (cs > 48 ? 48 : cs);
                const int kr = (U.row0 >> 6) + t;
                const ATT_LAS float* tb = tab + TAB_PAD + (kr - rq + 7) * 31 + 15 - c + 4 * hi;
                const int kc = 4 * hi - cs;
#define ATT_BIAS_B(ACT) do { _Pragma("unroll") for (int r = 0; r < 16; ++r) { const int cr = (r & 3) + 8 * (r >> 2); \
                    if (ACT(0, r)) { float b0 = tb[cr]; asm volatile("" : "+v"(b0)); p0[r] = ((unsigned)(kc + cr) < 16u) ? p0[r] + b0 : NEG_INF; } \
                    if (ACT(1, r)) { float b1 = tb[cr + 32]; asm volatile("" : "+v"(b1)); p1[r] = ((unsigned)(kc + cr + 32) < 16u) ? p1[r] + b1 : NEG_INF; } } } while (0)
                if ((wid & 1) == 0) { ATT_BIAS_B(ATT_ACT_C0); ATT_SOFTMAX_PV(ATT_ACT_C0); }
                else { ATT_BIAS_B(ATT_ACT_C1); ATT_SOFTMAX_PV(ATT_ACT_C1); }
#undef ATT_BIAS_B
            } else {
                ATT_SOFTMAX_PV(ATT_ACT_ALL);
            }
        }
        slot = nslot;
    }
    { auto rr = __builtin_amdgcn_permlane32_swap(__float_as_uint(l), __float_as_uint(l), false, false); l = __uint_as_float(rr[0]) + __uint_as_float(rr[1]); }
    asm volatile("" ::: "memory");
    if (hi == 0) wsf[32 + r32] = l;
    asm volatile("s_waitcnt lgkmcnt(0)" ::: "memory");
    float rli[16];
#pragma unroll
    for (int r = 0; r < 16; ++r) rli[r] = __builtin_amdgcn_rcpf(wsf[32 + crow(r, hi)]);
    { ATT_LAS bf16_t* stg = (ATT_LAS bf16_t*)(lds + LDS_OST) + wid * 2048;
#pragma unroll
      for (int r = 0; r < 16; ++r) { const int orow = crow(r, hi);
#pragma unroll
          for (int d0 = 0; d0 < 2; ++d0) { const unsigned pk = cvtpk_s(o[d0][r] * rli[r], 0.f); stg[orow * 64 + d0 * 32 + r32] = (bf16_t)(pk & 0xffffu); } }
      asm volatile("s_waitcnt lgkmcnt(0)" ::: "memory");
      bf16_t* Ow = U.O + (size_t)(wid * 32) * U.opitch;
#pragma unroll
      for (int i = 0; i < 4; ++i) { const int row = i * 8 + (lane >> 3), ch = lane & 7; const u32x4 v = *(const ATT_LAS u32x4*)(stg + row * 64 + ch * 8); *(u32x4*)(Ow + (size_t)row * U.opitch + ch * 8) = v; } }
    asm volatile("s_waitcnt vmcnt(0) lgkmcnt(0)\n\ts_barrier" ::: "memory");
#undef ATT_DMA
#undef ATT_CLAMP
}
}
constexpr int NWAVES = 8;
constexpr int SEQ = 16384, DM = 1024, DEPTH = 4, NQH = 12, NMH = 4, NMEM = 256, WIN_A = 1536, WIN_B = 2560, DFF = 2816, NGU = 2 * DFF;
constexpr float LOG2E = 1.4426950408889634f, C2 = 0.125f * LOG2E;
constexpr int N_PHASES = 2 + 5 * DEPTH;
#ifndef MK_PER_PHASE
#define MK_PER_PHASE 0
#endif
#ifndef MK_DUP
#define MK_DUP 0
#endif
#ifndef MK_NAIVE
#define MK_NAIVE 0
#endif

constexpr size_t MiB = 1u << 20;
constexpr size_t WS_CTL = 0, CTL_ZERO_BYTES = 1 * MiB;
constexpr size_t WS_SSQA = 1 * MiB, WS_SSQB = 2 * MiB;
constexpr size_t WS_MEMN = 3 * MiB;
constexpr size_t WS_MKV = 4 * MiB;
constexpr size_t WS_WIN = 6 * MiB;
constexpr size_t WS_WOUT = WS_WIN + 16 * MiB, WS_WGU = WS_WOUT + 8 * MiB, WS_WDN = WS_WGU + 44 * MiB, WS_WMKV = WS_WDN + 22 * MiB;
constexpr size_t WS_XB = WS_WMKV + 4 * MiB;
constexpr size_t WS_PROJ = WS_XB + 32 * MiB;
constexpr size_t WS_Y = WS_PROJ + 80 * MiB;
constexpr size_t WS_H = WS_PROJ;
constexpr size_t WS_END = WS_Y + 32 * MiB;
static_assert(WS_END <= 256 * MiB, "d_ws map");
__host__ __device__ constexpr size_t win_off(int l) { return (size_t)((l >> 1) * 8 + (l & 1) * 3) * MiB; }
constexpr int CW_BAR = 4096;

constexpr int RING_OFF = 0, RING_BYTES = 131072, LDSCTL_OFF = 139264, MISC_OFF = LDSCTL_OFF + 320, LDS_BYTES = 147456;
static_assert(att::LDS_END <= LDSCTL_OFF && att::PF == 5, "attention scratch below the control words; the wait ladder in attn_unit is written for PF = 5");

#define GAS __attribute__((address_space(1)))
#define LAS __attribute__((address_space(3)))
typedef unsigned short bf16;
typedef unsigned v4u __attribute__((ext_vector_type(4)));
typedef float f32x4 __attribute__((ext_vector_type(4)));
typedef short bf16x8 __attribute__((ext_vector_type(8)));
typedef GAS unsigned gu32;
typedef GAS unsigned long long gu64;
#define RLX_AGENT __ATOMIC_RELAXED, __HIP_MEMORY_SCOPE_AGENT
#define LDS_WAIT() asm volatile("s_waitcnt lgkmcnt(0)" ::: "memory")
#define VM_WAIT() asm volatile("s_waitcnt vmcnt(0)" ::: "memory")
__device__ __forceinline__ unsigned long long rt() { return __builtin_amdgcn_s_memrealtime(); }
__device__ __forceinline__ unsigned f2bf(float f) { unsigned u = __builtin_bit_cast(unsigned, f); return (u + 0x7fffu + ((u >> 16) & 1u)) >> 16; }
__device__ __forceinline__ unsigned pk2(float lo, float hi) { return f2bf(lo) | (f2bf(hi) << 16); }

#define XB_TMO      128
#define XB_XCNT(j)  (256  + 64 * (j))
#define XB_XSUB(j)  (1280 + 64 * (j))
#define XB_XGEN(j)  (2304 + 64 * (j))
#define XB_TOP      3328
#define XB_TOPGEN   3392
#define XCD_BAR_WORDS 3456
#define XB_SPIN_CAP (1u << 18)

__device__ __forceinline__ unsigned xb_ld(unsigned* p)              { return __hip_atomic_load(p, __ATOMIC_RELAXED, __HIP_MEMORY_SCOPE_AGENT); }
__device__ __forceinline__ unsigned xb_add(unsigned* p, unsigned v) { return __hip_atomic_fetch_add(p, v, __ATOMIC_RELAXED, __HIP_MEMORY_SCOPE_AGENT); }
__device__ __forceinline__ unsigned xb_xcc_id() { return (unsigned)__builtin_amdgcn_s_getreg((3 << 11) | 20) & 0xFu; }
#define XB_SPIN(cond, bar) do { unsigned _sp = 0; while (cond) { __builtin_amdgcn_s_sleep(1); \
    if ((++_sp & 255u) == 0u) { if (xb_ld(&(bar)[XB_TMO])) break; if (_sp > XB_SPIN_CAP) { atomicAdd(&(bar)[XB_TMO], 1u); break; } } } } while (0)

struct XcdBarrier {
    unsigned* bar; unsigned x;
    volatile LAS unsigned* st;
};

__device__ __forceinline__ XcdBarrier xcd_barrier_post(unsigned* bar, volatile LAS unsigned* st) {
    XcdBarrier b; b.bar = bar; b.x = xb_xcc_id(); b.st = st;
    if (threadIdx.x == 0) (void)xb_add(&bar[XB_XCNT(b.x)], 1u);
    return b;
}
__device__ __forceinline__ void xcd_barrier_complete(unsigned* bar, unsigned x, unsigned& nloc, unsigned& nx) {
    const unsigned G = gridDim.x * gridDim.y * gridDim.z;
    unsigned sum, cnt, mine, sp = 0u;
    for (;;) {
        sum = 0u; cnt = 0u; mine = 0u;
#pragma unroll
        for (unsigned j = 0; j < 16; ++j) { const unsigned c = xb_ld(&bar[XB_XCNT(j)]); sum += c; cnt += (c > 0u) ? 1u : 0u; mine = (j == x) ? c : mine; }
        if (sum == G) break;
        __builtin_amdgcn_s_sleep(1);
        if ((++sp & 255u) == 0u) { if (xb_ld(&bar[XB_TMO])) break; if (sp > XB_SPIN_CAP) { atomicAdd(&bar[XB_TMO], 1u); break; } }
    }
    nloc = mine > 0u ? mine : 1u; nx = cnt > 0u ? cnt : 1u;
}

__device__ __forceinline__ void xcd_barrier(const XcdBarrier& b) {
    asm volatile("s_waitcnt vmcnt(0)" ::: "memory");
    __syncthreads();
    if (threadIdx.x == 0) {
        unsigned* bar = b.bar;
        __builtin_amdgcn_s_waitcnt(0);
        unsigned nloc = b.st[0], nx = b.st[1];
        if (nloc == 0u) { xcd_barrier_complete(bar, b.x, nloc, nx); b.st[0] = nloc; b.st[1] = nx; }
        const unsigned old = xb_add(&bar[XB_XSUB(b.x)], 1u);
        const unsigned gen = old / nloc;
        if (old + 1u == (gen + 1u) * nloc) {
            __builtin_amdgcn_fence(__ATOMIC_RELEASE, "agent");
            asm volatile("s_waitcnt vmcnt(0)" ::: "memory");
            const unsigned og = xb_add(&bar[XB_TOP], 1u);
            const unsigned tg = og / nx;
            if (og + 1u == (tg + 1u) * nx) xb_add(&bar[XB_TOPGEN], 1u);
            else XB_SPIN(xb_ld(&bar[XB_TOPGEN]) == tg, bar);
            __builtin_amdgcn_fence(__ATOMIC_ACQUIRE, "agent");
            xb_add(&bar[XB_XGEN(b.x)], 1u);
            asm volatile("s_waitcnt vmcnt(0)" ::: "memory");
        } else {
            XB_SPIN(xb_ld(&bar[XB_XGEN(b.x)]) == gen, bar);
            __builtin_amdgcn_fence(__ATOMIC_ACQUIRE, "agent");
            asm volatile("s_waitcnt vmcnt(0)" ::: "memory");
        }
    }
    __syncthreads();
}
struct Frame {
    LAS unsigned char* lds;
    volatile LAS unsigned* MISC;
    gu32* ctl;
    int tid, lane, wave;
    int vcu, G;
    const float *x, *mem, *norm_mix, *norm_ffn, *norm_mem, *norm_final, *w_in_a, *sink_a, *w_in_b, *rpb_b, *w_mem_kv, *w_out, *w_gate_up, *w_down;
    float* out; unsigned char* ws;
};
__device__ __forceinline__ float wave_sum(float v) {
#pragma unroll
    for (int o = 1; o < 64; o <<= 1) v += __shfl_xor(v, o);
    return v;
}
__device__ __forceinline__ void transpose_item(const float* W, int K, int N, bf16* WT, int mode, const float* g, LAS float* scr, int item, int lane) {
    const int nblk = N / 32, kb = item / nblk, nb = item % nblk, k0 = 64 * kb, n0 = 32 * nb;
    const float gl = g ? g[k0 + lane] : 1.f;
    const float* wp = W + (size_t)(k0 + (lane >> 5)) * N + n0 + (lane & 31);
    float wv[32];
#pragma unroll
    for (int i = 0; i < 32; ++i) wv[i] = wp[(size_t)(2 * i) * N];
#pragma unroll
    for (int i = 0; i < 32; ++i) { const float g0 = __uint_as_float(__builtin_amdgcn_readlane(__float_as_uint(gl), 2 * i)), g1 = __uint_as_float(__builtin_amdgcn_readlane(__float_as_uint(gl), 2 * i + 1));
        scr[(2 * i + (lane >> 5)) * 33 + (lane & 31)] = wv[i] * ((lane >> 5) ? g1 : g0); }
    LDS_WAIT(); asm volatile("" ::: "memory");
    int rbase = n0;
    if (mode == 1) { rbase = (n0 < DFF) ? ((n0 / 128) * 256 + (n0 % 128)) : (((n0 - DFF) / 128) * 256 + 128 + ((n0 - DFF) % 128)); }
    const int c = lane & 7;
#pragma unroll
    for (int j = 0; j < 4; ++j) { const int n = (lane >> 3) + 8 * j; const LAS float* s = scr + (8 * c) * 33 + n;
        v4u o; o.x = pk2(s[0 * 33], s[1 * 33]); o.y = pk2(s[2 * 33], s[3 * 33]); o.z = pk2(s[4 * 33], s[5 * 33]); o.w = pk2(s[6 * 33], s[7 * 33]);
        *(GAS v4u*)(WT + (size_t)(rbase + n) * K + k0 + 8 * c) = o; }
    LDS_WAIT(); asm volatile("" ::: "memory");
}
constexpr int IT_OUT = 16 * 32, IT_GU = 16 * (NGU / 32), IT_DN = (DFF / 64) * 32, IT_MKV = 16 * 16;
__device__ __forceinline__ void convert_part(Frame& F, int l, int part, int gw, int NGW) {
    LAS float* scr = (LAS float*)(F.lds + RING_OFF + F.wave * 16384);
    int lane = F.lane; asm volatile("" : "+v"(lane));
    const int nin = (l & 1) ? WIN_B : WIN_A, iin = 16 * (nin / 32);
    const int n0 = (part == 0) ? iin : (part == 1) ? IT_GU : DEPTH * IT_MKV, ntot = (part == 0) ? iin + IT_OUT : (part == 1) ? IT_GU + IT_DN : DEPTH * IT_MKV;
    for (int it = gw; it < ntot; it += NGW) {
        const float* W; const float* g = nullptr; bf16* WT; int K = DM, N, mode = 0, item = it;
        if (part == 0) {
            if (it < n0) { W = (l & 1) ? F.w_in_b + (size_t)(l >> 1) * DM * WIN_B : F.w_in_a + (size_t)(l >> 1) * DM * WIN_A; N = nin; WT = (bf16*)(F.ws + WS_WIN + win_off(l)); g = F.norm_mix + l * DM; }
            else { W = F.w_out + (size_t)l * DM * DM; N = DM; WT = (bf16*)(F.ws + WS_WOUT + (size_t)l * 2 * MiB); item = it - n0; }
        } else if (part == 1) {
            if (it < n0) { W = F.w_gate_up + (size_t)l * DM * NGU; N = NGU; WT = (bf16*)(F.ws + WS_WGU + (size_t)l * 11 * MiB); mode = 1; g = F.norm_ffn + l * DM; }
            else { W = F.w_down + (size_t)l * DFF * DM; K = DFF; N = DM; WT = (bf16*)(F.ws + WS_WDN + (size_t)l * DFF * DM * 2); item = it - n0; }
        } else { const int lm = it / IT_MKV; W = F.w_mem_kv + (size_t)lm * DM * 512; N = 512; WT = (bf16*)(F.ws + WS_WMKV + (size_t)lm * MiB); item = it % IT_MKV; }
        transpose_item(W, K, N, WT, mode, g, scr, item, lane);
    }
}
__device__ __forceinline__ void convert_filler(Frame& F, int l, int part, int nwg) {
    const int rem = nwg % F.G, c = (int)blockIdx.x;
    if (rem == 0) convert_part(F, l, part, c * NWAVES + F.wave, F.G * NWAVES);
    else if (c >= rem) convert_part(F, l, part, (c - rem) * NWAVES + F.wave, (F.G - rem) * NWAVES);
}
__device__ __forceinline__ void p0_prologue(Frame& F) {
    const int gw = F.vcu * NWAVES + F.wave, NGW = F.G * NWAVES;
    for (int part = 0; part < 3; ++part) convert_part(F, 0, part, gw, NGW);
    for (int m = gw; m < SEQ; m += NGW) {
        const GAS f32x4* xr = (const GAS f32x4*)(F.x + (size_t)m * DM) + F.lane; f32x4 v[4]; float s = 0.f;
#pragma unroll
        for (int j = 0; j < 4; ++j) { v[j] = xr[64 * j]; s += (v[j].x * v[j].x + v[j].y * v[j].y) + (v[j].z * v[j].z + v[j].w * v[j].w); }
        s = wave_sum(s);
        GAS unsigned long long* o8 = (GAS unsigned long long*)(F.ws + WS_XB + (size_t)m * DM * 2) + F.lane;
#pragma unroll
        for (int j = 0; j < 4; ++j) o8[64 * j] = (unsigned long long)pk2(v[j].x, v[j].y) | ((unsigned long long)pk2(v[j].z, v[j].w) << 32);
        if (F.lane < 16) ((GAS float*)(F.ws + WS_SSQA))[(size_t)m * 16 + F.lane] = (F.lane == 0) ? s : 0.f;
    }
    for (int m = gw; m < NMEM; m += NGW) {
        const GAS f32x4* xr = (const GAS f32x4*)(F.mem + (size_t)m * DM) + F.lane; const GAS f32x4* gr = (const GAS f32x4*)F.norm_mem + F.lane; f32x4 v[4]; float s = 0.f;
#pragma unroll
        for (int j = 0; j < 4; ++j) { v[j] = xr[64 * j]; s += (v[j].x * v[j].x + v[j].y * v[j].y) + (v[j].z * v[j].z + v[j].w * v[j].w); }
        const float rstd = 1.0f / sqrtf(wave_sum(s) * (1.0f / DM) + 1e-6f);
        GAS unsigned long long* o8 = (GAS unsigned long long*)(F.ws + WS_MEMN + (size_t)m * DM * 2) + F.lane;
#pragma unroll
        for (int j = 0; j < 4; ++j) { const f32x4 g = gr[64 * j]; const f32x4 y = v[j] * rstd * g; o8[64 * j] = (unsigned long long)pk2(y.x, y.y) | ((unsigned long long)pk2(y.z, y.w) << 32); }
    }
}
__device__ __forceinline__ void final_norm(Frame& F) {
    const int gw = F.vcu * NWAVES + F.wave, NGW = F.G * NWAVES;
    const GAS f32x4* gr = (const GAS f32x4*)F.norm_final + F.lane;
    for (int m = gw; m < SEQ; m += NGW) {
        GAS f32x4* xr = (GAS f32x4*)(F.out + (size_t)m * DM) + F.lane;
        const float rstd = pg8::row_rstd((const float*)(F.ws + WS_SSQA), m);
#pragma unroll
        for (int j = 0; j < 4; ++j) { const f32x4 v = xr[64 * j], g = gr[64 * j]; xr[64 * j] = v * rstd * g; }
    }
}
__device__ __forceinline__ void attn_phase(Frame& F, int l, int amask) {
    const bool isA = (l & 1) == 0; const int pitch = isA ? WIN_A : WIN_B;
    const att::bf16_t* P = (const att::bf16_t*)(F.ws + WS_PROJ); att::bf16_t* Y = (att::bf16_t*)(F.ws + WS_Y);
    const att::bf16_t* MKV = (const att::bf16_t*)(F.ws + WS_MKV) + l * 512;
    for (int u = F.vcu; u < 1024; u += F.G) {
        att::UnitP U; U.seqlen = SEQ; U.rpb = nullptr; U.slope2 = 0.f; U.m0 = -1e30f; U.l0 = 0.f;
        if (u < 768) {
            if (!(amask & 1)) continue;
            const int h = u % NQH, blk = u / NQH, tok0 = blk * 256;
            U.Q = P + (size_t)tok0 * pitch + h * 64; U.qpitch = pitch; U.O = Y + (size_t)tok0 * DM + h * 64; U.opitch = DM; U.kvpitch = pitch; U.kvmax = SEQ - 1;
            if (isA) {
                U.K = P + 768 + (h / 3) * 64; U.V = P + 1024 + (h / 3) * 64; U.row0 = tok0 - 128; U.ntiles = 8; U.tok0 = tok0;
                U.slope2 = exp2f(-8.0f * (float)(h + 1) / 12.0f) * LOG2E; U.m0 = F.sink_a[(l >> 1) * NQH + h] * LOG2E; U.l0 = 1.f;
                att::attn_unit<0>(U, F.lds + RING_OFF);
            } else {
                const int R0 = blk * 4; int T0 = R0 - 4; T0 = T0 < 0 ? 0 : (T0 > 248 ? 248 : T0); int T1 = R0 - 1; T1 = T1 < 0 ? 0 : (T1 > 248 ? 248 : T1); T1 += 7;
                U.K = P + 768 + h * 64; U.V = P + 1536 + h * 64; U.row0 = T0 * 64; U.ntiles = T1 - T0 + 1; U.tok0 = R0;
                U.rpb = F.rpb_b + ((size_t)(l >> 1) * NQH + h) * 15 * 31;
                att::attn_unit<1>(U, F.lds + RING_OFF);
            }
        } else {
            if (!(amask & 2)) continue;
            const int v = u - 768, hm = v % NMH, blk = v / NMH, tok0 = blk * 256;
            U.Q = P + (size_t)tok0 * pitch + (pitch - 256) + hm * 64; U.qpitch = pitch; U.O = Y + (size_t)tok0 * DM + 768 + hm * 64; U.opitch = DM;
            U.K = MKV + hm * 64; U.V = MKV + 256 + hm * 64; U.kvpitch = 2048; U.kvmax = NMEM - 1; U.row0 = 0; U.ntiles = 4; U.tok0 = tok0;
            att::attn_unit<2>(U, F.lds + RING_OFF);
        }
    }
}

struct Args { const float* in[14]; float* out; unsigned char* ws; int ph_lo, ph_hi, li, amask; };
__global__ void __launch_bounds__(NWAVES * 64, 2) skel_fwd(Args args) {
    extern __shared__ __attribute__((aligned(16))) unsigned char lds[];
    Frame F;
    F.lds = (LAS unsigned char*)lds;
    F.MISC = (volatile LAS unsigned*)(F.lds + MISC_OFF);
    F.tid = threadIdx.x; F.lane = F.tid & 63; F.wave = __builtin_amdgcn_readfirstlane(F.tid >> 6);
    F.G = gridDim.x; { const int bx = blockIdx.x; F.vcu = (F.G % 8 == 0) ? (bx % 8) * (F.G / 8) + bx / 8 : bx; }
    F.ws = args.ws; F.out = args.out; F.ctl = (gu32*)(args.ws + WS_CTL);
    F.x = args.in[0]; F.mem = args.in[1]; F.norm_mix = args.in[2]; F.norm_ffn = args.in[3]; F.norm_mem = args.in[4]; F.norm_final = args.in[5]; F.w_in_a = args.in[6]; F.sink_a = args.in[7];
    F.w_in_b = args.in[8]; F.rpb_b = args.in[9]; F.w_mem_kv = args.in[10]; F.w_out = args.in[11]; F.w_gate_up = args.in[12]; F.w_down = args.in[13];
    for (int u = F.tid; u < (LDS_BYTES - LDSCTL_OFF) / 4; u += NWAVES * 64) ((LAS unsigned*)(F.lds + LDSCTL_OFF))[u] = 0u;
    __syncthreads();
    XcdBarrier bar; bar.bar = (unsigned*)(F.ctl + CW_BAR) + args.li * XCD_BAR_WORDS; bar.x = 0; bar.st = nullptr;
    if (!MK_PER_PHASE) bar = xcd_barrier_post((unsigned*)(F.ctl + CW_BAR) + args.li * XCD_BAR_WORDS, F.MISC + 8);
    const int lo = args.ph_lo, hi = args.ph_hi;
#define IN(k) (lo <= (k) && (k) < hi)
#define SEAM(k) do { if (IN((k) + 1)) xcd_barrier(bar); } while (0)
    typedef pg8::bf16_t pb;
    if (IN(0)) { for (int rep = 0; rep < ((MK_DUP & 1) ? 2 : 1); ++rep) { p0_prologue(F); SEAM(0); } }
    for (int l = 0; l < DEPTH; ++l) {
        const int pb0 = 1 + 5 * l; const bool isA = (l & 1) == 0; const int nin = isA ? WIN_A : WIN_B;
        if (IN(pb0)) { for (int rep = 0; rep < ((MK_DUP & 2) ? 2 : 1); ++rep) {
            { pg8::Gemm g{(const pb*)(F.ws + WS_XB), (const pb*)(F.ws + WS_WIN + win_off(l)), SEQ, nin, DM}; pg8::StaticOrder S; S.init(SEQ, nin, F.G, (int)blockIdx.x);
              pg8::EpiProj E{(pb*)(F.ws + WS_PROJ), nin, (const float*)(F.ws + WS_SSQA), 3, nin / 256 - 1, C2};
              pg8::gemm_phase<pg8::EpiProj, pg8::StaticOrder, true, true>(F.lds + RING_OFF, g, S, E); }
            if (l == 0) { pg8::Gemm g{(const pb*)(F.ws + WS_MEMN), (const pb*)(F.ws + WS_WMKV), NMEM, 2048, DM}; pg8::StaticOrder S; S.init(NMEM, 2048, F.G, (int)((blockIdx.x + F.G - 8) % F.G));
              pg8::EpiProj E{(pb*)(F.ws + WS_MKV), 2048, nullptr, 0, -1, 1.f};
              pg8::gemm_phase<pg8::EpiProj, pg8::StaticOrder, true, true>(F.lds + RING_OFF, g, S, E); }
            if (l + 1 < DEPTH) convert_filler(F, l + 1, 0, (SEQ / 256) * (nin / 256));
            SEAM(pb0); }
        }
        if (IN(pb0 + 1)) { for (int rep = 0; rep < ((MK_DUP & 4) ? 2 : 1); ++rep) { attn_phase(F, l, args.amask); SEAM(pb0 + 1); } }
        if (IN(pb0 + 2)) {
            pg8::Gemm g{(const pb*)(F.ws + WS_Y), (const pb*)(F.ws + WS_WOUT + (size_t)l * 2 * MiB), SEQ, DM, DM}; pg8::StaticOrder S; S.init(SEQ, DM, F.G, (int)blockIdx.x);
            pg8::EpiRes E{l == 0 ? F.x : (const float*)F.out, F.out, (pb*)(F.ws + WS_XB), (float*)(F.ws + WS_SSQB), DM};
            pg8::gemm_phase<pg8::EpiRes, pg8::StaticOrder, true, true>(F.lds + RING_OFF, g, S, E);
            SEAM(pb0 + 2);
        }
        if (IN(pb0 + 3)) { for (int rep = 0; rep < ((MK_DUP & 8) ? 2 : 1); ++rep) {
            pg8::Gemm g{(const pb*)(F.ws + WS_XB), (const pb*)(F.ws + WS_WGU + (size_t)l * 11 * MiB), SEQ, NGU, DM}; pg8::StaticOrder S; S.init(SEQ, NGU, F.G, (int)blockIdx.x);
            pg8::EpiGU E{(pb*)(F.ws + WS_H), DFF, (const float*)(F.ws + WS_SSQB)};
            pg8::gemm_phase<pg8::EpiGU, pg8::StaticOrder, true, true>(F.lds + RING_OFF, g, S, E);
            if (l + 1 < DEPTH) convert_filler(F, l + 1, 1, (SEQ / 256) * (NGU / 256));
            SEAM(pb0 + 3); }
        }
        if (IN(pb0 + 4)) {
            pg8::Gemm g{(const pb*)(F.ws + WS_H), (const pb*)(F.ws + WS_WDN + (size_t)l * DFF * DM * 2), SEQ, DM, DFF}; pg8::StaticOrder S; S.init(SEQ, DM, F.G, (int)blockIdx.x);
            pg8::EpiRes E{(const float*)F.out, F.out, (pb*)(F.ws + WS_XB), (float*)(F.ws + WS_SSQA), DM};
            pg8::gemm_phase<pg8::EpiRes, pg8::StaticOrder, true, true>(F.lds + RING_OFF, g, S, E);
            SEAM(pb0 + 4);
        }
    }
    if (IN(N_PHASES - 1)) final_norm(F);
#undef IN
#undef SEAM
}
#if MK_PER_PHASE && MK_NAIVE
namespace nv {
__device__ __forceinline__ float bf2f(unsigned short b) { return __uint_as_float((unsigned)b << 16); }
struct GArgs { const bf16* A; const bf16* Bt; int M, N, K, mode;
    bf16* O; int ldc; const float* ssq; int nq_tiles, qm_tile; float qscale;
    const float* base; float* out; bf16* xb; };
__global__ void __launch_bounds__(256) naive_gemm(GArgs a) {
    __shared__ float As[16][65], Bs[16][65], Bs2[16][65];
    const int tx = threadIdx.x & 15, ty = threadIdx.x >> 4, bx = blockIdx.x, by = blockIdx.y;
    float acc[4][4], acc2[4][4];
#pragma unroll
    for (int i = 0; i < 4; ++i)
#pragma unroll
        for (int j = 0; j < 4; ++j) { acc[i][j] = 0.f; acc2[i][j] = 0.f; }
    const int lr = threadIdx.x >> 2, lk = (threadIdx.x & 3) * 4;
    const int jc = bx * 64 + lr;
    const size_t brow = (a.mode == 2) ? (size_t)((jc / 128) * 256 + (jc % 128)) : (size_t)jc;
    for (int k0 = 0; k0 < a.K; k0 += 16) {
        const bf16* ap = a.A + (size_t)(by * 64 + lr) * a.K + k0 + lk; const bf16* bp = a.Bt + brow * a.K + k0 + lk;
#pragma unroll
        for (int i = 0; i < 4; ++i) { As[lk + i][lr] = bf2f(ap[i]); Bs[lk + i][lr] = bf2f(bp[i]); if (a.mode == 2) Bs2[lk + i][lr] = bf2f(bp[(size_t)128 * a.K + i]); }
        __syncthreads();
#pragma unroll
        for (int k = 0; k < 16; ++k) {
#pragma unroll
            for (int i = 0; i < 4; ++i)
#pragma unroll
                for (int j = 0; j < 4; ++j) { acc[i][j] += As[k][ty * 4 + i] * Bs[k][tx * 4 + j]; if (a.mode == 2) acc2[i][j] += As[k][ty * 4 + i] * Bs2[k][tx * 4 + j]; }
        }
        __syncthreads();
    }
#pragma unroll
    for (int i = 0; i < 4; ++i)
#pragma unroll
        for (int j = 0; j < 4; ++j) {
            const int row = by * 64 + ty * 4 + i, col = bx * 64 + tx * 4 + j;
            if (a.mode == 0) { float rs = 1.f; if (a.ssq) { float s = 0.f; for (int q = 0; q < 16; ++q) s += a.ssq[(size_t)row * 16 + q]; rs = 1.0f / sqrtf(s * (1.0f / 1024.0f) + 1e-6f); }
                const int pn = col / 256; const float sc = (pn < a.nq_tiles || pn == a.qm_tile) ? a.qscale : 1.f;
                a.O[(size_t)row * a.ldc + col] = (bf16)f2bf(acc[i][j] * rs * sc); }
            else if (a.mode == 1) { const size_t o = (size_t)row * a.ldc + col; const float v = a.base[o] + acc[i][j]; a.out[o] = v; a.xb[o] = (bf16)f2bf(v); }
            else { float s = 0.f; for (int q = 0; q < 16; ++q) s += a.ssq[(size_t)row * 16 + q]; const float rs = 1.0f / sqrtf(s * (1.0f / 1024.0f) + 1e-6f);
                const float g = acc[i][j] * rs, u = acc2[i][j] * rs; a.O[(size_t)row * a.ldc + col] = (bf16)f2bf(g / (1.0f + expf(-g)) * u); }
        }
}
__global__ void __launch_bounds__(256) naive_ssq(const float* x, float* ssq) {
    const int row = blockIdx.x * 256 + threadIdx.x; float s = 0.f;
    for (int c = 0; c < DM; ++c) { const float v = x[(size_t)row * DM + c]; s += v * v; }
    for (int q = 0; q < 16; ++q) ssq[(size_t)row * 16 + q] = (q == 0) ? s : 0.f;
}
__device__ __forceinline__ void ld64(const bf16* p, float (&v)[64]) {
#pragma unroll
    for (int c = 0; c < 8; ++c) { const uint4 w = *(const uint4*)(p + 8 * c); const unsigned ww[4] = {w.x, w.y, w.z, w.w};
#pragma unroll
        for (int e = 0; e < 4; ++e) { v[8 * c + 2 * e] = __uint_as_float(ww[e] << 16); v[8 * c + 2 * e + 1] = __uint_as_float(ww[e] & 0xffff0000u); } }
}
__global__ void __launch_bounds__(256) naive_attn(int type, const bf16* P, int pitch, const bf16* MKV, const float* sink, const float* rpb, bf16* Y) {
    const int idx = blockIdx.x * 256 + threadIdx.x; const int nh = (type == 2) ? NMH : NQH; const int h = idx % nh, t = idx / nh;
    float q[64], o[64], kv[64];
    ld64(P + (size_t)t * pitch + (type == 2 ? (pitch - 256) : 0) + h * 64, q);
#pragma unroll
    for (int d = 0; d < 64; ++d) o[d] = 0.f;
    float m = -1e30f, l = 0.f;
    int nkeys; if (type == 0) { m = sink[h] * LOG2E; l = 1.f; nkeys = 257; } else if (type == 1) nkeys = 128; else nkeys = 256;
    const float slope2 = exp2f(-8.0f * (float)(h + 1) / 12.0f) * LOG2E;
    const int r = t / 64, c = t % 64; int rs = r - 4; rs = rs < 0 ? 0 : (rs > 248 ? 248 : rs); int cs = c - 8; cs = cs < 0 ? 0 : (cs > 48 ? 48 : cs);
    for (int i = 0; i < nkeys; ++i) {
        const bf16 *kp, *vp; float bias = 0.f;
        if (type == 0) { const int s = t - 128 + i; if (s < 0 || s >= SEQ) continue; kp = P + (size_t)s * pitch + 768 + (h / 3) * 64; vp = P + (size_t)s * pitch + 1024 + (h / 3) * 64; bias = -slope2 * fabsf((float)(t - s)); }
        else if (type == 1) { const int kr = rs + (i >> 4), kc = cs + (i & 15); const int s = kr * 64 + kc; kp = P + (size_t)s * pitch + 768 + h * 64; vp = P + (size_t)s * pitch + 1536 + h * 64;
            bias = rpb[(size_t)h * 15 * 31 + (kr - r + 7) * 31 + (kc - c + 15)] * LOG2E; }
        else { kp = MKV + (size_t)i * 2048 + h * 64; vp = MKV + (size_t)i * 2048 + 256 + h * 64; }
        ld64(kp, kv); float dot = 0.f;
#pragma unroll
        for (int d = 0; d < 64; ++d) dot += q[d] * kv[d];
        const float sc = dot + bias, mn = fmaxf(m, sc), al = exp2f(m - mn), p = exp2f(sc - mn);
        ld64(vp, kv); l = l * al + p;
#pragma unroll
        for (int d = 0; d < 64; ++d) o[d] = o[d] * al + p * kv[d];
        m = mn;
    }
    const float il = 1.0f / l; bf16* yp = Y + (size_t)t * DM + (type == 2 ? 768 : 0) + h * 64;
#pragma unroll
    for (int d = 0; d < 64; ++d) yp[d] = (bf16)f2bf(o[d] * il);
}
}
#endif
extern "C" void kernel_launch(void* const* d_in, const int* in_sizes, int n_in, void* d_out, int out_size, void* d_ws, size_t ws_size, hipStream_t stream) {
    static int grid = 0;
    if (grid == 0) {
        if (n_in != 14 || in_sizes[0] != SEQ * DM || out_size != SEQ * DM || ws_size < WS_END) { fprintf(stderr, "kernel_launch: unexpected shapes (n_in %d, in0 %d, out %d, ws %zu); nothing launched\n", n_in, n_in > 0 ? in_sizes[0] : -1, out_size, ws_size); grid = -1; return; }
        int dev = 0, cus = 0, per_cu = 0;
        if (hipGetDevice(&dev) != hipSuccess || hipDeviceGetAttribute(&cus, hipDeviceAttributeMultiprocessorCount, dev) != hipSuccess) { grid = -1; return; }
        if (hipFuncSetAttribute((const void*)skel_fwd, hipFuncAttributeMaxDynamicSharedMemorySize, LDS_BYTES) != hipSuccess) { fprintf(stderr, "kernel_launch: hipFuncSetAttribute failed\n"); grid = -1; return; }
        if (hipOccupancyMaxActiveBlocksPerMultiprocessor(&per_cu, (const void*)skel_fwd, NWAVES * 64, LDS_BYTES) != hipSuccess || per_cu < 1)
            fprintf(stderr, "kernel_launch: note: occupancy query reports %d workgroups per CU\n", per_cu);
        (void)hipGetLastError();
        grid = cus;
    }
    if (grid < 0) return;
    if (hipMemsetAsync((char*)d_ws + WS_CTL, 0, CTL_ZERO_BYTES, stream) != hipSuccess) return;
    Args a{};
    for (int i = 0; i < 14; ++i) a.in[i] = (const float*)d_in[i];
    a.out = (float*)d_out; a.ws = (unsigned char*)d_ws; a.amask = 3;
#if MK_PER_PHASE
    unsigned char* ws = (unsigned char*)d_ws; const float* const* in = (const float* const*)d_in;
    for (int p = 0; p < N_PHASES; ++p) {
        const int l = (p - 1) / 5, k = (p - 1) % 5; const bool mid = (p > 0 && p < N_PHASES - 1);
        (void)l; (void)k; (void)ws; (void)in;
#if MK_NAIVE
        if (mid && (MK_NAIVE & 1) && k != 1) {
            const int nin = (l & 1) ? WIN_B : WIN_A;
            nv::GArgs g{};
            if (k == 0) { g.A = (const bf16*)(ws + WS_XB); g.Bt = (const bf16*)(ws + WS_WIN + win_off(l)); g.M = SEQ; g.N = nin; g.K = DM; g.mode = 0; g.O = (bf16*)(ws + WS_PROJ); g.ldc = nin; g.ssq = (const float*)(ws + WS_SSQA);
                g.nq_tiles = 3; g.qm_tile = nin / 256 - 1; g.qscale = C2;
                hipLaunchKernelGGL(nv::naive_gemm, dim3(g.N / 64, g.M / 64), dim3(256), 0, stream, g);
                if (l == 0) { nv::GArgs m{}; m.A = (const bf16*)(ws + WS_MEMN); m.Bt = (const bf16*)(ws + WS_WMKV); m.M = NMEM; m.N = 2048; m.K = DM; m.mode = 0; m.O = (bf16*)(ws + WS_MKV); m.ldc = 2048; m.ssq = nullptr; m.nq_tiles = 0; m.qm_tile = -1; m.qscale = 1.f;
                    hipLaunchKernelGGL(nv::naive_gemm, dim3(m.N / 64, m.M / 64), dim3(256), 0, stream, m); } }
            else if (k == 2) { g.A = (const bf16*)(ws + WS_Y); g.Bt = (const bf16*)(ws + WS_WOUT + (size_t)l * 2 * MiB); g.M = SEQ; g.N = DM; g.K = DM; g.mode = 1; g.ldc = DM; g.base = (l == 0) ? in[0] : (const float*)d_out; g.out = (float*)d_out; g.xb = (bf16*)(ws + WS_XB);
                hipLaunchKernelGGL(nv::naive_gemm, dim3(g.N / 64, g.M / 64), dim3(256), 0, stream, g);
                hipLaunchKernelGGL(nv::naive_ssq, dim3(SEQ / 256), dim3(256), 0, stream, (const float*)d_out, (float*)(ws + WS_SSQB)); }
            else if (k == 3) { g.A = (const bf16*)(ws + WS_XB); g.Bt = (const bf16*)(ws + WS_WGU + (size_t)l * 11 * MiB); g.M = SEQ; g.N = DFF; g.K = DM; g.mode = 2; g.O = (bf16*)(ws + WS_H); g.ldc = DFF; g.ssq = (const float*)(ws + WS_SSQB);
                hipLaunchKernelGGL(nv::naive_gemm, dim3(g.N / 64, g.M / 64), dim3(256), 0, stream, g); }
            else { g.A = (const bf16*)(ws + WS_H); g.Bt = (const bf16*)(ws + WS_WDN + (size_t)l * DFF * DM * 2); g.M = SEQ; g.N = DM; g.K = DFF; g.mode = 1; g.ldc = DM; g.base = (const float*)d_out; g.out = (float*)d_out; g.xb = (bf16*)(ws + WS_XB);
                hipLaunchKernelGGL(nv::naive_gemm, dim3(g.N / 64, g.M / 64), dim3(256), 0, stream, g);
                hipLaunchKernelGGL(nv::naive_ssq, dim3(SEQ / 256), dim3(256), 0, stream, (const float*)d_out, (float*)(ws + WS_SSQA)); }
            continue;
        }
        a.amask = 3;
        if (mid && k == 1) {
            const int pitch = (l & 1) ? WIN_B : WIN_A; const bf16* P = (const bf16*)(ws + WS_PROJ); const bf16* MKV = (const bf16*)(ws + WS_MKV) + l * 512; bf16* Y = (bf16*)(ws + WS_Y);
            if (MK_NAIVE & ((l & 1) ? 4 : 2)) { a.amask &= ~1;
                hipLaunchKernelGGL(nv::naive_attn, dim3(SEQ * NQH / 256), dim3(256), 0, stream, (l & 1), P, pitch, MKV, in[7] + (l >> 1) * NQH, in[9] + (size_t)(l >> 1) * NQH * 15 * 31, Y); }
            if (MK_NAIVE & 8) { a.amask &= ~2;
                hipLaunchKernelGGL(nv::naive_attn, dim3(SEQ * NMH / 256), dim3(256), 0, stream, 2, P, pitch, MKV, in[7], in[9], Y); }
            if (a.amask == 0) continue;
        }
#endif
        a.ph_lo = p; a.ph_hi = p + 1; a.li = p;
        hipLaunchKernelGGL(skel_fwd, dim3(grid), dim3(NWAVES * 64), LDS_BYTES, stream, a);
    }
#else
    a.ph_lo = 0; a.ph_hi = N_PHASES; a.li = 0;
    hipLaunchKernelGGL(skel_fwd, dim3(grid), dim3(NWAVES * 64), LDS_BYTES, stream, a);
#endif
    const hipError_t le = hipPeekAtLastError();
    if (le != hipSuccess) fprintf(stderr, "kernel_launch: launch failed: %s\n", hipGetErrorName(le));
}
```

```cpp
#define MK_PER_PHASE 0
#define MK_NAIVE 0
#include <hip/hip_runtime.h>
#include <cstdio>
#include <cstdint>
namespace pg8 {
#define PG8_LAS __attribute__((address_space(3)))
typedef unsigned short bf16_t;
typedef short bf16x8 __attribute__((ext_vector_type(8)));
typedef float f32x4 __attribute__((ext_vector_type(4)));
typedef unsigned u32x4 __attribute__((ext_vector_type(4)));
constexpr int BM = 256, BK = 64, HALF = 128, HTB = HALF * BK * 2  , STAGE_BYTES = 8 * HTB, NXCD = 8, WGM = 8;

__host__ __device__ __forceinline__ int lds_byte(int r, int c) { const int st = (r >> 4) * 2 + (c >> 5), rr = r & 15, cc = c & 31, ob = rr * 64 + cc * 2; return st * 1024 + (ob ^ (((ob >> 9) & 1) << 5)); }
__host__ __device__ __forceinline__ void stage_rc(int b, int& R, int& C) { const int st = b / 1024, sb = b % 1024, swz = sb ^ (((sb >> 9) & 1) << 5); R = (st >> 1) * 16 + swz / 64; C = (st & 1) * 32 + (swz % 64) / 2; }
__host__ __device__ __forceinline__ int perm32(int rho) { const int n = rho >> 4, i = rho & 15; return 8 * (i >> 2) + 4 * n + (i & 3); }

struct Unit { int pm, pn; };
struct Gemm { const bf16_t* A; const bf16_t* Bt; int M, N, K; };

struct StaticOrder {
    int nM, nN, nwg, G, c;
    __host__ __device__ void init(int M, int N, int G_, int c_) { nM = M / BM; nN = N / BM; nwg = nM * nN; G = G_; c = c_; }
    __host__ __device__ bool next(int i, Unit& u) const {
        const long L = (long)i * G + c; if (L >= nwg) return false;
        int wgid = (int)L; { const int q = nwg / NXCD, r = nwg % NXCD, xcd = wgid % NXCD, off = wgid / NXCD; wgid = (xcd < r ? xcd * (q + 1) : r * (q + 1) + (xcd - r) * q) + off; }
        const int nig = WGM * nN, gid = wgid / nig, fm = gid * WGM, gsz = (nM - fm) < WGM ? (nM - fm) : WGM;
        u.pm = fm + ((wgid % nig) % gsz); u.pn = (wgid % nig) / gsz; return true;
    }
    __device__ __forceinline__ void a_ready(const Unit&) const {}
    __device__ __forceinline__ void done(const Unit&) const {}
};

__device__ __forceinline__ unsigned cvt_pk_bf16(float lo, float hi) { unsigned r; asm volatile("v_cvt_pk_bf16_f32 %0, %1, %2" : "=v"(r) : "v"(lo), "v"(hi)); return r; }
typedef float f32x2 __attribute__((ext_vector_type(2)));
__device__ __forceinline__ float row_rstd(const float* ssq, int row) {
    const f32x4* p = (const f32x4*)(ssq + (size_t)row * 16);
    const f32x4 a = p[0], b = p[1], c = p[2], d = p[3];
    const float s = (((a[0] + a[1]) + (a[2] + a[3])) + ((b[0] + b[1]) + (b[2] + b[3]))) + (((c[0] + c[1]) + (c[2] + c[3])) + ((d[0] + d[1]) + (d[2] + d[3])));
    return __builtin_amdgcn_rsqf(s * (1.0f / 1024.0f) + 1e-6f);
}
struct EpiProj {
    static constexpr bool PERM = true, AFTER_DRAIN = false;
    bf16_t* O; size_t hstride; const float* ssq; int nq_tiles, qm_tile; float qscale;
    __device__ __forceinline__ void operator()(const f32x4 (&acc)[2][2][4][2], const Unit& u, int wr, int wc, int fr, int fq) const {
        const int row0 = u.pm * BM + wr * 64 + fr;
        const float sc = (u.pn < nq_tiles || u.pn == qm_tile) ? qscale : 1.f;
        const int col0 = u.pn * BM + wc * 32 + 8 * fq;
#pragma unroll
        for (int ai = 0; ai < 2; ++ai)
#pragma unroll
            for (int m = 0; m < 4; ++m) { const int row = row0 + ai * HALF + m * 16; const float rs = ssq ? row_rstd(ssq, row) * sc : sc;
                bf16_t* rowp = O + (size_t)(col0 >> 6) * hstride + (size_t)row * 64 + (col0 & 63);
#pragma unroll
                for (int bj = 0; bj < 2; ++bj) { const f32x4 v0 = acc[ai][bj][m][0] * rs, v1 = acc[ai][bj][m][1] * rs;
                    u32x4 w; w.x = cvt_pk_bf16(v0[0], v0[1]); w.y = cvt_pk_bf16(v0[2], v0[3]); w.z = cvt_pk_bf16(v1[0], v1[1]); w.w = cvt_pk_bf16(v1[2], v1[3]);
                    *(u32x4*)(rowp + bj * 2 * hstride) = w; } }
    }
};
struct EpiRes {
    static constexpr bool PERM = true, AFTER_DRAIN = false;
    const float* base; float* out; bf16_t* xb; float* ssq_out; int ldc;
    __device__ __forceinline__ void operator()(const f32x4 (&acc)[2][2][4][2], const Unit& u, int wr, int wc, int fr, int fq) const {
        const int row0 = u.pm * BM + wr * 64 + fr;
        const int col0 = u.pn * BM + wc * 32 + 8 * fq;
#pragma unroll
        for (int ai = 0; ai < 2; ++ai)
#pragma unroll
            for (int m = 0; m < 4; ++m) { const int row = row0 + ai * HALF + m * 16; const size_t off = (size_t)row * ldc + col0; float ss = 0.f;
#pragma unroll
                for (int bj = 0; bj < 2; ++bj) { const f32x4 b0 = *(const f32x4*)(base + off + bj * HALF), b1 = *(const f32x4*)(base + off + bj * HALF + 4);
                    const f32x4 v0 = b0 + acc[ai][bj][m][0], v1 = b1 + acc[ai][bj][m][1];
                    *(f32x4*)(out + off + bj * HALF) = v0; *(f32x4*)(out + off + bj * HALF + 4) = v1;
                    u32x4 w; w.x = cvt_pk_bf16(v0[0], v0[1]); w.y = cvt_pk_bf16(v0[2], v0[3]); w.z = cvt_pk_bf16(v1[0], v1[1]); w.w = cvt_pk_bf16(v1[2], v1[3]);
                    *(u32x4*)(xb + off + bj * HALF) = w;
                    ss += ((v0[0] * v0[0] + v0[1] * v0[1]) + (v0[2] * v0[2] + v0[3] * v0[3])) + ((v1[0] * v1[0] + v1[1] * v1[1]) + (v1[2] * v1[2] + v1[3] * v1[3])); }
                ss += __shfl_xor(ss, 16); ss += __shfl_xor(ss, 32);
                if (fq == 0) ssq_out[(size_t)row * 16 + u.pn * 4 + wc] = ss; }
    }
};
struct EpiGU {
    static constexpr bool PERM = true, AFTER_DRAIN = false;
    bf16_t* H; int ldh; const float* ssq;
    static __device__ __forceinline__ float swi(float g, float u) { return g * u * __builtin_amdgcn_rcpf(1.0f + __builtin_amdgcn_exp2f(-1.4426950408889634f * g)); }
    __device__ __forceinline__ void operator()(const f32x4 (&acc)[2][2][4][2], const Unit& u, int wr, int wc, int fr, int fq) const {
        const int row0 = u.pm * BM + wr * 64 + fr;
        const int col0 = u.pn * HALF + wc * 32 + 8 * fq;
#pragma unroll
        for (int ai = 0; ai < 2; ++ai)
#pragma unroll
            for (int m = 0; m < 4; ++m) { const int row = row0 + ai * HALF + m * 16; const float rs = row_rstd(ssq, row);
                const f32x4 g0 = acc[ai][0][m][0] * rs, g1 = acc[ai][0][m][1] * rs, u0 = acc[ai][1][m][0] * rs, u1 = acc[ai][1][m][1] * rs;
                u32x4 w; w.x = cvt_pk_bf16(swi(g0[0], u0[0]), swi(g0[1], u0[1])); w.y = cvt_pk_bf16(swi(g0[2], u0[2]), swi(g0[3], u0[3]));
                w.z = cvt_pk_bf16(swi(g1[0], u1[0]), swi(g1[1], u1[1])); w.w = cvt_pk_bf16(swi(g1[2], u1[2]), swi(g1[3], u1[3]));
                *(u32x4*)(H + (size_t)row * ldh + col0) = w; }
    }
};
template <class Epi, class Sched, bool ALIGN_EPI = false, bool SP2 = false>
__device__ __forceinline__ void gemm_phase(PG8_LAS unsigned char* lds, const Gemm g, const Sched& S, const Epi& E) {
    int tid_ = threadIdx.x; asm volatile("" : "+v"(tid_));
    const int tid = tid_, wid = __builtin_amdgcn_readfirstlane(tid >> 6), lane = tid & 63, wr = wid >> 2, wc = wid & 3, fr = lane & 15, fq = lane >> 4;
    const int K = g.K, nt = K / BK;
    unsigned voffA[2], voffB[2];
#pragma unroll
    for (int i = 0; i < 2; ++i) { int R, C; stage_rc(tid * 16 + i * 8192, R, C); const int Rb = Epi::PERM ? ((R & ~31) + perm32(R & 31)) : R;
        voffA[i] = (unsigned)(R * K + C) * 2u; voffB[i] = (unsigned)(Rb * K + C) * 2u; }
    const size_t kstep = (size_t)(BK * 2);
    const size_t hstep = (size_t)HALF * K * 2;
    const size_t tstep = 2 * hstep;
    const unsigned ldsw = (unsigned)wid * 1024u;
    const int aoff = lds_byte(wr * 64 + fr, fq * 8), boff = lds_byte(wc * 32 + fr, fq * 8);
#define PG8_SA(b, h) (((b) * 2 + (h)) * HTB)
#define PG8_SB(b, h) ((4 + (b) * 2 + (h)) * HTB)
#define PG8_STAGE(bufoff, gbase, voff) do { _Pragma("unroll") for (int _i = 0; _i < 2; ++_i) \
        __builtin_amdgcn_global_load_lds((const unsigned*)((const char*)(gbase) + (voff)[_i]), (PG8_LAS unsigned*)(lds + (bufoff) + ldsw + _i * 8192), 16, 0, 0); } while (0)
#define PG8_LDA(dst, b, h) do { _Pragma("unroll") for (int m = 0; m < 4; ++m) _Pragma("unroll") for (int k = 0; k < 2; ++k) dst[m][k] = *(const PG8_LAS bf16x8*)(lds + PG8_SA(b, h) + aoff + m * 2048 + k * 1024); } while (0)
#define PG8_LDB(dst, b, h) do { _Pragma("unroll") for (int n = 0; n < 2; ++n) _Pragma("unroll") for (int k = 0; k < 2; ++k) dst[n][k] = *(const PG8_LAS bf16x8*)(lds + PG8_SB(b, h) + boff + n * 2048 + k * 1024); } while (0)
#define PG8_MMA(ai, bj, At, Bt) do { __builtin_amdgcn_s_setprio(1); _Pragma("unroll") for (int m = 0; m < 4; ++m) _Pragma("unroll") for (int n = 0; n < 2; ++n) _Pragma("unroll") for (int k = 0; k < 2; ++k) \
        acc[ai][bj][m][n] = __builtin_amdgcn_mfma_f32_16x16x32_bf16(Bt[n][k], At[m][k], acc[ai][bj][m][n], 0, 0, 0); __builtin_amdgcn_s_setprio(0); } while (0)
#define PG8_WAIT_V(n) asm volatile("s_waitcnt vmcnt(" #n ")" ::: "memory")
#define PG8_WAIT_L(n) asm volatile("s_waitcnt lgkmcnt(" #n ")" ::: "memory")
#define PG8_BAR __builtin_amdgcn_s_barrier()
#define PG8_SCHED __builtin_amdgcn_sched_barrier(0)
    Unit cur, nxt; int ui = 0;
    if (!S.next(0, cur)) return;
    f32x4 acc[2][2][4][2];
#pragma unroll
    for (int a = 0; a < 2; ++a)
#pragma unroll
        for (int b = 0; b < 2; ++b)
#pragma unroll
            for (int m = 0; m < 4; ++m)
#pragma unroll
                for (int n = 0; n < 2; ++n) acc[a][b][m][n] = (f32x4){0.f, 0.f, 0.f, 0.f};
    bf16x8 At[4][2], B0[2][2], B1[2][2];
    const char* cA = (const char*)g.A + (size_t)cur.pm * tstep; const char* cB = (const char*)g.Bt + (size_t)cur.pn * tstep;
    S.a_ready(cur);
    if constexpr (SP2) {
        PG8_STAGE(PG8_SB(0, 0), cB, voffB); PG8_STAGE(PG8_SB(0, 1), cB + hstep, voffB); PG8_STAGE(PG8_SA(0, 0), cA, voffA); PG8_STAGE(PG8_SA(0, 1), cA + hstep, voffA);
        if (wr == 1) PG8_BAR;
        PG8_WAIT_V(2); PG8_BAR;
        PG8_STAGE(PG8_SB(1, 0), cB + kstep, voffB); PG8_STAGE(PG8_SA(1, 0), cA + kstep, voffA); PG8_STAGE(PG8_SB(1, 1), cB + hstep + kstep, voffB);
        PG8_WAIT_V(6); PG8_BAR;
    } else {
        PG8_STAGE(PG8_SB(0, 0), cB, voffB); PG8_STAGE(PG8_SA(0, 0), cA, voffA); PG8_STAGE(PG8_SB(0, 1), cB + hstep, voffB); PG8_STAGE(PG8_SA(0, 1), cA + hstep, voffA);
        if (wr == 1) PG8_BAR;
        PG8_WAIT_V(4); PG8_BAR;
        PG8_STAGE(PG8_SB(1, 0), cB + kstep, voffB); PG8_STAGE(PG8_SA(1, 0), cA + kstep, voffA); PG8_STAGE(PG8_SB(1, 1), cB + hstep + kstep, voffB);
        PG8_WAIT_V(6); PG8_BAR;
    }
    for (;;) {
        const bool has_next = S.next(ui + 1, nxt);
        const char* nA = has_next ? (const char*)g.A + (size_t)nxt.pm * tstep : cA; const char* nB = has_next ? (const char*)g.Bt + (size_t)nxt.pn * tstep : cB;
        for (int t = 0; t < nt; t += 2) {
            const bool last = (t == nt - 2);
            const char* a1 = cA + (size_t)(t + 1) * kstep;
            const char* a2 = last ? nA : cA + (size_t)(t + 2) * kstep; const char* b2 = last ? nB : cB + (size_t)(t + 2) * kstep;
            const char* a3 = a2 + kstep; const char* b3 = b2 + kstep;
            if (last && has_next) S.a_ready(nxt);
            if constexpr (SP2) {
            PG8_LDB(B0, 0, 0); PG8_LDB(B1, 0, 1); PG8_SCHED; PG8_LDA(At, 0, 0); PG8_STAGE(PG8_SA(1, 1), a1 + hstep, voffA);
            PG8_WAIT_V(8); PG8_WAIT_L(0); PG8_BAR; PG8_MMA(0, 0, At, B0); PG8_MMA(0, 1, At, B1); PG8_BAR; PG8_SCHED;
            PG8_LDA(At, 0, 1); PG8_STAGE(PG8_SB(0, 0), b2, voffB); PG8_STAGE(PG8_SB(0, 1), b2 + hstep, voffB); PG8_STAGE(PG8_SA(0, 0), a2, voffA);
            PG8_WAIT_V(8); PG8_WAIT_L(0); PG8_BAR; PG8_MMA(1, 0, At, B0); PG8_MMA(1, 1, At, B1); PG8_BAR; PG8_SCHED;
            PG8_LDB(B0, 1, 0); PG8_LDB(B1, 1, 1); PG8_SCHED; PG8_LDA(At, 1, 0); PG8_STAGE(PG8_SA(0, 1), a2 + hstep, voffA);
            PG8_WAIT_V(8); PG8_WAIT_L(0); PG8_BAR; PG8_MMA(0, 0, At, B0); PG8_MMA(0, 1, At, B1); PG8_BAR; PG8_SCHED;
            PG8_LDA(At, 1, 1); PG8_STAGE(PG8_SB(1, 0), b3, voffB); PG8_STAGE(PG8_SB(1, 1), b3 + hstep, voffB); PG8_STAGE(PG8_SA(1, 0), a3, voffA);
            PG8_WAIT_V(8); PG8_WAIT_L(0); PG8_BAR; PG8_MMA(1, 0, At, B0); PG8_MMA(1, 1, At, B1); PG8_BAR; PG8_SCHED;
            } else {
            PG8_LDB(B0, 0, 0); PG8_SCHED; PG8_LDA(At, 0, 0); PG8_STAGE(PG8_SA(1, 1), a1 + hstep, voffA);
            PG8_WAIT_L(8); PG8_BAR; PG8_WAIT_L(0); PG8_MMA(0, 0, At, B0); PG8_BAR; PG8_SCHED;
            PG8_LDB(B1, 0, 1); PG8_STAGE(PG8_SB(0, 0), b2, voffB);
            PG8_BAR; PG8_WAIT_L(0); PG8_MMA(0, 1, At, B1); PG8_BAR;
            PG8_LDA(At, 0, 1); PG8_STAGE(PG8_SA(0, 0), a2, voffA);
            PG8_BAR; PG8_WAIT_L(0); PG8_MMA(1, 0, At, B0); PG8_BAR; PG8_SCHED;
            PG8_STAGE(PG8_SB(0, 1), b2 + hstep, voffB);
            PG8_WAIT_V(6); PG8_BAR; PG8_MMA(1, 1, At, B1); PG8_BAR;
            PG8_LDB(B0, 1, 0); PG8_SCHED; PG8_LDA(At, 1, 0); PG8_STAGE(PG8_SA(0, 1), a2 + hstep, voffA);
            PG8_WAIT_L(8); PG8_BAR; PG8_WAIT_L(0); PG8_MMA(0, 0, At, B0); PG8_BAR; PG8_SCHED;
            PG8_LDB(B1, 1, 1); PG8_STAGE(PG8_SB(1, 0), b3, voffB);
            PG8_BAR; PG8_WAIT_L(0); PG8_MMA(0, 1, At, B1); PG8_BAR;
            PG8_LDA(At, 1, 1); PG8_STAGE(PG8_SA(1, 0), a3, voffA);
            PG8_BAR; PG8_WAIT_L(0); PG8_MMA(1, 0, At, B0); PG8_BAR; PG8_SCHED;
            PG8_STAGE(PG8_SB(1, 1), b3 + hstep, voffB);
            PG8_WAIT_V(6); PG8_BAR; PG8_MMA(1, 1, At, B1); PG8_BAR;
            }
        }
        if constexpr (ALIGN_EPI) { if (wr == 0) PG8_BAR; }
        if constexpr (!Epi::AFTER_DRAIN) { E(acc, cur, wr, wc, fr, fq); S.done(cur); }
        if (!has_next) break;
#pragma unroll
        for (int a = 0; a < 2; ++a)
#pragma unroll
            for (int b = 0; b < 2; ++b)
#pragma unroll
                for (int m = 0; m < 4; ++m)
#pragma unroll
                    for (int n = 0; n < 2; ++n) acc[a][b][m][n] = (f32x4){0.f, 0.f, 0.f, 0.f};
        cur = nxt; cA = nA; cB = nB; ++ui;
        if constexpr (ALIGN_EPI) { if (wr == 1) PG8_BAR; }
    }
    PG8_WAIT_V(0);
    if constexpr (!ALIGN_EPI) { if (wr == 0) PG8_BAR; }
    PG8_BAR;
    if constexpr (Epi::AFTER_DRAIN) { E.fused(acc, cur, wr, wc, fr, fq, lds, wid, lane); S.done(cur); }
#undef PG8_SA
#undef PG8_SB
#undef PG8_STAGE
#undef PG8_LDA
#undef PG8_LDB
#undef PG8_MMA
#undef PG8_WAIT_V
#undef PG8_WAIT_L
#undef PG8_BAR
#undef PG8_SCHED
}
}
namespace att {
typedef unsigned short bf16_t;
using bf16x8 = __attribute__((ext_vector_type(8))) short;
using s16x4 = __attribute__((ext_vector_type(4))) short;
using f32x16 = __attribute__((ext_vector_type(16))) float;
using u32x4 = __attribute__((ext_vector_type(4))) unsigned;
#define ATT_LAS __attribute__((address_space(3)))
constexpr int NW = 8, PF = 4, NSLOT = PF + 2, SLOTB = 16384, VOFF = 8192, TABF = 640;
constexpr int LDS_WS = NSLOT * SLOTB, LDS_OST = LDS_WS + NW * 256, LDS_TAB = LDS_OST + NW * 4096, TAB_PAD = 64, LDS_END = LDS_TAB + 2 * TABF * 4;
constexpr float NEG_INF = -__builtin_inff();
__device__ __forceinline__ constexpr int crow(int r, int hi) { return (r & 3) + 8 * (r >> 2) + 4 * hi; }
__device__ __forceinline__ void glds16(const void* gsrc, unsigned lds_dst) { unsigned keep;
    asm volatile("s_mov_b32 %0, m0\n\ts_mov_b32 m0, %2\n\ts_nop 0\n\tglobal_load_lds_dwordx4 %1, off\n\ts_mov_b32 m0, %0" : "=&s"(keep) : "v"(gsrc), "s"(lds_dst) : "memory"); }
__device__ __forceinline__ float fadd_s(float a, float b) { float r; asm("v_add_f32_e32 %0, %1, %2" : "=v"(r) : "v"(a), "v"(b)); return r; }
__device__ __forceinline__ float fsub_s(float a, float b) { float r; asm("v_sub_f32_e32 %0, %1, %2" : "=v"(r) : "v"(a), "v"(b)); return r; }
__device__ __forceinline__ float fmul_s(float a, float b) { float r; asm("v_mul_f32_e32 %0, %1, %2" : "=v"(r) : "v"(a), "v"(b)); return r; }
#define ATT_FMAMK(dst, a, K, c) asm("v_fmamk_f32 %0, %1, %3, %2" : "=v"(dst) : "v"(a), "v"(c), "i"(__builtin_bit_cast(int, (float)(K))))
#define ATT_MFMA_PAD(x, y) asm volatile("s_nop 15\n\ts_nop 7" : "+v"(x), "+v"(y))
__device__ __forceinline__ float max3f(float a, float b, float c) { return __builtin_fmaxf(__builtin_fmaxf(a, b), c); }
typedef float f32x2_t __attribute__((ext_vector_type(2))); typedef __bf16 bf16x2_t __attribute__((ext_vector_type(2)));
__device__ __forceinline__ unsigned cvtpk_s(float lo, float hi) { f32x2_t v = {lo, hi}; bf16x2_t b = __builtin_convertvector(v, bf16x2_t); return __builtin_bit_cast(unsigned, b); }

__device__ __forceinline__ void qkt(f32x16& p0, f32x16& p1, const ATT_LAS char* kp, const bf16x8* qr, const f32x16& z) {
#pragma unroll
    for (int d0 = 0; d0 < 4; ++d0) {
        const bf16x8 b0 = *(const ATT_LAS bf16x8*)(kp + d0 * 2048);
        const bf16x8 b1 = *(const ATT_LAS bf16x8*)(kp + d0 * 2048 + 512);
        if (d0 == 0) { p0 = __builtin_amdgcn_mfma_f32_32x32x16_bf16(b0, qr[0], z, 0, 0, 0); p1 = __builtin_amdgcn_mfma_f32_32x32x16_bf16(b1, qr[0], z, 0, 0, 0); }
        else { p0 = __builtin_amdgcn_mfma_f32_32x32x16_bf16(b0, qr[d0], p0, 0, 0, 0); p1 = __builtin_amdgcn_mfma_f32_32x32x16_bf16(b1, qr[d0], p1, 0, 0, 0); } }
}
__device__ __forceinline__ float rowmax(const f32x16& p0, const f32x16& p1) {
    float a = max3f(p0[0], p0[1], p1[0]), b = max3f(p0[2], p0[3], p1[1]); a = max3f(a, p1[2], p1[3]);
#pragma unroll
    for (int r = 4; r < 16; r += 4) { a = max3f(a, p0[r], p0[r + 1]); b = max3f(b, p0[r + 2], p0[r + 3]); a = max3f(a, p1[r], p1[r + 1]); b = max3f(b, p1[r + 2], p1[r + 3]); }
    const float m = __builtin_fmaxf(a, b);
    auto rr = __builtin_amdgcn_permlane32_swap(__float_as_uint(m), __float_as_uint(m), false, false);
    return __builtin_fmaxf(__uint_as_float(rr[0]), __uint_as_float(rr[1]));
}
__device__ __forceinline__ void pv(f32x16* o, int vb, bf16x8 pa0, bf16x8 pa1, bf16x8 pa2, bf16x8 pa3) {
#pragma unroll
    for (int d0 = 0; d0 < 2; ++d0) { s16x4 lo[4], hi[4];
#pragma unroll
        for (int ks = 0; ks < 4; ++ks) {
            asm volatile("ds_read_b64_tr_b16 %0,%1 offset:%c2" : "=&v"(lo[ks]) : "v"(vb), "i"(d0 * 4096 + ks * 1024) : "memory");
            asm volatile("ds_read_b64_tr_b16 %0,%1 offset:%c2" : "=&v"(hi[ks]) : "v"(vb), "i"(d0 * 4096 + ks * 1024 + 512) : "memory"); }
        asm volatile("s_waitcnt lgkmcnt(0)" ::: "memory"); __builtin_amdgcn_sched_barrier(0);
#define ATT_PK(k) (bf16x8){lo[k][0], lo[k][1], lo[k][2], lo[k][3], hi[k][0], hi[k][1], hi[k][2], hi[k][3]}
        o[d0] = __builtin_amdgcn_mfma_f32_32x32x16_bf16(pa0, ATT_PK(0), o[d0], 0, 0, 0);
        o[d0] = __builtin_amdgcn_mfma_f32_32x32x16_bf16(pa1, ATT_PK(1), o[d0], 0, 0, 0);
        o[d0] = __builtin_amdgcn_mfma_f32_32x32x16_bf16(pa2, ATT_PK(2), o[d0], 0, 0, 0);
        o[d0] = __builtin_amdgcn_mfma_f32_32x32x16_bf16(pa3, ATT_PK(3), o[d0], 0, 0, 0);
#undef ATT_PK
    }
}

struct UnitP {
    const bf16_t* Q; int qpitch;
    const bf16_t* K; const bf16_t* V; int kvpitch, kvmax;
    int row0, ntiles;
    bf16_t* O; int opitch;
    int tok0;
    float slope2, m0, l0;
    const float* rpb;
    int seqlen;
    int type;
};
template <int AK> __device__ __forceinline__ constexpr bool act(int half, int r) { return AK == 0 ? true : (AK == 1 ? (half == 0 || r < 4) : (half == 1 || r >= 12)); }
#ifndef ATT_LAG
#define ATT_LAG 1
#endif
#define ATT_THR 8.0f
#define ATT_LOW 24.0f
template <int AK>
__device__ __forceinline__ void softmax_pv(f32x16& p0, f32x16& p1, float& mhat, f32x16& negm, float& l, f32x16* o, ATT_LAS float* wsf, int vb, int r32, int hi) {
    float a_ = NEG_INF, b_ = NEG_INF;
#pragma unroll
    for (int r = 0; r < 16; r += 2) { if (act<AK>(0, r)) a_ = max3f(a_, p0[r], p0[r + 1]); if (act<AK>(1, r)) b_ = max3f(b_, p1[r], p1[r + 1]); }
    float rm = __builtin_fmaxf(a_, b_);
    { auto rr = __builtin_amdgcn_permlane32_swap(__float_as_uint(rm), __float_as_uint(rm), false, false); rm = __builtin_fmaxf(__uint_as_float(rr[0]), __uint_as_float(rr[1])); }
    const bool need_ = (rm > ATT_THR) || (rm < -ATT_LOW && rm > -1e30f);
    if (__builtin_expect(__any(need_), 0)) {
        const float dl = need_ ? rm : 0.f; mhat += dl;
#pragma unroll
        for (int r = 0; r < 16; ++r) { if (act<AK>(0, r)) p0[r] = fsub_s(p0[r], dl); if (act<AK>(1, r)) p1[r] = fsub_s(p1[r], dl); negm[r] = -mhat; }
        asm volatile("" : "+v"(negm));
        const float f_ = __builtin_amdgcn_exp2f(-dl); l *= f_;
        if (hi == 0) wsf[r32] = f_;
        asm volatile("s_waitcnt lgkmcnt(0)" ::: "memory");
#pragma unroll
        for (int r = 0; r < 16; ++r) { const float f = wsf[crow(r, hi)]; o[0][r] *= f; o[1][r] *= f; }
        asm volatile("" ::: "memory");
    }
    float sacc = 0.f;
#pragma unroll
    for (int r = 0; r < 16; ++r) {
        if (act<AK>(0, r)) p0[r] = __builtin_amdgcn_exp2f(p0[r]); else p0[r] = 0.f;
        if (act<AK>(1, r)) p1[r] = __builtin_amdgcn_exp2f(p1[r]); else p1[r] = 0.f; }
#pragma unroll
    for (int r = 0; r < 16; ++r) { if (act<AK>(0, r)) sacc += p0[r]; if (act<AK>(1, r)) sacc += p1[r]; }
    l += sacc;
    u32x4 pw0, pw1, pw2, pw3;
    pw0 = (u32x4){cvtpk_s(p0[0], p0[1]), cvtpk_s(p0[2], p0[3]), cvtpk_s(p0[4], p0[5]), cvtpk_s(p0[6], p0[7])};
    pw1 = (u32x4){cvtpk_s(p0[8], p0[9]), cvtpk_s(p0[10], p0[11]), cvtpk_s(p0[12], p0[13]), cvtpk_s(p0[14], p0[15])};
    pw2 = (u32x4){cvtpk_s(p1[0], p1[1]), cvtpk_s(p1[2], p1[3]), cvtpk_s(p1[4], p1[5]), cvtpk_s(p1[6], p1[7])};
    pw3 = (u32x4){cvtpk_s(p1[8], p1[9]), cvtpk_s(p1[10], p1[11]), cvtpk_s(p1[12], p1[13]), cvtpk_s(p1[14], p1[15])};
    __builtin_amdgcn_sched_barrier(0);
    pv(o, vb, __builtin_bit_cast(bf16x8, pw0), __builtin_bit_cast(bf16x8, pw1), __builtin_bit_cast(bf16x8, pw2), __builtin_bit_cast(bf16x8, pw3));
}

template <int TYPE, int AK>
__device__ __forceinline__ void qk_bias(f32x16& p0, f32x16& p1, const ATT_LAS char* kp, const bf16x8* qr, const f32x16& negm, float slope2, float dqf, int tl, const ATT_LAS float* tb, const float (&ng0)[16], const float (&ng1)[16]) {
    qkt(p0, p1, kp, qr, negm);
    ATT_MFMA_PAD(p0, p1);
    if (TYPE == 0) {
        if (tl < 2) {
            const float lc0 = -slope2 * dqf, lc1 = lc0 + 32.f * slope2;
#pragma unroll
            for (int r = 0; r < 16; ++r) { float x0, x1; ATT_FMAMK(x0, slope2, (r & 3) + 8 * (r >> 2), p0[r]); ATT_FMAMK(x1, slope2, (r & 3) + 8 * (r >> 2), p1[r]); p0[r] = fadd_s(x0, lc0); p1[r] = fadd_s(x1, lc1); }
            if (tl == 0) { const float thr = dqf - 128.f;
#pragma unroll
                for (int r = 0; r < 16; ++r) { const float cr = (float)((r & 3) + 8 * (r >> 2)); p0[r] = (cr >= thr) ? p0[r] : NEG_INF; p1[r] = (cr + 32.f >= thr) ? p1[r] : NEG_INF; } }
        } else if (tl > 2) {
            const float nslope = -slope2; const float lc0 = slope2 * dqf, lc1 = lc0 - 32.f * slope2;
#pragma unroll
            for (int r = 0; r < 16; ++r) { float x0, x1; ATT_FMAMK(x0, nslope, (r & 3) + 8 * (r >> 2), p0[r]); ATT_FMAMK(x1, nslope, (r & 3) + 8 * (r >> 2), p1[r]); p0[r] = fadd_s(x0, lc0); p1[r] = fadd_s(x1, lc1); }
            if (tl == 4) { const float thr = dqf + 128.f;
#pragma unroll
                for (int r = 0; r < 16; ++r) { const float cr = (float)((r & 3) + 8 * (r >> 2)); p0[r] = (cr <= thr) ? p0[r] : NEG_INF; p1[r] = (cr + 32.f <= thr) ? p1[r] : NEG_INF; } }
        } else {
#pragma unroll
            for (int r = 0; r < 16; ++r) { const float cr = (float)((r & 3) + 8 * (r >> 2)); const float a0 = __builtin_fabsf(dqf - cr), a1 = __builtin_fabsf(dqf - (cr + 32.f));
                p0[r] = __builtin_fmaf(-slope2, a0, p0[r]); p1[r] = __builtin_fmaf(-slope2, a1, p1[r]); }
        }
    } else if (TYPE == 1) {
#pragma unroll
        for (int r = 0; r < 16; ++r) { const int cr = (r & 3) + 8 * (r >> 2);
            if (act<AK>(0, r)) { const float b0 = tb[cr]; p0[r] = fadd_s(fadd_s(p0[r], b0), ng0[r]); }
            if (act<AK>(1, r)) { const float b1 = tb[cr + 32]; p1[r] = fadd_s(fadd_s(p1[r], b1), ng1[r]); } }
    }
}
#define ATT_CLAMPU(UU, r) ((r) < 0 ? 0 : ((r) > (UU).kvmax ? (UU).kvmax : (r)))
#define ATT_DMA_U(UU, t, slot) do { const int rb_ = (UU).row0 + 64 * (t); const int kr_ = ATT_CLAMPU(UU, rb_ + lane), vr_ = ATT_CLAMPU(UU, rb_ + 16 * (wid & 3) + (lane >> 2)); \
        glds16((UU).K + wid * 8 + (size_t)kr_ * (UU).kvpitch, (unsigned)__builtin_amdgcn_readfirstlane(lds0 + wid * 1024 + (slot) * SLOTB)); \
        glds16((UU).V + (wid >> 2) * 32 + (lane & 3) * 8 + (size_t)vr_ * (UU).kvpitch, (unsigned)__builtin_amdgcn_readfirstlane(lds0 + VOFF + wid * 1024 + (slot) * SLOTB)); } while (0)
#define ATT_LOADQ(UU, q) do { const bf16_t* Qw_ = (UU).Q + (size_t)(wid * 32 + r32) * (UU).qpitch + hi * 8; \
        _Pragma("unroll") for (int d0 = 0; d0 < 4; ++d0) (q)[d0] = *(const bf16x8*)(Qw_ + d0 * 16); } while (0)
#define ATT_LOADQ_ASM(UU, q) do { const bf16_t* Qw_ = (UU).Q + (size_t)(wid * 32 + r32) * (UU).qpitch + hi * 8; \
        asm volatile("global_load_dwordx4 %0, %4, off\n\tglobal_load_dwordx4 %1, %4, off offset:32\n\tglobal_load_dwordx4 %2, %4, off offset:64\n\tglobal_load_dwordx4 %3, %4, off offset:96" \
            : "=&v"((q)[0]), "=&v"((q)[1]), "=&v"((q)[2]), "=&v"((q)[3]) : "v"(Qw_) : "memory"); } while (0)
#define ATT_LOADF_ASM(dst, ptr) asm volatile("global_load_dword %0, %1, off" : "=&v"(dst) : "v"(ptr) : "memory")
template <int TYPE, int CH, bool LAG>
__device__ __forceinline__ void attn_unit(const UnitP& U, const UnitP& Un, bool has_next, int& slot0, bf16x8 (&qr)[4], float& rpbv, int parity, ATT_LAS unsigned char* lds) {
    int tid_ = threadIdx.x; asm volatile("" : "+v"(tid_));
    const int tid = tid_, lane = tid & 63, r32 = lane & 31, hi = lane >> 5; const int wid = __builtin_amdgcn_readfirstlane(tid >> 6);
    const unsigned lds0 = (unsigned)(uintptr_t)lds;
    const ATT_LAS char* shm3 = (const ATT_LAS char*)lds;
    ATT_LAS float* wsf = (ATT_LAS float*)(lds + LDS_WS) + wid * 64;
    ATT_LAS float* tab = (ATT_LAS float*)(lds + LDS_TAB) + parity * TABF;
    if (TYPE == 1) { if (tid < 15 * 31) tab[TAB_PAD + tid] = rpbv * 1.4426950408889634f; }
    const int NT = U.ntiles;
    float mhat = (TYPE == 0) ? U.m0 : 0.f, l = (hi == 0) ? U.l0 : 0.f;
    f32x16 negm;
#pragma unroll
    for (int r = 0; r < 16; ++r) negm[r] = -mhat;
    asm volatile("" : "+v"(negm));
    f32x16 o[2]; o[0] = f32x16{}; o[1] = f32x16{};
    const int vb0 = (int)(lds0 + VOFF) + ((lane >> 4) & 1) * 32 + (lane & 3) * 8 + (4 * hi + ((lane & 15) >> 2)) * 64;
    const ATT_LAS char* kp0 = shm3 + hi * 1024 + r32 * 16;
    int t_lo, t_hi;
    if (TYPE == 0) { t_lo = wid >> 1; t_hi = t_lo + 4; }
    else if (TYPE == 1) { const int r = U.tok0 + (wid >> 1); int rs = r - 4; rs = rs < 0 ? 0 : (rs > 248 ? 248 : rs); const int T0 = U.row0 >> 6; t_lo = rs - T0; t_hi = t_lo + 7; }
    else { t_lo = 0; t_hi = NT - 1; }
    float ng0[16], ng1[16];
#pragma unroll
    for (int r = 0; r < 16; ++r) { ng0[r] = 0.f; ng1[r] = 0.f; }
    if (TYPE == 1) { const int c = 32 * (wid & 1) + r32; int cs = c - 8; cs = cs < 0 ? 0 : (cs > 48 ? 48 : cs); const int kc = 4 * hi - cs;
#pragma unroll
        for (int r = 0; r < 16; ++r) { const int cr = (r & 3) + 8 * (r >> 2); ng0[r] = ((unsigned)(kc + cr) < 16u) ? 0.f : NEG_INF; ng1[r] = ((unsigned)(kc + cr + 32) < 16u) ? 0.f : NEG_INF; } }
    float rpbn;
    constexpr int AK = (TYPE == 1) ? (CH == 0 ? 1 : 2) : 0;
    constexpr bool lag = LAG;
    f32x16 p0 = f32x16{}, p1 = f32x16{}; bool pend = false; int pend_slot = 0;
#define ATT_QK_BIAS() do { const float dqf_ = (float)((U.tok0 + wid * 32 + r32) - (U.row0 + 64 * t + 4 * hi)); \
        const ATT_LAS float* tb_ = tab + TAB_PAD + ((U.row0 >> 6) + t - (U.tok0 + (wid >> 1)) + 7) * 31 + 15 - (32 * (wid & 1) + r32) + 4 * hi; \
        qk_bias<TYPE, AK>(p0, p1, kp0 + slot * SLOTB, qr, negm, U.slope2, dqf_, t - t_lo, tb_, ng0, ng1); \
        } while (0)
#define ATT_SM(vs) softmax_pv<AK>(p0, p1, mhat, negm, l, o, wsf, vb0 + (vs) * SLOTB, r32, hi)
    int slot = slot0;
    for (int t = 0; t < NT; ++t) {
        { const int behind = has_next ? (PF - 1) : ((NT - 1 - t) < (PF - 1) ? (NT - 1 - t) : (PF - 1));
          if (behind >= 3) asm volatile("s_waitcnt vmcnt(6) lgkmcnt(0)\n\ts_barrier" ::: "memory");
          else if (behind == 2) asm volatile("s_waitcnt vmcnt(4) lgkmcnt(0)\n\ts_barrier" ::: "memory");
          else if (behind == 1) asm volatile("s_waitcnt vmcnt(2) lgkmcnt(0)\n\ts_barrier" ::: "memory");
          else asm volatile("s_waitcnt vmcnt(0) lgkmcnt(0)\n\ts_barrier" ::: "memory"); }
        const int nslot = (slot == NSLOT - 1) ? 0 : slot + 1, islot = (slot < 2) ? slot + NSLOT - 2 : slot - 2;
        if (t + PF < NT) ATT_DMA_U(U, t + PF, islot);
        else if (has_next) ATT_DMA_U(Un, t + PF - NT, islot);
        bool rel = (t >= t_lo) && (t <= t_hi);
        if (TYPE == 0) { const int rb = U.row0 + 64 * t; rel = rel && (rb >= 0) && (rb < U.seqlen); }
        if (!lag) {
            if (rel) { ATT_QK_BIAS(); ATT_SM(slot); }
        } else {
            if (pend) { ATT_SM(pend_slot); pend = false; }
            if (rel) { ATT_QK_BIAS(); pend = true; pend_slot = slot; }
        }
        slot = nslot;
    }
    { ATT_LOADQ_ASM(Un, qr); const float* rp_ = (Un.type == 1) ? Un.rpb + (tid < 15 * 31 ? tid : 0) : (const float*)Un.Q; ATT_LOADF_ASM(rpbn, rp_); }
    if (pend) { ATT_SM(pend_slot); }
    slot0 = slot;
    { auto rr = __builtin_amdgcn_permlane32_swap(__float_as_uint(l), __float_as_uint(l), false, false); l = __uint_as_float(rr[0]) + __uint_as_float(rr[1]); }
    asm volatile("" ::: "memory");
    if (hi == 0) wsf[32 + r32] = l;
    asm volatile("s_waitcnt lgkmcnt(0)" ::: "memory");
    float rli[16];
#pragma unroll
    for (int r = 0; r < 16; ++r) rli[r] = __builtin_amdgcn_rcpf(wsf[32 + crow(r, hi)]);
    { ATT_LAS bf16_t* stg = (ATT_LAS bf16_t*)(lds + LDS_OST) + wid * 2048;
#pragma unroll
      for (int r = 0; r < 16; ++r) { const int orow = crow(r, hi);
#pragma unroll
          for (int d0 = 0; d0 < 2; ++d0) { const unsigned pk = cvtpk_s(o[d0][r] * rli[r], 0.f); stg[orow * 64 + d0 * 32 + r32] = (bf16_t)(pk & 0xffffu); } }
      asm volatile("s_waitcnt lgkmcnt(0)" ::: "memory");
      bf16_t* Ow = U.O + (size_t)(wid * 32) * U.opitch;
#pragma unroll
      for (int i = 0; i < 4; ++i) { const int row = i * 8 + (lane >> 3), ch = lane & 7; const u32x4 v = *(const ATT_LAS u32x4*)(stg + row * 64 + ch * 8); *(u32x4*)(Ow + (size_t)row * U.opitch + ch * 8) = v; } }
    asm volatile("s_waitcnt lgkmcnt(0)" ::: "memory");
    rpbv = rpbn;
    asm volatile("s_waitcnt vmcnt(0)" : "+v"(qr[0]), "+v"(qr[1]), "+v"(qr[2]), "+v"(qr[3]), "+v"(rpbv) :: "memory");
}
__device__ __forceinline__ void attn_stream_begin(const UnitP& U, bf16x8 (&qr)[4], float& rpbv, ATT_LAS unsigned char* lds) {
    int tid_ = threadIdx.x; asm volatile("" : "+v"(tid_));
    const int tid = tid_, lane = tid & 63, r32 = lane & 31, hi = lane >> 5; const int wid = __builtin_amdgcn_readfirstlane(tid >> 6);
    const unsigned lds0 = (unsigned)(uintptr_t)lds;
    ATT_LOADQ(U, qr); rpbv = 0.f; if (U.type == 1 && tid < 15 * 31) rpbv = U.rpb[tid];
#pragma unroll
    for (int j = 0; j < PF; ++j) ATT_DMA_U(U, j, j);
    asm volatile("" : "+v"(qr[0]), "+v"(qr[1]), "+v"(qr[2]), "+v"(qr[3]), "+v"(rpbv));
}
__device__ __forceinline__ void attn_stream_end() { asm volatile("s_waitcnt vmcnt(0) lgkmcnt(0)\n\ts_barrier" ::: "memory"); }
}
constexpr int NWAVES = 8;
constexpr int SEQ = 16384, DM = 1024, DEPTH = 4, NQH = 12, NMH = 4, NMEM = 256, WIN_A = 1536, WIN_B = 2560, DFF = 2816, NGU = 2 * DFF;
constexpr float LOG2E = 1.4426950408889634f, C2 = 0.125f * LOG2E;
constexpr int N_PHASES = 2 + 5 * DEPTH;
#ifndef MK_PER_PHASE
#define MK_PER_PHASE 0
#endif
#ifndef MK_DUP
#define MK_DUP 0
#endif
#ifndef MK_NAIVE
#define MK_NAIVE 0
#endif

constexpr size_t MiB = 1u << 20;
constexpr size_t WS_CTL = 0, CTL_ZERO_BYTES = 1 * MiB;
constexpr size_t WS_SSQA = 1 * MiB, WS_SSQB = 2 * MiB;
constexpr size_t WS_MEMN = 3 * MiB;
constexpr size_t WS_MKV = 4 * MiB;
constexpr size_t WS_WIN = 6 * MiB;
constexpr size_t WS_WOUT = WS_WIN + 16 * MiB, WS_WGU = WS_WOUT + 8 * MiB, WS_WDN = WS_WGU + 44 * MiB, WS_WMKV = WS_WDN + 22 * MiB;
constexpr size_t WS_XB = WS_WMKV + 4 * MiB;
constexpr size_t WS_PROJ = WS_XB + 32 * MiB;
constexpr size_t WS_Y = WS_PROJ + 80 * MiB;
constexpr size_t WS_H = WS_PROJ;
constexpr size_t WS_END = WS_Y + 32 * MiB;
static_assert(WS_END <= 256 * MiB, "d_ws map");
__host__ __device__ constexpr size_t win_off(int l) { return (size_t)((l >> 1) * 8 + (l & 1) * 3) * MiB; }
constexpr int CW_BAR = 4096;

constexpr int RING_OFF = 0, RING_BYTES = 131072, LDSCTL_OFF = 139264, MISC_OFF = LDSCTL_OFF + 320, LDS_BYTES = 147456;
static_assert(att::LDS_END <= LDSCTL_OFF && att::PF == 4, "attention scratch below the control words; the wait ladder in attn_unit is written for PF = 4 (and every unit has >= PF tiles)");

#define GAS __attribute__((address_space(1)))
#define LAS __attribute__((address_space(3)))
typedef unsigned short bf16;
typedef unsigned v4u __attribute__((ext_vector_type(4)));
typedef float f32x4 __attribute__((ext_vector_type(4)));
typedef short bf16x8 __attribute__((ext_vector_type(8)));
typedef GAS unsigned gu32;
typedef GAS unsigned long long gu64;
#define RLX_AGENT __ATOMIC_RELAXED, __HIP_MEMORY_SCOPE_AGENT
#define LDS_WAIT() asm volatile("s_waitcnt lgkmcnt(0)" ::: "memory")
#define VM_WAIT() asm volatile("s_waitcnt vmcnt(0)" ::: "memory")
__device__ __forceinline__ unsigned long long rt() { return __builtin_amdgcn_s_memrealtime(); }
__device__ __forceinline__ unsigned f2bf(float f) { unsigned u = __builtin_bit_cast(unsigned, f); return (u + 0x7fffu + ((u >> 16) & 1u)) >> 16; }
__device__ __forceinline__ unsigned pk2(float lo, float hi) { return f2bf(lo) | (f2bf(hi) << 16); }

#define XB_TMO      128
#define XB_XCNT(j)  (256  + 64 * (j))
#define XB_XSUB(j)  (1280 + 64 * (j))
#define XB_XGEN(j)  (2304 + 64 * (j))
#define XB_TOP      3328
#define XB_TOPGEN   3392
#define XCD_BAR_WORDS 3456
#define XB_SPIN_CAP (1u << 18)

__device__ __forceinline__ unsigned xb_ld(unsigned* p)              { return __hip_atomic_load(p, __ATOMIC_RELAXED, __HIP_MEMORY_SCOPE_AGENT); }
__device__ __forceinline__ unsigned xb_add(unsigned* p, unsigned v) { return __hip_atomic_fetch_add(p, v, __ATOMIC_RELAXED, __HIP_MEMORY_SCOPE_AGENT); }
__device__ __forceinline__ unsigned xb_xcc_id() { return (unsigned)__builtin_amdgcn_s_getreg((3 << 11) | 20) & 0xFu; }
#define XB_SPIN(cond, bar) do { unsigned _sp = 0; while (cond) { __builtin_amdgcn_s_sleep(1); \
    if ((++_sp & 255u) == 0u) { if (xb_ld(&(bar)[XB_TMO])) break; if (_sp > XB_SPIN_CAP) { atomicAdd(&(bar)[XB_TMO], 1u); break; } } } } while (0)

struct XcdBarrier {
    unsigned* bar; unsigned x;
    volatile LAS unsigned* st;
};

__device__ __forceinline__ XcdBarrier xcd_barrier_post(unsigned* bar, volatile LAS unsigned* st) {
    XcdBarrier b; b.bar = bar; b.x = xb_xcc_id(); b.st = st;
    if (threadIdx.x == 0) (void)xb_add(&bar[XB_XCNT(b.x)], 1u);
    return b;
}
__device__ __forceinline__ void xcd_barrier_complete(unsigned* bar, unsigned x, unsigned& nloc, unsigned& nx) {
    const unsigned G = gridDim.x * gridDim.y * gridDim.z;
    unsigned sum, cnt, mine, sp = 0u;
    for (;;) {
        sum = 0u; cnt = 0u; mine = 0u;
#pragma unroll
        for (unsigned j = 0; j < 16; ++j) { const unsigned c = xb_ld(&bar[XB_XCNT(j)]); sum += c; cnt += (c > 0u) ? 1u : 0u; mine = (j == x) ? c : mine; }
        if (sum == G) break;
        __builtin_amdgcn_s_sleep(1);
        if ((++sp & 255u) == 0u) { if (xb_ld(&bar[XB_TMO])) break; if (sp > XB_SPIN_CAP) { atomicAdd(&bar[XB_TMO], 1u); break; } }
    }
    nloc = mine > 0u ? mine : 1u; nx = cnt > 0u ? cnt : 1u;
}

__device__ __forceinline__ void xcd_barrier(const XcdBarrier& b) {
    asm volatile("s_waitcnt vmcnt(0)" ::: "memory");
    __syncthreads();
    if (threadIdx.x == 0) {
        unsigned* bar = b.bar;
        __builtin_amdgcn_s_waitcnt(0);
        unsigned nloc = b.st[0], nx = b.st[1];
        if (nloc == 0u) { xcd_barrier_complete(bar, b.x, nloc, nx); b.st[0] = nloc; b.st[1] = nx; }
        const unsigned old = xb_add(&bar[XB_XSUB(b.x)], 1u);
        const unsigned gen = old / nloc;
        if (old + 1u == (gen + 1u) * nloc) {
            __builtin_amdgcn_fence(__ATOMIC_RELEASE, "agent");
            asm volatile("s_waitcnt vmcnt(0)" ::: "memory");
            const unsigned og = xb_add(&bar[XB_TOP], 1u);
            const unsigned tg = og / nx;
            if (og + 1u == (tg + 1u) * nx) xb_add(&bar[XB_TOPGEN], 1u);
            else XB_SPIN(xb_ld(&bar[XB_TOPGEN]) == tg, bar);
            __builtin_amdgcn_fence(__ATOMIC_ACQUIRE, "agent");
            xb_add(&bar[XB_XGEN(b.x)], 1u);
            asm volatile("s_waitcnt vmcnt(0)" ::: "memory");
        } else {
            XB_SPIN(xb_ld(&bar[XB_XGEN(b.x)]) == gen, bar);
            __builtin_amdgcn_fence(__ATOMIC_ACQUIRE, "agent");
            asm volatile("s_waitcnt vmcnt(0)" ::: "memory");
        }
    }
    __syncthreads();
}
struct Frame {
    LAS unsigned char* lds;
    volatile LAS unsigned* MISC;
    gu32* ctl;
    int tid, lane, wave;
    int vcu, G;
    const float *x, *mem, *norm_mix, *norm_ffn, *norm_mem, *norm_final, *w_in_a, *sink_a, *w_in_b, *rpb_b, *w_mem_kv, *w_out, *w_gate_up, *w_down;
    float* out; unsigned char* ws;
};
__device__ __forceinline__ float wave_sum(float v) {
#pragma unroll
    for (int o = 1; o < 64; o <<= 1) v += __shfl_xor(v, o);
    return v;
}
__device__ __forceinline__ void transpose_item(const float* W, int K, int N, bf16* WT, int mode, const float* g, LAS float* scr, int item, int lane) {
    const int nblk = N / 32, kb = item / nblk, nb = item % nblk, k0 = 64 * kb, n0 = 32 * nb;
    const float gl = g ? g[k0 + lane] : 1.f;
    const float* wp = W + (size_t)(k0 + (lane >> 5)) * N + n0 + (lane & 31);
    float wv[32];
#pragma unroll
    for (int i = 0; i < 32; ++i) wv[i] = wp[(size_t)(2 * i) * N];
#pragma unroll
    for (int i = 0; i < 32; ++i) { const float g0 = __uint_as_float(__builtin_amdgcn_readlane(__float_as_uint(gl), 2 * i)), g1 = __uint_as_float(__builtin_amdgcn_readlane(__float_as_uint(gl), 2 * i + 1));
        scr[(2 * i + (lane >> 5)) * 33 + (lane & 31)] = wv[i] * ((lane >> 5) ? g1 : g0); }
    LDS_WAIT(); asm volatile("" ::: "memory");
    int rbase = n0;
    if (mode == 1) { rbase = (n0 < DFF) ? ((n0 / 128) * 256 + (n0 % 128)) : (((n0 - DFF) / 128) * 256 + 128 + ((n0 - DFF) % 128)); }
    const int c = lane & 7;
#pragma unroll
    for (int j = 0; j < 4; ++j) { const int n = (lane >> 3) + 8 * j; const LAS float* s = scr + (8 * c) * 33 + n;
        v4u o; o.x = pk2(s[0 * 33], s[1 * 33]); o.y = pk2(s[2 * 33], s[3 * 33]); o.z = pk2(s[4 * 33], s[5 * 33]); o.w = pk2(s[6 * 33], s[7 * 33]);
        *(GAS v4u*)(WT + (size_t)(rbase + n) * K + k0 + 8 * c) = o; }
    LDS_WAIT(); asm volatile("" ::: "memory");
}
constexpr int IT_OUT = 16 * 32, IT_GU = 16 * (NGU / 32), IT_DN = (DFF / 64) * 32, IT_MKV = 16 * 16;
__device__ __forceinline__ void convert_part(Frame& F, int l, int part, int gw, int NGW) {
    LAS float* scr = (LAS float*)(F.lds + RING_OFF + F.wave * 16384);
    int lane = F.lane; asm volatile("" : "+v"(lane));
    const int nin = (l & 1) ? WIN_B : WIN_A, iin = 16 * (nin / 32);
    const int n0 = (part == 0) ? iin : (part == 1) ? IT_GU : DEPTH * IT_MKV, ntot = (part == 0) ? iin + IT_OUT : (part == 1) ? IT_GU + IT_DN : DEPTH * IT_MKV;
    for (int it = gw; it < ntot; it += NGW) {
        const float* W; const float* g = nullptr; bf16* WT; int K = DM, N, mode = 0, item = it;
        if (part == 0) {
            if (it < n0) { W = (l & 1) ? F.w_in_b + (size_t)(l >> 1) * DM * WIN_B : F.w_in_a + (size_t)(l >> 1) * DM * WIN_A; N = nin; WT = (bf16*)(F.ws + WS_WIN + win_off(l)); g = F.norm_mix + l * DM; }
            else { W = F.w_out + (size_t)l * DM * DM; N = DM; WT = (bf16*)(F.ws + WS_WOUT + (size_t)l * 2 * MiB); item = it - n0; }
        } else if (part == 1) {
            if (it < n0) { W = F.w_gate_up + (size_t)l * DM * NGU; N = NGU; WT = (bf16*)(F.ws + WS_WGU + (size_t)l * 11 * MiB); mode = 1; g = F.norm_ffn + l * DM; }
            else { W = F.w_down + (size_t)l * DFF * DM; K = DFF; N = DM; WT = (bf16*)(F.ws + WS_WDN + (size_t)l * DFF * DM * 2); item = it - n0; }
        } else { const int lm = it / IT_MKV; W = F.w_mem_kv + (size_t)lm * DM * 512; N = 512; WT = (bf16*)(F.ws + WS_WMKV + (size_t)lm * MiB); item = it % IT_MKV; }
        transpose_item(W, K, N, WT, mode, g, scr, item, lane);
    }
}
__device__ __forceinline__ void convert_filler(Frame& F, int l, int part, int nwg) {
    const int rem = nwg % F.G, c = (int)blockIdx.x;
    if (rem == 0) convert_part(F, l, part, c * NWAVES + F.wave, F.G * NWAVES);
    else if (c >= rem) convert_part(F, l, part, (c - rem) * NWAVES + F.wave, (F.G - rem) * NWAVES);
}
__device__ __forceinline__ void p0_prologue(Frame& F) {
    const int gw = F.vcu * NWAVES + F.wave, NGW = F.G * NWAVES;
    for (int part = 0; part < 3; ++part) convert_part(F, 0, part, gw, NGW);
    for (int m = gw; m < SEQ; m += NGW) {
        const GAS f32x4* xr = (const GAS f32x4*)(F.x + (size_t)m * DM) + F.lane; f32x4 v[4]; float s = 0.f;
#pragma unroll
        for (int j = 0; j < 4; ++j) { v[j] = xr[64 * j]; s += (v[j].x * v[j].x + v[j].y * v[j].y) + (v[j].z * v[j].z + v[j].w * v[j].w); }
        s = wave_sum(s);
        GAS unsigned long long* o8 = (GAS unsigned long long*)(F.ws + WS_XB + (size_t)m * DM * 2) + F.lane;
#pragma unroll
        for (int j = 0; j < 4; ++j) o8[64 * j] = (unsigned long long)pk2(v[j].x, v[j].y) | ((unsigned long long)pk2(v[j].z, v[j].w) << 32);
        if (F.lane < 16) ((GAS float*)(F.ws + WS_SSQA))[(size_t)m * 16 + F.lane] = (F.lane == 0) ? s : 0.f;
    }
    for (int m = gw; m < NMEM; m += NGW) {
        const GAS f32x4* xr = (const GAS f32x4*)(F.mem + (size_t)m * DM) + F.lane; const GAS f32x4* gr = (const GAS f32x4*)F.norm_mem + F.lane; f32x4 v[4]; float s = 0.f;
#pragma unroll
        for (int j = 0; j < 4; ++j) { v[j] = xr[64 * j]; s += (v[j].x * v[j].x + v[j].y * v[j].y) + (v[j].z * v[j].z + v[j].w * v[j].w); }
        const float rstd = 1.0f / sqrtf(wave_sum(s) * (1.0f / DM) + 1e-6f);
        GAS unsigned long long* o8 = (GAS unsigned long long*)(F.ws + WS_MEMN + (size_t)m * DM * 2) + F.lane;
#pragma unroll
        for (int j = 0; j < 4; ++j) { const f32x4 g = gr[64 * j]; const f32x4 y = v[j] * rstd * g; o8[64 * j] = (unsigned long long)pk2(y.x, y.y) | ((unsigned long long)pk2(y.z, y.w) << 32); }
    }
}
__device__ __forceinline__ void final_norm(Frame& F) {
    const int gw = F.vcu * NWAVES + F.wave, NGW = F.G * NWAVES;
    const GAS f32x4* gr = (const GAS f32x4*)F.norm_final + F.lane;
    for (int m = gw; m < SEQ; m += NGW) {
        GAS f32x4* xr = (GAS f32x4*)(F.out + (size_t)m * DM) + F.lane;
        const float rstd = pg8::row_rstd((const float*)(F.ws + WS_SSQA), m);
#pragma unroll
        for (int j = 0; j < 4; ++j) { const f32x4 v = xr[64 * j], g = gr[64 * j]; xr[64 * j] = v * rstd * g; }
    }
}
__device__ __forceinline__ att::UnitP attn_make_unit(Frame& F, int l, int u) {
    const bool isA = (l & 1) == 0; const int nkv = isA ? 4 : 12; constexpr size_t SS = (size_t)SEQ * 64, MS = (size_t)NMEM * 64;
    const att::bf16_t* P = (const att::bf16_t*)(F.ws + WS_PROJ); att::bf16_t* Y = (att::bf16_t*)(F.ws + WS_Y);
    const att::bf16_t* MKV = (const att::bf16_t*)(F.ws + WS_MKV) + (size_t)l * 8 * MS;
    att::UnitP U; U.seqlen = SEQ; U.rpb = nullptr; U.slope2 = 0.f; U.m0 = -1e30f; U.l0 = 0.f; U.qpitch = 64; U.kvpitch = 64; U.opitch = DM;
    if (u < 768) {
        const int h = u % NQH, blk = u / NQH, tok0 = blk * 256;
        U.Q = P + (size_t)h * SS + (size_t)tok0 * 64; U.O = Y + (size_t)tok0 * DM + h * 64; U.kvmax = SEQ - 1;
        if (isA) {
            U.type = 0; U.K = P + (size_t)(12 + h / 3) * SS; U.V = P + (size_t)(16 + h / 3) * SS; U.row0 = tok0 - 128; U.ntiles = 8; U.tok0 = tok0;
            U.slope2 = exp2f(-8.0f * (float)(h + 1) / 12.0f) * LOG2E; U.m0 = F.sink_a[(l >> 1) * NQH + h] * LOG2E; U.l0 = 1.f;
        } else {
            const int R0 = blk * 4; int T0 = R0 - 4; T0 = T0 < 0 ? 0 : (T0 > 248 ? 248 : T0); int T1 = R0 - 1; T1 = T1 < 0 ? 0 : (T1 > 248 ? 248 : T1); T1 += 7;
            U.type = 1; U.K = P + (size_t)(12 + h) * SS; U.V = P + (size_t)(24 + h) * SS; U.row0 = T0 * 64; U.ntiles = T1 - T0 + 1; U.tok0 = R0;
            U.rpb = F.rpb_b + ((size_t)(l >> 1) * NQH + h) * 15 * 31;
        }
    } else {
        const int v = u - 768, hm = v % NMH, blk = v / NMH, tok0 = blk * 256;
        U.type = 2; U.Q = P + (size_t)(12 + 2 * nkv + hm) * SS + (size_t)tok0 * 64; U.O = Y + (size_t)tok0 * DM + 768 + hm * 64;
        U.K = MKV + (size_t)hm * MS; U.V = MKV + (size_t)(4 + hm) * MS; U.kvmax = NMEM - 1; U.row0 = 0; U.ntiles = 4; U.tok0 = tok0;
    }
    return U;
}
__device__ __forceinline__ int attn_next_u(Frame& F, int u, int amask) {
    for (u = (u < 0) ? F.vcu : u + F.G; u < 1024; u += F.G) if (amask & (u < 768 ? 1 : 2)) break;
    return u;
}
__device__ __forceinline__ void attn_phase(Frame& F, int l, int amask) {
    int u = attn_next_u(F, -1, amask);
    if (u >= 1024) return;
    att::UnitP U = attn_make_unit(F, l, u);
    att::bf16x8 qr[4]; float rpbv; int slot0 = 0, parity = 0;
    att::attn_stream_begin(U, qr, rpbv, F.lds + RING_OFF);
    for (;;) {
        const int un = attn_next_u(F, u, amask); const bool has_next = un < 1024;
        const att::UnitP Un = attn_make_unit(F, l, has_next ? un : u);
#define ATTN_CALL(T, C, L) att::attn_unit<T, C, L>(U, Un, has_next, slot0, qr, rpbv, parity, F.lds + RING_OFF)
        const bool lagw = (ATT_LAG != 0) && F.wave >= 4;
        if (U.type == 0) { if (lagw) ATTN_CALL(0, 0, true); else ATTN_CALL(0, 0, false); }
        else if (U.type == 1) { if (F.wave & 1) { if (lagw) ATTN_CALL(1, 1, true); else ATTN_CALL(1, 1, false); } else { if (lagw) ATTN_CALL(1, 0, true); else ATTN_CALL(1, 0, false); } }
        else { if (lagw) ATTN_CALL(2, 0, true); else ATTN_CALL(2, 0, false); }
#undef ATTN_CALL
        if (!has_next) break;
        U = Un; u = un; parity ^= 1;
    }
    att::attn_stream_end();
}

struct Args { const float* in[14]; float* out; unsigned char* ws; int ph_lo, ph_hi, li, amask; };
__global__ void __launch_bounds__(NWAVES * 64, 2) skel_fwd(Args args) {
    extern __shared__ __attribute__((aligned(16))) unsigned char lds[];
    Frame F;
    F.lds = (LAS unsigned char*)lds;
    F.MISC = (volatile LAS unsigned*)(F.lds + MISC_OFF);
    F.tid = threadIdx.x; F.lane = F.tid & 63; F.wave = __builtin_amdgcn_readfirstlane(F.tid >> 6);
    F.G = gridDim.x; { const int bx = blockIdx.x; F.vcu = (F.G % 8 == 0) ? (bx % 8) * (F.G / 8) + bx / 8 : bx; }
    F.ws = args.ws; F.out = args.out; F.ctl = (gu32*)(args.ws + WS_CTL);
    F.x = args.in[0]; F.mem = args.in[1]; F.norm_mix = args.in[2]; F.norm_ffn = args.in[3]; F.norm_mem = args.in[4]; F.norm_final = args.in[5]; F.w_in_a = args.in[6]; F.sink_a = args.in[7];
    F.w_in_b = args.in[8]; F.rpb_b = args.in[9]; F.w_mem_kv = args.in[10]; F.w_out = args.in[11]; F.w_gate_up = args.in[12]; F.w_down = args.in[13];
    for (int u = F.tid; u < (LDS_BYTES - LDSCTL_OFF) / 4; u += NWAVES * 64) ((LAS unsigned*)(F.lds + LDSCTL_OFF))[u] = 0u;
    __syncthreads();
    XcdBarrier bar; bar.bar = (unsigned*)(F.ctl + CW_BAR) + args.li * XCD_BAR_WORDS; bar.x = 0; bar.st = nullptr;
    if (!MK_PER_PHASE) bar = xcd_barrier_post((unsigned*)(F.ctl + CW_BAR) + args.li * XCD_BAR_WORDS, F.MISC + 8);
    const int lo = args.ph_lo, hi = args.ph_hi;
#define IN(k) (lo <= (k) && (k) < hi)
#define SEAM(k) do { if (IN((k) + 1)) { xcd_barrier(bar); if (MK_DUP & 16) xcd_barrier(bar); } } while (0)
    typedef pg8::bf16_t pb;
    if (IN(0)) { for (int rep = 0; rep < ((MK_DUP & 1) ? 2 : 1); ++rep) { p0_prologue(F); SEAM(0); } }
    for (int l = 0; l < DEPTH; ++l) {
        const int pb0 = 1 + 5 * l; const bool isA = (l & 1) == 0; const int nin = isA ? WIN_A : WIN_B;
        if (IN(pb0)) { for (int rep = 0; rep < ((MK_DUP & 2) ? 2 : 1); ++rep) {
            { pg8::Gemm g{(const pb*)(F.ws + WS_XB), (const pb*)(F.ws + WS_WIN + win_off(l)), SEQ, nin, DM}; pg8::StaticOrder S; S.init(SEQ, nin, F.G, (int)blockIdx.x);
              pg8::EpiProj E{(pb*)(F.ws + WS_PROJ), (size_t)SEQ * 64, (const float*)(F.ws + WS_SSQA), 3, nin / 256 - 1, C2};
              pg8::gemm_phase<pg8::EpiProj, pg8::StaticOrder, true, true>(F.lds + RING_OFF, g, S, E); }
            if (l == 0) { pg8::Gemm g{(const pb*)(F.ws + WS_MEMN), (const pb*)(F.ws + WS_WMKV), NMEM, 2048, DM}; pg8::StaticOrder S; S.init(NMEM, 2048, F.G, (int)((blockIdx.x + F.G - 8) % F.G));
              pg8::EpiProj E{(pb*)(F.ws + WS_MKV), (size_t)NMEM * 64, nullptr, 0, -1, 1.f};
              pg8::gemm_phase<pg8::EpiProj, pg8::StaticOrder, true, true>(F.lds + RING_OFF, g, S, E); }
            if (l + 1 < DEPTH) convert_filler(F, l + 1, 0, (SEQ / 256) * (nin / 256));
            SEAM(pb0); }
        }
        if (IN(pb0 + 1)) { for (int rep = 0; rep < ((MK_DUP & (4 | 32 | 64)) ? 2 : 1); ++rep) { attn_phase(F, l, (rep == 0 || (MK_DUP & 4)) ? args.amask : ((MK_DUP & 32) ? 1 : 2)); SEAM(pb0 + 1); } }
        if (IN(pb0 + 2)) {
            pg8::Gemm g{(const pb*)(F.ws + WS_Y), (const pb*)(F.ws + WS_WOUT + (size_t)l * 2 * MiB), SEQ, DM, DM}; pg8::StaticOrder S; S.init(SEQ, DM, F.G, (int)blockIdx.x);
            pg8::EpiRes E{l == 0 ? F.x : (const float*)F.out, F.out, (pb*)(F.ws + WS_XB), (float*)(F.ws + WS_SSQB), DM};
            pg8::gemm_phase<pg8::EpiRes, pg8::StaticOrder, true, true>(F.lds + RING_OFF, g, S, E);
            SEAM(pb0 + 2);
        }
        if (IN(pb0 + 3)) { for (int rep = 0; rep < ((MK_DUP & 8) ? 2 : 1); ++rep) {
            pg8::Gemm g{(const pb*)(F.ws + WS_XB), (const pb*)(F.ws + WS_WGU + (size_t)l * 11 * MiB), SEQ, NGU, DM}; pg8::StaticOrder S; S.init(SEQ, NGU, F.G, (int)blockIdx.x);
            pg8::EpiGU E{(pb*)(F.ws + WS_H), DFF, (const float*)(F.ws + WS_SSQB)};
            pg8::gemm_phase<pg8::EpiGU, pg8::StaticOrder, true, true>(F.lds + RING_OFF, g, S, E);
            if (l + 1 < DEPTH) convert_filler(F, l + 1, 1, (SEQ / 256) * (NGU / 256));
            SEAM(pb0 + 3); }
        }
        if (IN(pb0 + 4)) {
            pg8::Gemm g{(const pb*)(F.ws + WS_H), (const pb*)(F.ws + WS_WDN + (size_t)l * DFF * DM * 2), SEQ, DM, DFF}; pg8::StaticOrder S; S.init(SEQ, DM, F.G, (int)blockIdx.x);
            pg8::EpiRes E{(const float*)F.out, F.out, (pb*)(F.ws + WS_XB), (float*)(F.ws + WS_SSQA), DM};
            pg8::gemm_phase<pg8::EpiRes, pg8::StaticOrder, true, true>(F.lds + RING_OFF, g, S, E);
            SEAM(pb0 + 4);
        }
    }
    if (IN(N_PHASES - 1)) final_norm(F);
#undef IN
#undef SEAM
}
#if MK_PER_PHASE && MK_NAIVE
namespace nv {
__device__ __forceinline__ float bf2f(unsigned short b) { return __uint_as_float((unsigned)b << 16); }
struct GArgs { const bf16* A; const bf16* Bt; int M, N, K, mode;
    bf16* O; int ldc; const float* ssq; int nq_tiles, qm_tile; float qscale;
    const float* base; float* out; bf16* xb; };
__global__ void __launch_bounds__(256) naive_gemm(GArgs a) {
    __shared__ float As[16][65], Bs[16][65], Bs2[16][65];
    const int tx = threadIdx.x & 15, ty = threadIdx.x >> 4, bx = blockIdx.x, by = blockIdx.y;
    float acc[4][4], acc2[4][4];
#pragma unroll
    for (int i = 0; i < 4; ++i)
#pragma unroll
        for (int j = 0; j < 4; ++j) { acc[i][j] = 0.f; acc2[i][j] = 0.f; }
    const int lr = threadIdx.x >> 2, lk = (threadIdx.x & 3) * 4;
    const int jc = bx * 64 + lr;
    const size_t brow = (a.mode == 2) ? (size_t)((jc / 128) * 256 + (jc % 128)) : (size_t)jc;
    for (int k0 = 0; k0 < a.K; k0 += 16) {
        const bf16* ap = a.A + (size_t)(by * 64 + lr) * a.K + k0 + lk; const bf16* bp = a.Bt + brow * a.K + k0 + lk;
#pragma unroll
        for (int i = 0; i < 4; ++i) { As[lk + i][lr] = bf2f(ap[i]); Bs[lk + i][lr] = bf2f(bp[i]); if (a.mode == 2) Bs2[lk + i][lr] = bf2f(bp[(size_t)128 * a.K + i]); }
        __syncthreads();
#pragma unroll
        for (int k = 0; k < 16; ++k) {
#pragma unroll
            for (int i = 0; i < 4; ++i)
#pragma unroll
                for (int j = 0; j < 4; ++j) { acc[i][j] += As[k][ty * 4 + i] * Bs[k][tx * 4 + j]; if (a.mode == 2) acc2[i][j] += As[k][ty * 4 + i] * Bs2[k][tx * 4 + j]; }
        }
        __syncthreads();
    }
#pragma unroll
    for (int i = 0; i < 4; ++i)
#pragma unroll
        for (int j = 0; j < 4; ++j) {
            const int row = by * 64 + ty * 4 + i, col = bx * 64 + tx * 4 + j;
            if (a.mode == 0) { float rs = 1.f; if (a.ssq) { float s = 0.f; for (int q = 0; q < 16; ++q) s += a.ssq[(size_t)row * 16 + q]; rs = 1.0f / sqrtf(s * (1.0f / 1024.0f) + 1e-6f); }
                const int pn = col / 256; const float sc = (pn < a.nq_tiles || pn == a.qm_tile) ? a.qscale : 1.f;
                a.O[(size_t)(col >> 6) * ((size_t)a.M * 64) + (size_t)row * 64 + (col & 63)] = (bf16)f2bf(acc[i][j] * rs * sc); }
            else if (a.mode == 1) { const size_t o = (size_t)row * a.ldc + col; const float v = a.base[o] + acc[i][j]; a.out[o] = v; a.xb[o] = (bf16)f2bf(v); }
            else { float s = 0.f; for (int q = 0; q < 16; ++q) s += a.ssq[(size_t)row * 16 + q]; const float rs = 1.0f / sqrtf(s * (1.0f / 1024.0f) + 1e-6f);
                const float g = acc[i][j] * rs, u = acc2[i][j] * rs; a.O[(size_t)row * a.ldc + col] = (bf16)f2bf(g / (1.0f + expf(-g)) * u); }
        }
}
__global__ void __launch_bounds__(256) naive_ssq(const float* x, float* ssq) {
    const int row = blockIdx.x * 256 + threadIdx.x; float s = 0.f;
    for (int c = 0; c < DM; ++c) { const float v = x[(size_t)row * DM + c]; s += v * v; }
    for (int q = 0; q < 16; ++q) ssq[(size_t)row * 16 + q] = (q == 0) ? s : 0.f;
}
__device__ __forceinline__ void ld64(const bf16* p, float (&v)[64]) {
#pragma unroll
    for (int c = 0; c < 8; ++c) { const uint4 w = *(const uint4*)(p + 8 * c); const unsigned ww[4] = {w.x, w.y, w.z, w.w};
#pragma unroll
        for (int e = 0; e < 4; ++e) { v[8 * c + 2 * e] = __uint_as_float(ww[e] << 16); v[8 * c + 2 * e + 1] = __uint_as_float(ww[e] & 0xffff0000u); } }
}
__global__ void __launch_bounds__(256) naive_attn(int type, const bf16* P, int nkv, const bf16* MKV, const float* sink, const float* rpb, bf16* Y) {
    const int idx = blockIdx.x * 256 + threadIdx.x; const int nh = (type == 2) ? NMH : NQH; const int h = idx % nh, t = idx / nh;
    constexpr size_t SS = (size_t)SEQ * 64, MS = (size_t)NMEM * 64;
    float q[64], o[64], kv[64];
    ld64(P + (size_t)(type == 2 ? 12 + 2 * nkv + h : h) * SS + (size_t)t * 64, q);
#pragma unroll
    for (int d = 0; d < 64; ++d) o[d] = 0.f;
    float m = -1e30f, l = 0.f;
    int nkeys; if (type == 0) { m = sink[h] * LOG2E; l = 1.f; nkeys = 257; } else if (type == 1) nkeys = 128; else nkeys = 256;
    const float slope2 = exp2f(-8.0f * (float)(h + 1) / 12.0f) * LOG2E;
    const int r = t / 64, c = t % 64; int rs = r - 4; rs = rs < 0 ? 0 : (rs > 248 ? 248 : rs); int cs = c - 8; cs = cs < 0 ? 0 : (cs > 48 ? 48 : cs);
    for (int i = 0; i < nkeys; ++i) {
        const bf16 *kp, *vp; float bias = 0.f;
        if (type == 0) { const int s = t - 128 + i; if (s < 0 || s >= SEQ) continue; kp = P + (size_t)(12 + h / 3) * SS + (size_t)s * 64; vp = P + (size_t)(16 + h / 3) * SS + (size_t)s * 64; bias = -slope2 * fabsf((float)(t - s)); }
        else if (type == 1) { const int kr = rs + (i >> 4), kc = cs + (i & 15); const int s = kr * 64 + kc; kp = P + (size_t)(12 + h) * SS + (size_t)s * 64; vp = P + (size_t)(24 + h) * SS + (size_t)s * 64;
            bias = rpb[(size_t)h * 15 * 31 + (kr - r + 7) * 31 + (kc - c + 15)] * LOG2E; }
        else { kp = MKV + (size_t)h * MS + (size_t)i * 64; vp = MKV + (size_t)(4 + h) * MS + (size_t)i * 64; }
        ld64(kp, kv); float dot = 0.f;
#pragma unroll
        for (int d = 0; d < 64; ++d) dot += q[d] * kv[d];
        const float sc = dot + bias, mn = fmaxf(m, sc), al = exp2f(m - mn), p = exp2f(sc - mn);
        ld64(vp, kv); l = l * al + p;
#pragma unroll
        for (int d = 0; d < 64; ++d) o[d] = o[d] * al + p * kv[d];
        m = mn;
    }
    const float il = 1.0f / l; bf16* yp = Y + (size_t)t * DM + (type == 2 ? 768 : 0) + h * 64;
#pragma unroll
    for (int d = 0; d < 64; ++d) yp[d] = (bf16)f2bf(o[d] * il);
}
}
#endif
extern "C" void kernel_launch(void* const* d_in, const int* in_sizes, int n_in, void* d_out, int out_size, void* d_ws, size_t ws_size, hipStream_t stream) {
    static int grid = 0;
    if (grid == 0) {
        if (n_in != 14 || in_sizes[0] != SEQ * DM || out_size != SEQ * DM || ws_size < WS_END) { fprintf(stderr, "kernel_launch: unexpected shapes (n_in %d, in0 %d, out %d, ws %zu); nothing launched\n", n_in, n_in > 0 ? in_sizes[0] : -1, out_size, ws_size); grid = -1; return; }
        int dev = 0, cus = 0, per_cu = 0;
        if (hipGetDevice(&dev) != hipSuccess || hipDeviceGetAttribute(&cus, hipDeviceAttributeMultiprocessorCount, dev) != hipSuccess) { grid = -1; return; }
        if (hipFuncSetAttribute((const void*)skel_fwd, hipFuncAttributeMaxDynamicSharedMemorySize, LDS_BYTES) != hipSuccess) { fprintf(stderr, "kernel_launch: hipFuncSetAttribute failed\n"); grid = -1; return; }
        if (hipOccupancyMaxActiveBlocksPerMultiprocessor(&per_cu, (const void*)skel_fwd, NWAVES * 64, LDS_BYTES) != hipSuccess || per_cu < 1)
            fprintf(stderr, "kernel_launch: note: occupancy query reports %d workgroups per CU\n", per_cu);
        (void)hipGetLastError();
        grid = cus;
    }
    if (grid < 0) return;
    if (hipMemsetAsync((char*)d_ws + WS_CTL, 0, CTL_ZERO_BYTES, stream) != hipSuccess) return;
    Args a{};
    for (int i = 0; i < 14; ++i) a.in[i] = (const float*)d_in[i];
    a.out = (float*)d_out; a.ws = (unsigned char*)d_ws; a.amask = 3;
#if MK_PER_PHASE
    unsigned char* ws = (unsigned char*)d_ws; const float* const* in = (const float* const*)d_in;
    for (int p = 0; p < N_PHASES; ++p) {
        const int l = (p - 1) / 5, k = (p - 1) % 5; const bool mid = (p > 0 && p < N_PHASES - 1);
        (void)l; (void)k; (void)ws; (void)in;
#if MK_NAIVE
        if (mid && (MK_NAIVE & 1) && k != 1) {
            const int nin = (l & 1) ? WIN_B : WIN_A;
            nv::GArgs g{};
            if (k == 0) { g.A = (const bf16*)(ws + WS_XB); g.Bt = (const bf16*)(ws + WS_WIN + win_off(l)); g.M = SEQ; g.N = nin; g.K = DM; g.mode = 0; g.O = (bf16*)(ws + WS_PROJ); g.ldc = nin; g.ssq = (const float*)(ws + WS_SSQA);
                g.nq_tiles = 3; g.qm_tile = nin / 256 - 1; g.qscale = C2;
                hipLaunchKernelGGL(nv::naive_gemm, dim3(g.N / 64, g.M / 64), dim3(256), 0, stream, g);
                if (l == 0) { nv::GArgs m{}; m.A = (const bf16*)(ws + WS_MEMN); m.Bt = (const bf16*)(ws + WS_WMKV); m.M = NMEM; m.N = 2048; m.K = DM; m.mode = 0; m.O = (bf16*)(ws + WS_MKV); m.ldc = 2048; m.ssq = nullptr; m.nq_tiles = 0; m.qm_tile = -1; m.qscale = 1.f;
                    hipLaunchKernelGGL(nv::naive_gemm, dim3(m.N / 64, m.M / 64), dim3(256), 0, stream, m); } }
            else if (k == 2) { g.A = (const bf16*)(ws + WS_Y); g.Bt = (const bf16*)(ws + WS_WOUT + (size_t)l * 2 * MiB); g.M = SEQ; g.N = DM; g.K = DM; g.mode = 1; g.ldc = DM; g.base = (l == 0) ? in[0] : (const float*)d_out; g.out = (float*)d_out; g.xb = (bf16*)(ws + WS_XB);
                hipLaunchKernelGGL(nv::naive_gemm, dim3(g.N / 64, g.M / 64), dim3(256), 0, stream, g);
                hipLaunchKernelGGL(nv::naive_ssq, dim3(SEQ / 256), dim3(256), 0, stream, (const float*)d_out, (float*)(ws + WS_SSQB)); }
            else if (k == 3) { g.A = (const bf16*)(ws + WS_XB); g.Bt = (const bf16*)(ws + WS_WGU + (size_t)l * 11 * MiB); g.M = SEQ; g.N = DFF; g.K = DM; g.mode = 2; g.O = (bf16*)(ws + WS_H); g.ldc = DFF; g.ssq = (const float*)(ws + WS_SSQB);
                hipLaunchKernelGGL(nv::naive_gemm, dim3(g.N / 64, g.M / 64), dim3(256), 0, stream, g); }
            else { g.A = (const bf16*)(ws + WS_H); g.Bt = (const bf16*)(ws + WS_WDN + (size_t)l * DFF * DM * 2); g.M = SEQ; g.N = DM; g.K = DFF; g.mode = 1; g.ldc = DM; g.base = (const float*)d_out; g.out = (float*)d_out; g.xb = (bf16*)(ws + WS_XB);
                hipLaunchKernelGGL(nv::naive_gemm, dim3(g.N / 64, g.M / 64), dim3(256), 0, stream, g);
                hipLaunchKernelGGL(nv::naive_ssq, dim3(SEQ / 256), dim3(256), 0, stream, (const float*)d_out, (float*)(ws + WS_SSQA)); }
            continue;
        }
        a.amask = 3;
        if (mid && k == 1) {
            const int pitch = (l & 1) ? 12 : 4; const bf16* P = (const bf16*)(ws + WS_PROJ); const bf16* MKV = (const bf16*)(ws + WS_MKV) + (size_t)l * 8 * NMEM * 64; bf16* Y = (bf16*)(ws + WS_Y);
            if (MK_NAIVE & ((l & 1) ? 4 : 2)) { a.amask &= ~1;
                hipLaunchKernelGGL(nv::naive_attn, dim3(SEQ * NQH / 256), dim3(256), 0, stream, (l & 1), P, pitch, MKV, in[7] + (l >> 1) * NQH, in[9] + (size_t)(l >> 1) * NQH * 15 * 31, Y); }
            if (MK_NAIVE & 8) { a.amask &= ~2;
                hipLaunchKernelGGL(nv::naive_attn, dim3(SEQ * NMH / 256), dim3(256), 0, stream, 2, P, pitch, MKV, in[7], in[9], Y); }
            if (a.amask == 0) continue;
        }
#endif
        a.ph_lo = p; a.ph_hi = p + 1; a.li = p;
        hipLaunchKernelGGL(skel_fwd, dim3(grid), dim3(NWAVES * 64), LDS_BYTES, stream, a);
    }
#else
    a.ph_lo = 0; a.ph_hi = N_PHASES; a.li = 0;
    hipLaunchKernelGGL(skel_fwd, dim3(grid), dim3(NWAVES * 64), LDS_BYTES, stream, a);
#endif
    const hipError_t le = hipPeekAtLastError();
    if (le != hipSuccess) fprintf(stderr, "kernel_launch: launch failed: %s\n", hipGetErrorName(le));
}
```

```cpp
#define MK_PER_PHASE 0
#define MK_NAIVE 0
#include <hip/hip_runtime.h>
#include <cstdio>
#include <cstdint>
namespace pg8 {
#define PG8_LAS __attribute__((address_space(3)))
typedef unsigned short bf16_t;
typedef short bf16x8 __attribute__((ext_vector_type(8)));
typedef float f32x4 __attribute__((ext_vector_type(4)));
typedef unsigned u32x4 __attribute__((ext_vector_type(4)));
constexpr int BM = 256, BK = 64, HALF = 128, HTB = HALF * BK * 2  , STAGE_BYTES = 8 * HTB, NXCD = 8, WGM = 8;

__host__ __device__ __forceinline__ int lds_byte(int r, int c) { const int st = (r >> 4) * 2 + (c >> 5), rr = r & 15, cc = c & 31, ob = rr * 64 + cc * 2; return st * 1024 + (ob ^ (((ob >> 9) & 1) << 5)); }
__host__ __device__ __forceinline__ void stage_rc(int b, int& R, int& C) { const int st = b / 1024, sb = b % 1024, swz = sb ^ (((sb >> 9) & 1) << 5); R = (st >> 1) * 16 + swz / 64; C = (st & 1) * 32 + (swz % 64) / 2; }
__host__ __device__ __forceinline__ int perm32(int rho) { const int n = rho >> 4, i = rho & 15; return 8 * (i >> 2) + 4 * n + (i & 3); }

struct Unit { int pm, pn; };
struct Gemm { const bf16_t* A; const bf16_t* Bt; int M, N, K; };

struct StaticOrder {
    int nM, nN, nwg, G, c;
    __host__ __device__ void init(int M, int N, int G_, int c_) { nM = M / BM; nN = N / BM; nwg = nM * nN; G = G_; c = c_; }
    __host__ __device__ bool next(int i, Unit& u) const {
        const long L = (long)i * G + c; if (L >= nwg) return false;
        int wgid = (int)L; { const int q = nwg / NXCD, r = nwg % NXCD, xcd = wgid % NXCD, off = wgid / NXCD; wgid = (xcd < r ? xcd * (q + 1) : r * (q + 1) + (xcd - r) * q) + off; }
        const int nig = WGM * nN, gid = wgid / nig, fm = gid * WGM, gsz = (nM - fm) < WGM ? (nM - fm) : WGM;
        u.pm = fm + ((wgid % nig) % gsz); u.pn = (wgid % nig) / gsz; return true;
    }
    __device__ __forceinline__ void a_ready(const Unit&) const {}
    __device__ __forceinline__ void done(const Unit&) const {}
};

__device__ __forceinline__ unsigned cvt_pk_bf16(float lo, float hi) { unsigned r; asm volatile("v_cvt_pk_bf16_f32 %0, %1, %2" : "=v"(r) : "v"(lo), "v"(hi)); return r; }
typedef float f32x2 __attribute__((ext_vector_type(2)));
__device__ __forceinline__ float row_rstd(const float* ssq, int row) {
    const f32x4* p = (const f32x4*)(ssq + (size_t)row * 16);
    const f32x4 a = p[0], b = p[1], c = p[2], d = p[3];
    const float s = (((a[0] + a[1]) + (a[2] + a[3])) + ((b[0] + b[1]) + (b[2] + b[3]))) + (((c[0] + c[1]) + (c[2] + c[3])) + ((d[0] + d[1]) + (d[2] + d[3])));
    return __builtin_amdgcn_rsqf(s * (1.0f / 1024.0f) + 1e-6f);
}
__device__ __forceinline__ void row_rstd8(const float* ssq, int row0, int fq, float (&rs)[2][4]) {
    f32x4 part[2][4];
#pragma unroll
    for (int ai = 0; ai < 2; ++ai)
#pragma unroll
        for (int m = 0; m < 4; ++m) part[ai][m] = *(const f32x4*)(ssq + (size_t)(row0 + ai * HALF + m * 16) * 16 + 4 * fq);
#pragma unroll
    for (int ai = 0; ai < 2; ++ai)
#pragma unroll
        for (int m = 0; m < 4; ++m) { float s = (part[ai][m][0] + part[ai][m][1]) + (part[ai][m][2] + part[ai][m][3]); s += __shfl_xor(s, 16); s += __shfl_xor(s, 32);
            rs[ai][m] = __builtin_amdgcn_rsqf(s * (1.0f / 1024.0f) + 1e-6f); }
}
struct EpiProj {
    static constexpr bool PERM = true, AFTER_DRAIN = false;
    bf16_t* O; size_t hstride; const float* ssq; int nq_tiles, qm_tile; float qscale;
    __device__ __forceinline__ void operator()(const f32x4 (&acc)[2][2][4][2], const Unit& u, int wr, int wc, int fr, int fq) const {
        const int row0 = u.pm * BM + wr * 64 + fr;
        const float sc = (u.pn < nq_tiles || u.pn == qm_tile) ? qscale : 1.f;
        const int col0 = u.pn * BM + wc * 32 + 8 * fq;
        float rs8[2][4];
        if (ssq) row_rstd8(ssq, row0, fq, rs8);
#pragma unroll
        for (int ai = 0; ai < 2; ++ai)
#pragma unroll
            for (int m = 0; m < 4; ++m) { const int row = row0 + ai * HALF + m * 16; const float rs = ssq ? rs8[ai][m] * sc : sc;
                bf16_t* rowp = O + (size_t)(col0 >> 6) * hstride + (size_t)row * 64 + (col0 & 63);
#pragma unroll
                for (int bj = 0; bj < 2; ++bj) { const f32x4 v0 = acc[ai][bj][m][0] * rs, v1 = acc[ai][bj][m][1] * rs;
                    u32x4 w; w.x = cvt_pk_bf16(v0[0], v0[1]); w.y = cvt_pk_bf16(v0[2], v0[3]); w.z = cvt_pk_bf16(v1[0], v1[1]); w.w = cvt_pk_bf16(v1[2], v1[3]);
                    *(u32x4*)(rowp + bj * 2 * hstride) = w; } }
    }
};
struct EpiRes {
    static constexpr bool PERM = true, AFTER_DRAIN = false;
    const float* base; float* out; bf16_t* xb; float* ssq_out; int ldc;
    __device__ __forceinline__ void operator()(const f32x4 (&acc)[2][2][4][2], const Unit& u, int wr, int wc, int fr, int fq) const {
        const int row0 = u.pm * BM + wr * 64 + fr;
        const int col0 = u.pn * BM + wc * 32 + 8 * fq;
#pragma unroll
        for (int ai = 0; ai < 2; ++ai) {
            f32x4 pre[4][2][2];
#pragma unroll
            for (int m = 0; m < 4; ++m) { const size_t off = (size_t)(row0 + ai * HALF + m * 16) * ldc + col0;
#pragma unroll
                for (int bj = 0; bj < 2; ++bj) { pre[m][bj][0] = *(const f32x4*)(base + off + bj * HALF); pre[m][bj][1] = *(const f32x4*)(base + off + bj * HALF + 4); } }
            asm volatile("" ::: "memory");
#pragma unroll
            for (int m = 0; m < 4; ++m) { const int row = row0 + ai * HALF + m * 16; const size_t off = (size_t)row * ldc + col0; float ss = 0.f;
#pragma unroll
                for (int bj = 0; bj < 2; ++bj) { const f32x4 v0 = pre[m][bj][0] + acc[ai][bj][m][0], v1 = pre[m][bj][1] + acc[ai][bj][m][1];
                    *(f32x4*)(out + off + bj * HALF) = v0; *(f32x4*)(out + off + bj * HALF + 4) = v1;
                    u32x4 w; w.x = cvt_pk_bf16(v0[0], v0[1]); w.y = cvt_pk_bf16(v0[2], v0[3]); w.z = cvt_pk_bf16(v1[0], v1[1]); w.w = cvt_pk_bf16(v1[2], v1[3]);
                    *(u32x4*)(xb + off + bj * HALF) = w;
                    ss += ((v0[0] * v0[0] + v0[1] * v0[1]) + (v0[2] * v0[2] + v0[3] * v0[3])) + ((v1[0] * v1[0] + v1[1] * v1[1]) + (v1[2] * v1[2] + v1[3] * v1[3])); }
                ss += __shfl_xor(ss, 16); ss += __shfl_xor(ss, 32);
                if (fq == 0) ssq_out[(size_t)row * 16 + u.pn * 4 + wc] = ss; }
        }
    }
};
struct EpiGU {
    static constexpr bool PERM = true, AFTER_DRAIN = false;
    bf16_t* H; int ldh; const float* ssq;
    static __device__ __forceinline__ float swi(float g, float u) { return g * u * __builtin_amdgcn_rcpf(1.0f + __builtin_amdgcn_exp2f(-1.4426950408889634f * g)); }
    __device__ __forceinline__ void operator()(const f32x4 (&acc)[2][2][4][2], const Unit& u, int wr, int wc, int fr, int fq) const {
        const int row0 = u.pm * BM + wr * 64 + fr;
        const int col0 = u.pn * HALF + wc * 32 + 8 * fq;
        float rs8[2][4];
        row_rstd8(ssq, row0, fq, rs8);
#pragma unroll
        for (int ai = 0; ai < 2; ++ai)
#pragma unroll
            for (int m = 0; m < 4; ++m) { const int row = row0 + ai * HALF + m * 16; const float rs = rs8[ai][m];
                const f32x4 g0 = acc[ai][0][m][0] * rs, g1 = acc[ai][0][m][1] * rs, u0 = acc[ai][1][m][0] * rs, u1 = acc[ai][1][m][1] * rs;
                u32x4 w; w.x = cvt_pk_bf16(swi(g0[0], u0[0]), swi(g0[1], u0[1])); w.y = cvt_pk_bf16(swi(g0[2], u0[2]), swi(g0[3], u0[3]));
                w.z = cvt_pk_bf16(swi(g1[0], u1[0]), swi(g1[1], u1[1])); w.w = cvt_pk_bf16(swi(g1[2], u1[2]), swi(g1[3], u1[3]));
                *(u32x4*)(H + (size_t)row * ldh + col0) = w; }
    }
};
template <class Epi, class Sched, bool ALIGN_EPI = false, bool SP2 = false>
__device__ __forceinline__ void gemm_phase(PG8_LAS unsigned char* lds, const Gemm g, const Sched& S, const Epi& E) {
    int tid_ = threadIdx.x; asm volatile("" : "+v"(tid_));
    const int tid = tid_, wid = __builtin_amdgcn_readfirstlane(tid >> 6), lane = tid & 63, wr = wid >> 2, wc = wid & 3, fr = lane & 15, fq = lane >> 4;
    const int K = g.K, nt = K / BK;
    unsigned voffA[2], voffB[2];
#pragma unroll
    for (int i = 0; i < 2; ++i) { int R, C; stage_rc(tid * 16 + i * 8192, R, C); const int Rb = Epi::PERM ? ((R & ~31) + perm32(R & 31)) : R;
        voffA[i] = (unsigned)(R * K + C) * 2u; voffB[i] = (unsigned)(Rb * K + C) * 2u; }
    const size_t kstep = (size_t)(BK * 2);
    const size_t hstep = (size_t)HALF * K * 2;
    const size_t tstep = 2 * hstep;
    const unsigned ldsw = (unsigned)wid * 1024u;
    const int aoff = lds_byte(wr * 64 + fr, fq * 8), boff = lds_byte(wc * 32 + fr, fq * 8);
#define PG8_SA(b, h) (((b) * 2 + (h)) * HTB)
#define PG8_SB(b, h) ((4 + (b) * 2 + (h)) * HTB)
#define PG8_STAGE(bufoff, gbase, voff) do { _Pragma("unroll") for (int _i = 0; _i < 2; ++_i) \
        __builtin_amdgcn_global_load_lds((const unsigned*)((const char*)(gbase) + (voff)[_i]), (PG8_LAS unsigned*)(lds + (bufoff) + ldsw + _i * 8192), 16, 0, 0); } while (0)
#define PG8_LDA(dst, b, h) do { _Pragma("unroll") for (int m = 0; m < 4; ++m) _Pragma("unroll") for (int k = 0; k < 2; ++k) dst[m][k] = *(const PG8_LAS bf16x8*)(lds + PG8_SA(b, h) + aoff + m * 2048 + k * 1024); } while (0)
#define PG8_LDB(dst, b, h) do { _Pragma("unroll") for (int n = 0; n < 2; ++n) _Pragma("unroll") for (int k = 0; k < 2; ++k) dst[n][k] = *(const PG8_LAS bf16x8*)(lds + PG8_SB(b, h) + boff + n * 2048 + k * 1024); } while (0)
#define PG8_MMA(ai, bj, At, Bt) do { __builtin_amdgcn_s_setprio(1); _Pragma("unroll") for (int m = 0; m < 4; ++m) _Pragma("unroll") for (int n = 0; n < 2; ++n) _Pragma("unroll") for (int k = 0; k < 2; ++k) \
        acc[ai][bj][m][n] = __builtin_amdgcn_mfma_f32_16x16x32_bf16(Bt[n][k], At[m][k], acc[ai][bj][m][n], 0, 0, 0); __builtin_amdgcn_s_setprio(0); } while (0)
#define PG8_WAIT_V(n) asm volatile("s_waitcnt vmcnt(" #n ")" ::: "memory")
#define PG8_WAIT_L(n) asm volatile("s_waitcnt lgkmcnt(" #n ")" ::: "memory")
#define PG8_BAR __builtin_amdgcn_s_barrier()
#define PG8_SCHED __builtin_amdgcn_sched_barrier(0)
    Unit cur, nxt; int ui = 0;
    if (!S.next(0, cur)) return;
    f32x4 acc[2][2][4][2];
#pragma unroll
    for (int a = 0; a < 2; ++a)
#pragma unroll
        for (int b = 0; b < 2; ++b)
#pragma unroll
            for (int m = 0; m < 4; ++m)
#pragma unroll
                for (int n = 0; n < 2; ++n) acc[a][b][m][n] = (f32x4){0.f, 0.f, 0.f, 0.f};
    bf16x8 At[4][2], B0[2][2], B1[2][2];
    const char* cA = (const char*)g.A + (size_t)cur.pm * tstep; const char* cB = (const char*)g.Bt + (size_t)cur.pn * tstep;
    S.a_ready(cur);
    if constexpr (SP2) {
        PG8_STAGE(PG8_SB(0, 0), cB, voffB); PG8_STAGE(PG8_SB(0, 1), cB + hstep, voffB); PG8_STAGE(PG8_SA(0, 0), cA, voffA); PG8_STAGE(PG8_SA(0, 1), cA + hstep, voffA);
        if (wr == 1) PG8_BAR;
        PG8_WAIT_V(2); PG8_BAR;
        PG8_STAGE(PG8_SB(1, 0), cB + kstep, voffB); PG8_STAGE(PG8_SA(1, 0), cA + kstep, voffA); PG8_STAGE(PG8_SB(1, 1), cB + hstep + kstep, voffB);
        PG8_WAIT_V(6); PG8_BAR;
    } else {
        PG8_STAGE(PG8_SB(0, 0), cB, voffB); PG8_STAGE(PG8_SA(0, 0), cA, voffA); PG8_STAGE(PG8_SB(0, 1), cB + hstep, voffB); PG8_STAGE(PG8_SA(0, 1), cA + hstep, voffA);
        if (wr == 1) PG8_BAR;
        PG8_WAIT_V(4); PG8_BAR;
        PG8_STAGE(PG8_SB(1, 0), cB + kstep, voffB); PG8_STAGE(PG8_SA(1, 0), cA + kstep, voffA); PG8_STAGE(PG8_SB(1, 1), cB + hstep + kstep, voffB);
        PG8_WAIT_V(6); PG8_BAR;
    }
    for (;;) {
        const bool has_next = S.next(ui + 1, nxt);
        const char* nA = has_next ? (const char*)g.A + (size_t)nxt.pm * tstep : cA; const char* nB = has_next ? (const char*)g.Bt + (size_t)nxt.pn * tstep : cB;
        for (int t = 0; t < nt; t += 2) {
            const bool last = (t == nt - 2);
            const char* a1 = cA + (size_t)(t + 1) * kstep;
            const char* a2 = last ? nA : cA + (size_t)(t + 2) * kstep; const char* b2 = last ? nB : cB + (size_t)(t + 2) * kstep;
            const char* a3 = a2 + kstep; const char* b3 = b2 + kstep;
            if (last && has_next) S.a_ready(nxt);
            if constexpr (SP2) {
            PG8_LDB(B0, 0, 0); PG8_LDB(B1, 0, 1); PG8_SCHED; PG8_LDA(At, 0, 0); PG8_STAGE(PG8_SA(1, 1), a1 + hstep, voffA);
            PG8_WAIT_V(8); PG8_WAIT_L(0); PG8_BAR; PG8_MMA(0, 0, At, B0); PG8_MMA(0, 1, At, B1); PG8_BAR; PG8_SCHED;
            PG8_LDA(At, 0, 1); PG8_STAGE(PG8_SB(0, 0), b2, voffB); PG8_STAGE(PG8_SB(0, 1), b2 + hstep, voffB); PG8_STAGE(PG8_SA(0, 0), a2, voffA);
            PG8_WAIT_V(8); PG8_WAIT_L(0); PG8_BAR; PG8_MMA(1, 0, At, B0); PG8_MMA(1, 1, At, B1); PG8_BAR; PG8_SCHED;
            PG8_LDB(B0, 1, 0); PG8_LDB(B1, 1, 1); PG8_SCHED; PG8_LDA(At, 1, 0); PG8_STAGE(PG8_SA(0, 1), a2 + hstep, voffA);
            PG8_WAIT_V(8); PG8_WAIT_L(0); PG8_BAR; PG8_MMA(0, 0, At, B0); PG8_MMA(0, 1, At, B1); PG8_BAR; PG8_SCHED;
            PG8_LDA(At, 1, 1); PG8_STAGE(PG8_SB(1, 0), b3, voffB); PG8_STAGE(PG8_SB(1, 1), b3 + hstep, voffB); PG8_STAGE(PG8_SA(1, 0), a3, voffA);
            PG8_WAIT_V(8); PG8_WAIT_L(0); PG8_BAR; PG8_MMA(1, 0, At, B0); PG8_MMA(1, 1, At, B1); PG8_BAR; PG8_SCHED;
            } else {
            PG8_LDB(B0, 0, 0); PG8_SCHED; PG8_LDA(At, 0, 0); PG8_STAGE(PG8_SA(1, 1), a1 + hstep, voffA);
            PG8_WAIT_L(8); PG8_BAR; PG8_WAIT_L(0); PG8_MMA(0, 0, At, B0); PG8_BAR; PG8_SCHED;
            PG8_LDB(B1, 0, 1); PG8_STAGE(PG8_SB(0, 0), b2, voffB);
            PG8_BAR; PG8_WAIT_L(0); PG8_MMA(0, 1, At, B1); PG8_BAR;
            PG8_LDA(At, 0, 1); PG8_STAGE(PG8_SA(0, 0), a2, voffA);
            PG8_BAR; PG8_WAIT_L(0); PG8_MMA(1, 0, At, B0); PG8_BAR; PG8_SCHED;
            PG8_STAGE(PG8_SB(0, 1), b2 + hstep, voffB);
            PG8_WAIT_V(6); PG8_BAR; PG8_MMA(1, 1, At, B1); PG8_BAR;
            PG8_LDB(B0, 1, 0); PG8_SCHED; PG8_LDA(At, 1, 0); PG8_STAGE(PG8_SA(0, 1), a2 + hstep, voffA);
            PG8_WAIT_L(8); PG8_BAR; PG8_WAIT_L(0); PG8_MMA(0, 0, At, B0); PG8_BAR; PG8_SCHED;
            PG8_LDB(B1, 1, 1); PG8_STAGE(PG8_SB(1, 0), b3, voffB);
            PG8_BAR; PG8_WAIT_L(0); PG8_MMA(0, 1, At, B1); PG8_BAR;
            PG8_LDA(At, 1, 1); PG8_STAGE(PG8_SA(1, 0), a3, voffA);
            PG8_BAR; PG8_WAIT_L(0); PG8_MMA(1, 0, At, B0); PG8_BAR; PG8_SCHED;
            PG8_STAGE(PG8_SB(1, 1), b3 + hstep, voffB);
            PG8_WAIT_V(6); PG8_BAR; PG8_MMA(1, 1, At, B1); PG8_BAR;
            }
        }
        if constexpr (ALIGN_EPI) { if (wr == 0) PG8_BAR; }
        if constexpr (!Epi::AFTER_DRAIN) { E(acc, cur, wr, wc, fr, fq); S.done(cur); }
        if (!has_next) break;
#pragma unroll
        for (int a = 0; a < 2; ++a)
#pragma unroll
            for (int b = 0; b < 2; ++b)
#pragma unroll
                for (int m = 0; m < 4; ++m)
#pragma unroll
                    for (int n = 0; n < 2; ++n) acc[a][b][m][n] = (f32x4){0.f, 0.f, 0.f, 0.f};
        cur = nxt; cA = nA; cB = nB; ++ui;
        if constexpr (ALIGN_EPI) { if (wr == 1) PG8_BAR; }
    }
    PG8_WAIT_V(0);
    if constexpr (!ALIGN_EPI) { if (wr == 0) PG8_BAR; }
    PG8_BAR;
    if constexpr (Epi::AFTER_DRAIN) { E.fused(acc, cur, wr, wc, fr, fq, lds, wid, lane); S.done(cur); }
#undef PG8_SA
#undef PG8_SB
#undef PG8_STAGE
#undef PG8_LDA
#undef PG8_LDB
#undef PG8_MMA
#undef PG8_WAIT_V
#undef PG8_WAIT_L
#undef PG8_BAR
#undef PG8_SCHED
}
}
namespace att {
typedef unsigned short bf16_t;
using bf16x8 = __attribute__((ext_vector_type(8))) short;
using s16x4 = __attribute__((ext_vector_type(4))) short;
using f32x16 = __attribute__((ext_vector_type(16))) float;
using u32x4 = __attribute__((ext_vector_type(4))) unsigned;
#define ATT_LAS __attribute__((address_space(3)))
constexpr int NW = 8, PF = 4, NSLOT = PF + 2, SLOTB = 16384, VOFF = 8192, TABF = 640;
constexpr int LDS_WS = NSLOT * SLOTB, LDS_OST = LDS_WS + NW * 256, LDS_TAB = LDS_OST + NW * 4096, TAB_PAD = 64, LDS_END = LDS_TAB + 2 * TABF * 4;
constexpr float NEG_INF = -__builtin_inff();
__device__ __forceinline__ constexpr int crow(int r, int hi) { return (r & 3) + 8 * (r >> 2) + 4 * hi; }
__device__ __forceinline__ void glds16(const void* gsrc, unsigned lds_dst) { unsigned keep;
    asm volatile("s_mov_b32 %0, m0\n\ts_mov_b32 m0, %2\n\ts_nop 0\n\tglobal_load_lds_dwordx4 %1, off\n\ts_mov_b32 m0, %0" : "=&s"(keep) : "v"(gsrc), "s"(lds_dst) : "memory"); }
__device__ __forceinline__ float fadd_s(float a, float b) { float r; asm("v_add_f32_e32 %0, %1, %2" : "=v"(r) : "v"(a), "v"(b)); return r; }
__device__ __forceinline__ float fsub_s(float a, float b) { float r; asm("v_sub_f32_e32 %0, %1, %2" : "=v"(r) : "v"(a), "v"(b)); return r; }
__device__ __forceinline__ float fmul_s(float a, float b) { float r; asm("v_mul_f32_e32 %0, %1, %2" : "=v"(r) : "v"(a), "v"(b)); return r; }
#define ATT_FMAMK(dst, a, K, c) asm("v_fmamk_f32 %0, %1, %3, %2" : "=v"(dst) : "v"(a), "v"(c), "i"(__builtin_bit_cast(int, (float)(K))))
#define ATT_MFMA_PAD(x, y) asm volatile("s_nop 15\n\ts_nop 7" : "+v"(x), "+v"(y))
__device__ __forceinline__ float max3f(float a, float b, float c) { return __builtin_fmaxf(__builtin_fmaxf(a, b), c); }
typedef float f32x2_t __attribute__((ext_vector_type(2))); typedef __bf16 bf16x2_t __attribute__((ext_vector_type(2)));
__device__ __forceinline__ unsigned cvtpk_s(float lo, float hi) { f32x2_t v = {lo, hi}; bf16x2_t b = __builtin_convertvector(v, bf16x2_t); return __builtin_bit_cast(unsigned, b); }

__device__ __forceinline__ void qkt(f32x16& p0, f32x16& p1, const ATT_LAS char* kp, const bf16x8* qr, const f32x16& z) {
#pragma unroll
    for (int d0 = 0; d0 < 4; ++d0) {
        const bf16x8 b0 = *(const ATT_LAS bf16x8*)(kp + d0 * 2048);
        const bf16x8 b1 = *(const ATT_LAS bf16x8*)(kp + d0 * 2048 + 512);
        if (d0 == 0) { p0 = __builtin_amdgcn_mfma_f32_32x32x16_bf16(b0, qr[0], z, 0, 0, 0); p1 = __builtin_amdgcn_mfma_f32_32x32x16_bf16(b1, qr[0], z, 0, 0, 0); }
        else { p0 = __builtin_amdgcn_mfma_f32_32x32x16_bf16(b0, qr[d0], p0, 0, 0, 0); p1 = __builtin_amdgcn_mfma_f32_32x32x16_bf16(b1, qr[d0], p1, 0, 0, 0); } }
}
__device__ __forceinline__ float rowmax(const f32x16& p0, const f32x16& p1) {
    float a = max3f(p0[0], p0[1], p1[0]), b = max3f(p0[2], p0[3], p1[1]); a = max3f(a, p1[2], p1[3]);
#pragma unroll
    for (int r = 4; r < 16; r += 4) { a = max3f(a, p0[r], p0[r + 1]); b = max3f(b, p0[r + 2], p0[r + 3]); a = max3f(a, p1[r], p1[r + 1]); b = max3f(b, p1[r + 2], p1[r + 3]); }
    const float m = __builtin_fmaxf(a, b);
    auto rr = __builtin_amdgcn_permlane32_swap(__float_as_uint(m), __float_as_uint(m), false, false);
    return __builtin_fmaxf(__uint_as_float(rr[0]), __uint_as_float(rr[1]));
}
__device__ __forceinline__ void pv(f32x16* o, int vb, bf16x8 pa0, bf16x8 pa1, bf16x8 pa2, bf16x8 pa3) {
#pragma unroll
    for (int d0 = 0; d0 < 2; ++d0) { s16x4 lo[4], hi[4];
#pragma unroll
        for (int ks = 0; ks < 4; ++ks) {
            asm volatile("ds_read_b64_tr_b16 %0,%1 offset:%c2" : "=&v"(lo[ks]) : "v"(vb), "i"(d0 * 4096 + ks * 1024) : "memory");
            asm volatile("ds_read_b64_tr_b16 %0,%1 offset:%c2" : "=&v"(hi[ks]) : "v"(vb), "i"(d0 * 4096 + ks * 1024 + 512) : "memory"); }
        asm volatile("s_waitcnt lgkmcnt(0)" ::: "memory"); __builtin_amdgcn_sched_barrier(0);
#define ATT_PK(k) (bf16x8){lo[k][0], lo[k][1], lo[k][2], lo[k][3], hi[k][0], hi[k][1], hi[k][2], hi[k][3]}
        o[d0] = __builtin_amdgcn_mfma_f32_32x32x16_bf16(pa0, ATT_PK(0), o[d0], 0, 0, 0);
        o[d0] = __builtin_amdgcn_mfma_f32_32x32x16_bf16(pa1, ATT_PK(1), o[d0], 0, 0, 0);
        o[d0] = __builtin_amdgcn_mfma_f32_32x32x16_bf16(pa2, ATT_PK(2), o[d0], 0, 0, 0);
        o[d0] = __builtin_amdgcn_mfma_f32_32x32x16_bf16(pa3, ATT_PK(3), o[d0], 0, 0, 0);
#undef ATT_PK
    }
}

struct UnitP {
    const bf16_t* Q; int qpitch;
    const bf16_t* K; const bf16_t* V; int kvpitch, kvmax;
    int row0, ntiles;
    bf16_t* O; int opitch;
    int tok0;
    float slope2, m0, l0;
    const float* rpb;
    int seqlen;
    int type;
};
template <int AK> __device__ __forceinline__ constexpr bool act(int half, int r) { return AK == 0 ? true : (AK == 1 ? (half == 0 || r < 4) : (half == 1 || r >= 12)); }
#ifndef ATT_LAG
#define ATT_LAG 1
#endif
#define ATT_THR 8.0f
#define ATT_LOW 24.0f
template <int AK, bool USE_LOW>
__device__ __forceinline__ void softmax_pv(f32x16& p0, f32x16& p1, float& mhat, f32x16& negm, float& l, f32x16* o, ATT_LAS float* wsf, int vb, int r32, int hi) {
    float a_ = NEG_INF, b_ = NEG_INF;
#pragma unroll
    for (int r = 0; r < 16; r += 2) { if (act<AK>(0, r)) a_ = max3f(a_, p0[r], p0[r + 1]); if (act<AK>(1, r)) b_ = max3f(b_, p1[r], p1[r + 1]); }
    float rm = __builtin_fmaxf(a_, b_);
    { auto rr = __builtin_amdgcn_permlane32_swap(__float_as_uint(rm), __float_as_uint(rm), false, false); rm = __builtin_fmaxf(__uint_as_float(rr[0]), __uint_as_float(rr[1])); }
    const bool need_ = (rm > ATT_THR) || (USE_LOW && rm < -ATT_LOW && rm > -1e30f);
    if (__builtin_expect(__any(need_), 0)) {
        const float dl = need_ ? rm : 0.f; mhat += dl;
#pragma unroll
        for (int r = 0; r < 16; ++r) { if (act<AK>(0, r)) p0[r] = fsub_s(p0[r], dl); if (act<AK>(1, r)) p1[r] = fsub_s(p1[r], dl); negm[r] = -mhat; }
        asm volatile("" : "+v"(negm));
        const float f_ = __builtin_amdgcn_exp2f(-dl); l *= f_;
        if (hi == 0) wsf[r32] = f_;
        asm volatile("s_waitcnt lgkmcnt(0)" ::: "memory");
#pragma unroll
        for (int r = 0; r < 16; ++r) { const float f = wsf[crow(r, hi)]; o[0][r] *= f; o[1][r] *= f; }
        asm volatile("" ::: "memory");
    }
    float sacc = 0.f;
#pragma unroll
    for (int r = 0; r < 16; ++r) {
        if (act<AK>(0, r)) p0[r] = __builtin_amdgcn_exp2f(p0[r]); else p0[r] = 0.f;
        if (act<AK>(1, r)) p1[r] = __builtin_amdgcn_exp2f(p1[r]); else p1[r] = 0.f; }
#pragma unroll
    for (int r = 0; r < 16; ++r) { if (act<AK>(0, r)) sacc += p0[r]; if (act<AK>(1, r)) sacc += p1[r]; }
    l += sacc;
    u32x4 pw0, pw1, pw2, pw3;
    pw0 = (u32x4){cvtpk_s(p0[0], p0[1]), cvtpk_s(p0[2], p0[3]), cvtpk_s(p0[4], p0[5]), cvtpk_s(p0[6], p0[7])};
    pw1 = (u32x4){cvtpk_s(p0[8], p0[9]), cvtpk_s(p0[10], p0[11]), cvtpk_s(p0[12], p0[13]), cvtpk_s(p0[14], p0[15])};
    pw2 = (u32x4){cvtpk_s(p1[0], p1[1]), cvtpk_s(p1[2], p1[3]), cvtpk_s(p1[4], p1[5]), cvtpk_s(p1[6], p1[7])};
    pw3 = (u32x4){cvtpk_s(p1[8], p1[9]), cvtpk_s(p1[10], p1[11]), cvtpk_s(p1[12], p1[13]), cvtpk_s(p1[14], p1[15])};
    __builtin_amdgcn_sched_barrier(0);
    pv(o, vb, __builtin_bit_cast(bf16x8, pw0), __builtin_bit_cast(bf16x8, pw1), __builtin_bit_cast(bf16x8, pw2), __builtin_bit_cast(bf16x8, pw3));
}

template <int TYPE, int AK>
__device__ __forceinline__ void qk_bias(f32x16& p0, f32x16& p1, const ATT_LAS char* kp, const bf16x8* qr, const f32x16& negm, float slope2, float dqf, int tl, const ATT_LAS float* tb, const float (&ng0)[16], const float (&ng1)[16]) {
    qkt(p0, p1, kp, qr, negm);
    ATT_MFMA_PAD(p0, p1);
    if (TYPE == 0) {
        if (tl < 2) {
            const float lc0 = -slope2 * dqf, lc1 = lc0 + 32.f * slope2;
#pragma unroll
            for (int r = 0; r < 16; ++r) { float x0, x1; ATT_FMAMK(x0, slope2, (r & 3) + 8 * (r >> 2), p0[r]); ATT_FMAMK(x1, slope2, (r & 3) + 8 * (r >> 2), p1[r]); p0[r] = fadd_s(x0, lc0); p1[r] = fadd_s(x1, lc1); }
            if (tl == 0) { const float thr = dqf - 128.f;
#pragma unroll
                for (int r = 0; r < 16; ++r) { const float cr = (float)((r & 3) + 8 * (r >> 2)); p0[r] = (cr >= thr) ? p0[r] : NEG_INF; p1[r] = (cr + 32.f >= thr) ? p1[r] : NEG_INF; } }
        } else if (tl > 2) {
            const float nslope = -slope2; const float lc0 = slope2 * dqf, lc1 = lc0 - 32.f * slope2;
#pragma unroll
            for (int r = 0; r < 16; ++r) { float x0, x1; ATT_FMAMK(x0, nslope, (r & 3) + 8 * (r >> 2), p0[r]); ATT_FMAMK(x1, nslope, (r & 3) + 8 * (r >> 2), p1[r]); p0[r] = fadd_s(x0, lc0); p1[r] = fadd_s(x1, lc1); }
            if (tl == 4) { const float thr = dqf + 128.f;
#pragma unroll
                for (int r = 0; r < 16; ++r) { const float cr = (float)((r & 3) + 8 * (r >> 2)); p0[r] = (cr <= thr) ? p0[r] : NEG_INF; p1[r] = (cr + 32.f <= thr) ? p1[r] : NEG_INF; } }
        } else {
#pragma unroll
            for (int r = 0; r < 16; ++r) { const float cr = (float)((r & 3) + 8 * (r >> 2)); const float a0 = __builtin_fabsf(dqf - cr), a1 = __builtin_fabsf(dqf - (cr + 32.f));
                p0[r] = __builtin_fmaf(-slope2, a0, p0[r]); p1[r] = __builtin_fmaf(-slope2, a1, p1[r]); }
        }
    } else if (TYPE == 1) {
#pragma unroll
        for (int r = 0; r < 16; ++r) { const int cr = (r & 3) + 8 * (r >> 2);
            if (act<AK>(0, r)) { const float b0 = tb[cr]; p0[r] = fadd_s(fadd_s(p0[r], b0), ng0[r]); }
            if (act<AK>(1, r)) { const float b1 = tb[cr + 32]; p1[r] = fadd_s(fadd_s(p1[r], b1), ng1[r]); } }
    }
}
#define ATT_CLAMPU(UU, r) ((r) < 0 ? 0 : ((r) > (UU).kvmax ? (UU).kvmax : (r)))
#define ATT_DMA_U(UU, t, slot) do { const int rb_ = (UU).row0 + 64 * (t); const int kr_ = ATT_CLAMPU(UU, rb_ + lane), vr_ = ATT_CLAMPU(UU, rb_ + 16 * (wid & 3) + (lane >> 2)); \
        glds16((UU).K + wid * 8 + (size_t)kr_ * (UU).kvpitch, (unsigned)__builtin_amdgcn_readfirstlane(lds0 + wid * 1024 + (slot) * SLOTB)); \
        glds16((UU).V + (wid >> 2) * 32 + (lane & 3) * 8 + (size_t)vr_ * (UU).kvpitch, (unsigned)__builtin_amdgcn_readfirstlane(lds0 + VOFF + wid * 1024 + (slot) * SLOTB)); } while (0)
#define ATT_LOADQ(UU, q) do { const bf16_t* Qw_ = (UU).Q + (size_t)(wid * 32 + r32) * (UU).qpitch + hi * 8; \
        _Pragma("unroll") for (int d0 = 0; d0 < 4; ++d0) (q)[d0] = *(const bf16x8*)(Qw_ + d0 * 16); } while (0)
#define ATT_LOADQ_ASM(UU, q) do { const bf16_t* Qw_ = (UU).Q + (size_t)(wid * 32 + r32) * (UU).qpitch + hi * 8; \
        asm volatile("global_load_dwordx4 %0, %4, off\n\tglobal_load_dwordx4 %1, %4, off offset:32\n\tglobal_load_dwordx4 %2, %4, off offset:64\n\tglobal_load_dwordx4 %3, %4, off offset:96" \
            : "=&v"((q)[0]), "=&v"((q)[1]), "=&v"((q)[2]), "=&v"((q)[3]) : "v"(Qw_) : "memory"); } while (0)
#define ATT_LOADF_ASM(dst, ptr) asm volatile("global_load_dword %0, %1, off" : "=&v"(dst) : "v"(ptr) : "memory")
template <int TYPE, int CH, bool LAG>
__device__ __forceinline__ void attn_unit(const UnitP& U, const UnitP& Un, bool has_next, int& slot0, bf16x8 (&qr)[4], float& rpbv, int parity, ATT_LAS unsigned char* lds, unsigned& ts_acc) {
#if MK_TS
#define ATT_TS(id, stmt) do { if (MK_TS == (id)) { const unsigned t0_ = (unsigned)__builtin_amdgcn_s_memtime(); stmt; ts_acc += (unsigned)__builtin_amdgcn_s_memtime() - t0_; } else { stmt; } } while (0)
#else
#define ATT_TS(id, stmt) do { stmt; } while (0)
#endif
    int tid_ = threadIdx.x; asm volatile("" : "+v"(tid_));
    const int tid = tid_, lane = tid & 63, r32 = lane & 31, hi = lane >> 5; const int wid = __builtin_amdgcn_readfirstlane(tid >> 6);
    const unsigned lds0 = (unsigned)(uintptr_t)lds;
    const ATT_LAS char* shm3 = (const ATT_LAS char*)lds;
    ATT_LAS float* wsf = (ATT_LAS float*)(lds + LDS_WS) + wid * 64;
    ATT_LAS float* tab = (ATT_LAS float*)(lds + LDS_TAB) + parity * TABF;
    if (TYPE == 1) { if (tid < 15 * 31) tab[TAB_PAD + tid] = rpbv * 1.4426950408889634f; }
    const int NT = U.ntiles;
    float mhat = (TYPE == 0) ? U.m0 : 0.f, l = (hi == 0) ? U.l0 : 0.f;
    f32x16 negm;
#pragma unroll
    for (int r = 0; r < 16; ++r) negm[r] = -mhat;
    asm volatile("" : "+v"(negm));
    f32x16 o[2]; o[0] = f32x16{}; o[1] = f32x16{};
    const int vb0 = (int)(lds0 + VOFF) + ((lane >> 4) & 1) * 32 + (lane & 3) * 8 + (4 * hi + ((lane & 15) >> 2)) * 64;
    const ATT_LAS char* kp0 = shm3 + hi * 1024 + r32 * 16;
    int t_lo, t_hi;
    if (TYPE == 0) { t_lo = wid >> 1; t_hi = t_lo + 4; }
    else if (TYPE == 1) { const int r = U.tok0 + (wid >> 1); int rs = r - 4; rs = rs < 0 ? 0 : (rs > 248 ? 248 : rs); const int T0 = U.row0 >> 6; t_lo = rs - T0; t_hi = t_lo + 7; }
    else { t_lo = 0; t_hi = NT - 1; }
    float ng0[16], ng1[16];
#pragma unroll
    for (int r = 0; r < 16; ++r) { ng0[r] = 0.f; ng1[r] = 0.f; }
    if (TYPE == 1) { const int c = 32 * (wid & 1) + r32; int cs = c - 8; cs = cs < 0 ? 0 : (cs > 48 ? 48 : cs); const int kc = 4 * hi - cs;
#pragma unroll
        for (int r = 0; r < 16; ++r) { const int cr = (r & 3) + 8 * (r >> 2); ng0[r] = ((unsigned)(kc + cr) < 16u) ? 0.f : NEG_INF; ng1[r] = ((unsigned)(kc + cr + 32) < 16u) ? 0.f : NEG_INF; } }
    float rpbn;
    constexpr int AK = (TYPE == 1) ? (CH == 0 ? 1 : 2) : 0;
    constexpr bool lag = LAG;
    f32x16 p0 = f32x16{}, p1 = f32x16{}; bool pend = false; int pend_slot = 0;
#define ATT_QK_BIAS() do { const float dqf_ = (float)((U.tok0 + wid * 32 + r32) - (U.row0 + 64 * t + 4 * hi)); \
        const ATT_LAS float* tb_ = tab + TAB_PAD + ((U.row0 >> 6) + t - (U.tok0 + (wid >> 1)) + 7) * 31 + 15 - (32 * (wid & 1) + r32) + 4 * hi; \
        qk_bias<TYPE, AK>(p0, p1, kp0 + slot * SLOTB, qr, negm, U.slope2, dqf_, t - t_lo, tb_, ng0, ng1); \
        } while (0)
#define ATT_SM(vs) softmax_pv<AK, TYPE != 0>(p0, p1, mhat, negm, l, o, wsf, vb0 + (vs) * SLOTB, r32, hi)
    int slot = slot0;
    for (int t = 0; t < NT; ++t) {
        ATT_TS(1, { const int behind = has_next ? (PF - 1) : ((NT - 1 - t) < (PF - 1) ? (NT - 1 - t) : (PF - 1));
          if (behind >= 3) asm volatile("s_waitcnt vmcnt(6) lgkmcnt(0)\n\ts_barrier" ::: "memory");
          else if (behind == 2) asm volatile("s_waitcnt vmcnt(4) lgkmcnt(0)\n\ts_barrier" ::: "memory");
          else if (behind == 1) asm volatile("s_waitcnt vmcnt(2) lgkmcnt(0)\n\ts_barrier" ::: "memory");
          else asm volatile("s_waitcnt vmcnt(0) lgkmcnt(0)\n\ts_barrier" ::: "memory"); });
        const int nslot = (slot == NSLOT - 1) ? 0 : slot + 1, islot = (slot < 2) ? slot + NSLOT - 2 : slot - 2;
        ATT_TS(2, { if (t + PF < NT) ATT_DMA_U(U, t + PF, islot); else if (has_next) ATT_DMA_U(Un, t + PF - NT, islot); });
        bool rel = (t >= t_lo) && (t <= t_hi);
        if (TYPE == 0) { const int rb = U.row0 + 64 * t; rel = rel && (rb >= 0) && (rb < U.seqlen); }
        if (!lag) {
            if (rel) { ATT_TS(3, ATT_QK_BIAS()); ATT_TS(4, ATT_SM(slot)); }
        } else {
            if (pend) { ATT_TS(4, ATT_SM(pend_slot)); pend = false; }
            if (rel) { ATT_TS(3, ATT_QK_BIAS()); pend = true; pend_slot = slot; }
        }
        slot = nslot;
    }
#if MK_TS
    const unsigned ts_e0 = (unsigned)__builtin_amdgcn_s_memtime();
#endif
    { ATT_LOADQ_ASM(Un, qr); const float* rp_ = (Un.type == 1) ? Un.rpb + (tid < 15 * 31 ? tid : 0) : (const float*)Un.Q; ATT_LOADF_ASM(rpbn, rp_); }
    if (pend) { ATT_SM(pend_slot); }
    slot0 = slot;
    { auto rr = __builtin_amdgcn_permlane32_swap(__float_as_uint(l), __float_as_uint(l), false, false); l = __uint_as_float(rr[0]) + __uint_as_float(rr[1]); }
    asm volatile("" ::: "memory");
    if (hi == 0) wsf[32 + r32] = l;
    asm volatile("s_waitcnt lgkmcnt(0)" ::: "memory");
    float rli[16];
#pragma unroll
    for (int r = 0; r < 16; ++r) rli[r] = __builtin_amdgcn_rcpf(wsf[32 + crow(r, hi)]);
    { ATT_LAS bf16_t* stg = (ATT_LAS bf16_t*)(lds + LDS_OST) + wid * 2048;
#pragma unroll
      for (int r = 0; r < 16; ++r) { const int orow = crow(r, hi);
#pragma unroll
          for (int d0 = 0; d0 < 2; ++d0) { const unsigned pk = cvtpk_s(o[d0][r] * rli[r], 0.f); stg[orow * 64 + d0 * 32 + r32] = (bf16_t)(pk & 0xffffu); } }
      asm volatile("s_waitcnt lgkmcnt(0)" ::: "memory");
      bf16_t* Ow = U.O + (size_t)(wid * 32) * U.opitch;
#pragma unroll
      for (int i = 0; i < 4; ++i) { const int row = i * 8 + (lane >> 3), ch = lane & 7; const u32x4 v = *(const ATT_LAS u32x4*)(stg + row * 64 + ch * 8); *(u32x4*)(Ow + (size_t)row * U.opitch + ch * 8) = v; } }
    asm volatile("s_waitcnt lgkmcnt(0)" ::: "memory");
    rpbv = rpbn;
    asm volatile("s_waitcnt vmcnt(0)" : "+v"(qr[0]), "+v"(qr[1]), "+v"(qr[2]), "+v"(qr[3]), "+v"(rpbv) :: "memory");
#if MK_TS
    if (MK_TS == 5) ts_acc += (unsigned)__builtin_amdgcn_s_memtime() - ts_e0;
#endif
}
__device__ __forceinline__ void attn_stream_begin(const UnitP& U, bf16x8 (&qr)[4], float& rpbv, ATT_LAS unsigned char* lds) {
    int tid_ = threadIdx.x; asm volatile("" : "+v"(tid_));
    const int tid = tid_, lane = tid & 63, r32 = lane & 31, hi = lane >> 5; const int wid = __builtin_amdgcn_readfirstlane(tid >> 6);
    const unsigned lds0 = (unsigned)(uintptr_t)lds;
    ATT_LOADQ(U, qr); rpbv = 0.f; if (U.type == 1 && tid < 15 * 31) rpbv = U.rpb[tid];
#pragma unroll
    for (int j = 0; j < PF; ++j) ATT_DMA_U(U, j, j);
    asm volatile("" : "+v"(qr[0]), "+v"(qr[1]), "+v"(qr[2]), "+v"(qr[3]), "+v"(rpbv));
}
__device__ __forceinline__ void attn_stream_end() { asm volatile("s_waitcnt vmcnt(0) lgkmcnt(0)\n\ts_barrier" ::: "memory"); }
}
constexpr int NWAVES = 8;
constexpr int SEQ = 16384, DM = 1024, DEPTH = 4, NQH = 12, NMH = 4, NMEM = 256, WIN_A = 1536, WIN_B = 2560, DFF = 2816, NGU = 2 * DFF;
constexpr float LOG2E = 1.4426950408889634f, C2 = 0.125f * LOG2E;
constexpr int N_PHASES = 2 + 5 * DEPTH;
#ifndef MK_PER_PHASE
#define MK_PER_PHASE 0
#endif
#ifndef MK_DUP
#define MK_DUP 0
#endif
#ifndef MK_TS
#define MK_TS 0
#endif
#ifndef MK_TSL
#define MK_TSL 0
#endif
#ifndef MK_TSB
#define MK_TSB 0
#endif
#ifndef MK_TSW
#define MK_TSW 0
#endif
#ifndef MK_NAIVE
#define MK_NAIVE 0
#endif

constexpr size_t MiB = 1u << 20;
constexpr size_t WS_CTL = 0, CTL_ZERO_BYTES = 1 * MiB;
constexpr size_t WS_SSQA = 1 * MiB, WS_SSQB = 2 * MiB;
constexpr size_t WS_MEMN = 3 * MiB;
constexpr size_t WS_MKV = 4 * MiB;
constexpr size_t WS_WIN = 6 * MiB;
constexpr size_t WS_WOUT = WS_WIN + 16 * MiB, WS_WGU = WS_WOUT + 8 * MiB, WS_WDN = WS_WGU + 44 * MiB, WS_WMKV = WS_WDN + 22 * MiB;
constexpr size_t WS_XB = WS_WMKV + 4 * MiB;
constexpr size_t WS_PROJ = WS_XB + 32 * MiB;
constexpr size_t WS_Y = WS_PROJ + 80 * MiB;
constexpr size_t WS_H = WS_PROJ;
constexpr size_t WS_END = WS_Y + 32 * MiB;
static_assert(WS_END <= 256 * MiB, "d_ws map");
__host__ __device__ constexpr size_t win_off(int l) { return (size_t)((l >> 1) * 8 + (l & 1) * 3) * MiB; }
constexpr int CW_BAR = 4096;

constexpr int RING_OFF = 0, RING_BYTES = 131072, LDSCTL_OFF = 139264, MISC_OFF = LDSCTL_OFF + 320, LDS_BYTES = 147456;
static_assert(att::LDS_END <= LDSCTL_OFF && att::PF == 4, "attention scratch below the control words; the wait ladder in attn_unit is written for PF = 4 (and every unit has >= PF tiles)");

#define GAS __attribute__((address_space(1)))
#define LAS __attribute__((address_space(3)))
typedef unsigned short bf16;
typedef unsigned v4u __attribute__((ext_vector_type(4)));
typedef float f32x4 __attribute__((ext_vector_type(4)));
typedef short bf16x8 __attribute__((ext_vector_type(8)));
typedef GAS unsigned gu32;
typedef GAS unsigned long long gu64;
#define RLX_AGENT __ATOMIC_RELAXED, __HIP_MEMORY_SCOPE_AGENT
#define LDS_WAIT() asm volatile("s_waitcnt lgkmcnt(0)" ::: "memory")
#define VM_WAIT() asm volatile("s_waitcnt vmcnt(0)" ::: "memory")
__device__ __forceinline__ unsigned long long rt() { return __builtin_amdgcn_s_memrealtime(); }
__device__ __forceinline__ unsigned f2bf(float f) { unsigned u = __builtin_bit_cast(unsigned, f); return (u + 0x7fffu + ((u >> 16) & 1u)) >> 16; }
__device__ __forceinline__ unsigned pk2(float lo, float hi) { return f2bf(lo) | (f2bf(hi) << 16); }

#define XB_TMO      128
#define XB_XCNT(j)  (256  + 64 * (j))
#define XB_XSUB(j)  (1280 + 64 * (j))
#define XB_XGEN(j)  (2304 + 64 * (j))
#define XB_TOP      3328
#define XB_TOPGEN   3392
#define XCD_BAR_WORDS 3456
#define XB_SPIN_CAP (1u << 18)

__device__ __forceinline__ unsigned xb_ld(unsigned* p)              { return __hip_atomic_load(p, __ATOMIC_RELAXED, __HIP_MEMORY_SCOPE_AGENT); }
__device__ __forceinline__ unsigned xb_add(unsigned* p, unsigned v) { return __hip_atomic_fetch_add(p, v, __ATOMIC_RELAXED, __HIP_MEMORY_SCOPE_AGENT); }
__device__ __forceinline__ unsigned xb_xcc_id() { return (unsigned)__builtin_amdgcn_s_getreg((3 << 11) | 20) & 0xFu; }
#define XB_SPIN(cond, bar) do { unsigned _sp = 0; while (cond) { __builtin_amdgcn_s_sleep(1); \
    if ((++_sp & 255u) == 0u) { if (xb_ld(&(bar)[XB_TMO])) break; if (_sp > XB_SPIN_CAP) { atomicAdd(&(bar)[XB_TMO], 1u); break; } } } } while (0)

struct XcdBarrier {
    unsigned* bar; unsigned x;
    volatile LAS unsigned* st;
};

__device__ __forceinline__ XcdBarrier xcd_barrier_post(unsigned* bar, volatile LAS unsigned* st) {
    XcdBarrier b; b.bar = bar; b.x = xb_xcc_id(); b.st = st;
    if (threadIdx.x == 0) (void)xb_add(&bar[XB_XCNT(b.x)], 1u);
    return b;
}
__device__ __forceinline__ void xcd_barrier_complete(unsigned* bar, unsigned x, unsigned& nloc, unsigned& nx) {
    const unsigned G = gridDim.x * gridDim.y * gridDim.z;
    unsigned sum, cnt, mine, sp = 0u;
    for (;;) {
        sum = 0u; cnt = 0u; mine = 0u;
#pragma unroll
        for (unsigned j = 0; j < 16; ++j) { const unsigned c = xb_ld(&bar[XB_XCNT(j)]); sum += c; cnt += (c > 0u) ? 1u : 0u; mine = (j == x) ? c : mine; }
        if (sum == G) break;
        __builtin_amdgcn_s_sleep(1);
        if ((++sp & 255u) == 0u) { if (xb_ld(&bar[XB_TMO])) break; if (sp > XB_SPIN_CAP) { atomicAdd(&bar[XB_TMO], 1u); break; } }
    }
    nloc = mine > 0u ? mine : 1u; nx = cnt > 0u ? cnt : 1u;
}

__device__ __forceinline__ void xcd_barrier(const XcdBarrier& b) {
    asm volatile("s_waitcnt vmcnt(0)" ::: "memory");
    __syncthreads();
    if (threadIdx.x == 0) {
        unsigned* bar = b.bar;
        __builtin_amdgcn_s_waitcnt(0);
        unsigned nloc = b.st[0], nx = b.st[1];
        if (nloc == 0u) { xcd_barrier_complete(bar, b.x, nloc, nx); b.st[0] = nloc; b.st[1] = nx; }
        const unsigned old = xb_add(&bar[XB_XSUB(b.x)], 1u);
        const unsigned gen = old / nloc;
        if (old + 1u == (gen + 1u) * nloc) {
            __builtin_amdgcn_fence(__ATOMIC_RELEASE, "agent");
            asm volatile("s_waitcnt vmcnt(0)" ::: "memory");
            const unsigned og = xb_add(&bar[XB_TOP], 1u);
            const unsigned tg = og / nx;
            if (og + 1u == (tg + 1u) * nx) xb_add(&bar[XB_TOPGEN], 1u);
            else XB_SPIN(xb_ld(&bar[XB_TOPGEN]) == tg, bar);
            __builtin_amdgcn_fence(__ATOMIC_ACQUIRE, "agent");
            xb_add(&bar[XB_XGEN(b.x)], 1u);
            asm volatile("s_waitcnt vmcnt(0)" ::: "memory");
        } else {
            XB_SPIN(xb_ld(&bar[XB_XGEN(b.x)]) == gen, bar);
            __builtin_amdgcn_fence(__ATOMIC_ACQUIRE, "agent");
            asm volatile("s_waitcnt vmcnt(0)" ::: "memory");
        }
    }
    __syncthreads();
}
struct Frame {
    LAS unsigned char* lds;
    volatile LAS unsigned* MISC;
    gu32* ctl;
    int tid, lane, wave;
    int vcu, G;
    const float *x, *mem, *norm_mix, *norm_ffn, *norm_mem, *norm_final, *w_in_a, *sink_a, *w_in_b, *rpb_b, *w_mem_kv, *w_out, *w_gate_up, *w_down;
    float* out; unsigned char* ws;
};
__device__ __forceinline__ float wave_sum(float v) {
#pragma unroll
    for (int o = 1; o < 64; o <<= 1) v += __shfl_xor(v, o);
    return v;
}
__device__ __forceinline__ void transpose_item(const float* W, int K, int N, bf16* WT, int mode, const float* g, LAS float* scr, int item, int lane) {
    const int nblk = N / 32, kb = item / nblk, nb = item % nblk, k0 = 64 * kb, n0 = 32 * nb;
    const float gl = g ? g[k0 + lane] : 1.f;
    const float* wp = W + (size_t)(k0 + (lane >> 5)) * N + n0 + (lane & 31);
    float wv[32];
#pragma unroll
    for (int i = 0; i < 32; ++i) wv[i] = wp[(size_t)(2 * i) * N];
#pragma unroll
    for (int i = 0; i < 32; ++i) { const float g0 = __uint_as_float(__builtin_amdgcn_readlane(__float_as_uint(gl), 2 * i)), g1 = __uint_as_float(__builtin_amdgcn_readlane(__float_as_uint(gl), 2 * i + 1));
        scr[(2 * i + (lane >> 5)) * 33 + (lane & 31)] = wv[i] * ((lane >> 5) ? g1 : g0); }
    LDS_WAIT(); asm volatile("" ::: "memory");
    int rbase = n0;
    if (mode == 1) { rbase = (n0 < DFF) ? ((n0 / 128) * 256 + (n0 % 128)) : (((n0 - DFF) / 128) * 256 + 128 + ((n0 - DFF) % 128)); }
    const int c = lane & 7;
#pragma unroll
    for (int j = 0; j < 4; ++j) { const int n = (lane >> 3) + 8 * j; const LAS float* s = scr + (8 * c) * 33 + n;
        v4u o; o.x = pk2(s[0 * 33], s[1 * 33]); o.y = pk2(s[2 * 33], s[3 * 33]); o.z = pk2(s[4 * 33], s[5 * 33]); o.w = pk2(s[6 * 33], s[7 * 33]);
        *(GAS v4u*)(WT + (size_t)(rbase + n) * K + k0 + 8 * c) = o; }
    LDS_WAIT(); asm volatile("" ::: "memory");
}
constexpr int IT_OUT = 16 * 32, IT_GU = 16 * (NGU / 32), IT_DN = (DFF / 64) * 32, IT_MKV = 16 * 16;
__device__ __forceinline__ void convert_part(Frame& F, int l, int part, int gw, int NGW) {
    LAS float* scr = (LAS float*)(F.lds + RING_OFF + F.wave * 16384);
    int lane = F.lane; asm volatile("" : "+v"(lane));
    const int nin = (l & 1) ? WIN_B : WIN_A, iin = 16 * (nin / 32);
    const int n0 = (part == 0) ? iin : (part == 1) ? IT_GU : DEPTH * IT_MKV, ntot = (part == 0) ? iin + IT_OUT : (part == 1) ? IT_GU + IT_DN : DEPTH * IT_MKV;
    for (int it = gw; it < ntot; it += NGW) {
        const float* W; const float* g = nullptr; bf16* WT; int K = DM, N, mode = 0, item = it;
        if (part == 0) {
            if (it < n0) { W = (l & 1) ? F.w_in_b + (size_t)(l >> 1) * DM * WIN_B : F.w_in_a + (size_t)(l >> 1) * DM * WIN_A; N = nin; WT = (bf16*)(F.ws + WS_WIN + win_off(l)); g = F.norm_mix + l * DM; }
            else { W = F.w_out + (size_t)l * DM * DM; N = DM; WT = (bf16*)(F.ws + WS_WOUT + (size_t)l * 2 * MiB); item = it - n0; }
        } else if (part == 1) {
            if (it < n0) { W = F.w_gate_up + (size_t)l * DM * NGU; N = NGU; WT = (bf16*)(F.ws + WS_WGU + (size_t)l * 11 * MiB); mode = 1; g = F.norm_ffn + l * DM; }
            else { W = F.w_down + (size_t)l * DFF * DM; K = DFF; N = DM; WT = (bf16*)(F.ws + WS_WDN + (size_t)l * DFF * DM * 2); item = it - n0; }
        } else { const int lm = it / IT_MKV; W = F.w_mem_kv + (size_t)lm * DM * 512; N = 512; WT = (bf16*)(F.ws + WS_WMKV + (size_t)lm * MiB); item = it % IT_MKV; }
        transpose_item(W, K, N, WT, mode, g, scr, item, lane);
    }
}
__device__ __forceinline__ void convert_filler(Frame& F, int l, int part, int nwg) {
    const int rem = nwg % F.G, c = (int)blockIdx.x;
    if (rem == 0) convert_part(F, l, part, c * NWAVES + F.wave, F.G * NWAVES);
    else if (c >= rem) convert_part(F, l, part, (c - rem) * NWAVES + F.wave, (F.G - rem) * NWAVES);
}
__device__ __forceinline__ void p0_prologue(Frame& F) {
    const int gw = F.vcu * NWAVES + F.wave, NGW = F.G * NWAVES;
    for (int part = 0; part < 3; ++part) convert_part(F, 0, part, gw, NGW);
    for (int m = gw; m < SEQ; m += NGW) {
        const GAS f32x4* xr = (const GAS f32x4*)(F.x + (size_t)m * DM) + F.lane; f32x4 v[4]; float s = 0.f;
#pragma unroll
        for (int j = 0; j < 4; ++j) { v[j] = xr[64 * j]; s += (v[j].x * v[j].x + v[j].y * v[j].y) + (v[j].z * v[j].z + v[j].w * v[j].w); }
        s = wave_sum(s);
        GAS unsigned long long* o8 = (GAS unsigned long long*)(F.ws + WS_XB + (size_t)m * DM * 2) + F.lane;
#pragma unroll
        for (int j = 0; j < 4; ++j) o8[64 * j] = (unsigned long long)pk2(v[j].x, v[j].y) | ((unsigned long long)pk2(v[j].z, v[j].w) << 32);
        if (F.lane < 16) ((GAS float*)(F.ws + WS_SSQA))[(size_t)m * 16 + F.lane] = (F.lane == 0) ? s : 0.f;
    }
    for (int m = gw; m < NMEM; m += NGW) {
        const GAS f32x4* xr = (const GAS f32x4*)(F.mem + (size_t)m * DM) + F.lane; const GAS f32x4* gr = (const GAS f32x4*)F.norm_mem + F.lane; f32x4 v[4]; float s = 0.f;
#pragma unroll
        for (int j = 0; j < 4; ++j) { v[j] = xr[64 * j]; s += (v[j].x * v[j].x + v[j].y * v[j].y) + (v[j].z * v[j].z + v[j].w * v[j].w); }
        const float rstd = 1.0f / sqrtf(wave_sum(s) * (1.0f / DM) + 1e-6f);
        GAS unsigned long long* o8 = (GAS unsigned long long*)(F.ws + WS_MEMN + (size_t)m * DM * 2) + F.lane;
#pragma unroll
        for (int j = 0; j < 4; ++j) { const f32x4 g = gr[64 * j]; const f32x4 y = v[j] * rstd * g; o8[64 * j] = (unsigned long long)pk2(y.x, y.y) | ((unsigned long long)pk2(y.z, y.w) << 32); }
    }
}
__device__ __forceinline__ void final_norm(Frame& F) {
    const int gw = F.vcu * NWAVES + F.wave, NGW = F.G * NWAVES;
    const GAS f32x4* gr = (const GAS f32x4*)F.norm_final + F.lane;
    for (int m = gw; m < SEQ; m += NGW) {
        GAS f32x4* xr = (GAS f32x4*)(F.out + (size_t)m * DM) + F.lane;
        const float rstd = pg8::row_rstd((const float*)(F.ws + WS_SSQA), m);
#pragma unroll
        for (int j = 0; j < 4; ++j) { const f32x4 v = xr[64 * j], g = gr[64 * j]; f32x4 y = v * rstd * g;
#if MK_TS
            if (m == 0 && j == 0 && F.lane == 0) { const unsigned ta = __hip_atomic_load((unsigned*)F.ctl + 8, __ATOMIC_RELAXED, __HIP_MEMORY_SCOPE_AGENT), tb = __hip_atomic_load((unsigned*)F.ctl + 9, __ATOMIC_RELAXED, __HIP_MEMORY_SCOPE_AGENT); y.x += 0.05f + 0.1f * ((float)ta / (float)(tb ? tb : 1u)); }
#endif
            xr[64 * j] = y; }
    }
}
__device__ __forceinline__ att::UnitP attn_make_unit(Frame& F, int l, int u) {
    const bool isA = (l & 1) == 0; const int nkv = isA ? 4 : 12; constexpr size_t SS = (size_t)SEQ * 64, MS = (size_t)NMEM * 64;
    const att::bf16_t* P = (const att::bf16_t*)(F.ws + WS_PROJ); att::bf16_t* Y = (att::bf16_t*)(F.ws + WS_Y);
    const att::bf16_t* MKV = (const att::bf16_t*)(F.ws + WS_MKV) + (size_t)l * 8 * MS;
    att::UnitP U; U.seqlen = SEQ; U.rpb = nullptr; U.slope2 = 0.f; U.m0 = -1e30f; U.l0 = 0.f; U.qpitch = 64; U.kvpitch = 64; U.opitch = DM;
    if (u < 768) {
        const int h = u % NQH, blk = u / NQH, tok0 = blk * 256;
        U.Q = P + (size_t)h * SS + (size_t)tok0 * 64; U.O = Y + (size_t)tok0 * DM + h * 64; U.kvmax = SEQ - 1;
        if (isA) {
            U.type = 0; U.K = P + (size_t)(12 + h / 3) * SS; U.V = P + (size_t)(16 + h / 3) * SS; U.row0 = tok0 - 128; U.ntiles = 8; U.tok0 = tok0;
            U.slope2 = exp2f(-8.0f * (float)(h + 1) / 12.0f) * LOG2E; U.m0 = F.sink_a[(l >> 1) * NQH + h] * LOG2E; U.l0 = 1.f;
        } else {
            const int R0 = blk * 4; int T0 = R0 - 4; T0 = T0 < 0 ? 0 : (T0 > 248 ? 248 : T0); int T1 = R0 - 1; T1 = T1 < 0 ? 0 : (T1 > 248 ? 248 : T1); T1 += 7;
            U.type = 1; U.K = P + (size_t)(12 + h) * SS; U.V = P + (size_t)(24 + h) * SS; U.row0 = T0 * 64; U.ntiles = T1 - T0 + 1; U.tok0 = R0;
            U.rpb = F.rpb_b + ((size_t)(l >> 1) * NQH + h) * 15 * 31;
        }
    } else {
        const int v = u - 768, hm = v % NMH, blk = v / NMH, tok0 = blk * 256;
        U.type = 2; U.Q = P + (size_t)(12 + 2 * nkv + hm) * SS + (size_t)tok0 * 64; U.O = Y + (size_t)tok0 * DM + 768 + hm * 64;
        U.K = MKV + (size_t)hm * MS; U.V = MKV + (size_t)(4 + hm) * MS; U.kvmax = NMEM - 1; U.row0 = 0; U.ntiles = 4; U.tok0 = tok0;
    }
    return U;
}
__device__ __forceinline__ int attn_next_u(Frame& F, int u, int amask) {
    for (u = (u < 0) ? F.vcu : u + F.G; u < 1024; u += F.G) if (amask & (u < 768 ? 1 : 2)) break;
    return u;
}
__device__ __forceinline__ void attn_phase(Frame& F, int l, int amask) {
    int u = attn_next_u(F, -1, amask);
    if (u >= 1024) return;
    att::UnitP U = attn_make_unit(F, l, u);
    att::bf16x8 qr[4]; float rpbv; int slot0 = 0, parity = 0; unsigned ts_acc = 0;
#if MK_TS
    const unsigned ts_t0 = (unsigned)__builtin_amdgcn_s_memtime();
#endif
    att::attn_stream_begin(U, qr, rpbv, F.lds + RING_OFF);
    for (;;) {
        const int un = attn_next_u(F, u, amask); const bool has_next = un < 1024;
        const att::UnitP Un = attn_make_unit(F, l, has_next ? un : u);
#define ATTN_CALL(T, C, L) att::attn_unit<T, C, L>(U, Un, has_next, slot0, qr, rpbv, parity, F.lds + RING_OFF, ts_acc)
        const bool lagw = (ATT_LAG != 0) && F.wave >= 4;
        if (U.type == 0) { if (lagw) ATTN_CALL(0, 0, true); else ATTN_CALL(0, 0, false); }
        else if (U.type == 1) { if (F.wave & 1) { if (lagw) ATTN_CALL(1, 1, true); else ATTN_CALL(1, 1, false); } else { if (lagw) ATTN_CALL(1, 0, true); else ATTN_CALL(1, 0, false); } }
        else { if (lagw) ATTN_CALL(2, 0, true); else ATTN_CALL(2, 0, false); }
#undef ATTN_CALL
        if (!has_next) break;
        U = Un; u = un; parity ^= 1;
    }
    att::attn_stream_end();
#if MK_TS
    if (l == MK_TSL && blockIdx.x == MK_TSB && F.tid == MK_TSW * 64) { ((unsigned*)F.ctl)[8] = ts_acc; ((unsigned*)F.ctl)[9] = (unsigned)__builtin_amdgcn_s_memtime() - ts_t0; }
#endif
}

struct Args { const float* in[14]; float* out; unsigned char* ws; int ph_lo, ph_hi, li, amask; };
__global__ void __launch_bounds__(NWAVES * 64, 2) skel_fwd(Args args) {
    extern __shared__ __attribute__((aligned(16))) unsigned char lds[];
    Frame F;
    F.lds = (LAS unsigned char*)lds;
    F.MISC = (volatile LAS unsigned*)(F.lds + MISC_OFF);
    F.tid = threadIdx.x; F.lane = F.tid & 63; F.wave = __builtin_amdgcn_readfirstlane(F.tid >> 6);
    F.G = gridDim.x; { const int bx = blockIdx.x; F.vcu = (F.G % 8 == 0) ? (bx % 8) * (F.G / 8) + bx / 8 : bx; }
    F.ws = args.ws; F.out = args.out; F.ctl = (gu32*)(args.ws + WS_CTL);
    F.x = args.in[0]; F.mem = args.in[1]; F.norm_mix = args.in[2]; F.norm_ffn = args.in[3]; F.norm_mem = args.in[4]; F.norm_final = args.in[5]; F.w_in_a = args.in[6]; F.sink_a = args.in[7];
    F.w_in_b = args.in[8]; F.rpb_b = args.in[9]; F.w_mem_kv = args.in[10]; F.w_out = args.in[11]; F.w_gate_up = args.in[12]; F.w_down = args.in[13];
    for (int u = F.tid; u < (LDS_BYTES - LDSCTL_OFF) / 4; u += NWAVES * 64) ((LAS unsigned*)(F.lds + LDSCTL_OFF))[u] = 0u;
    __syncthreads();
    XcdBarrier bar; bar.bar = (unsigned*)(F.ctl + CW_BAR) + args.li * XCD_BAR_WORDS; bar.x = 0; bar.st = nullptr;
    if (!MK_PER_PHASE) bar = xcd_barrier_post((unsigned*)(F.ctl + CW_BAR) + args.li * XCD_BAR_WORDS, F.MISC + 8);
    const int lo = args.ph_lo, hi = args.ph_hi;
#define IN(k) (lo <= (k) && (k) < hi)
#define SEAM(k) do { if (IN((k) + 1)) { xcd_barrier(bar); if (MK_DUP & 16) xcd_barrier(bar); } } while (0)
    typedef pg8::bf16_t pb;
    if (IN(0)) { for (int rep = 0; rep < ((MK_DUP & 1) ? 2 : 1); ++rep) { p0_prologue(F); SEAM(0); } }
    for (int l = 0; l < DEPTH; ++l) {
        const int pb0 = 1 + 5 * l; const bool isA = (l & 1) == 0; const int nin = isA ? WIN_A : WIN_B;
        if (IN(pb0)) { for (int rep = 0; rep < ((MK_DUP & 2) ? 2 : 1); ++rep) {
            { pg8::Gemm g{(const pb*)(F.ws + WS_XB), (const pb*)(F.ws + WS_WIN + win_off(l)), SEQ, nin, DM}; pg8::StaticOrder S; S.init(SEQ, nin, F.G, (int)blockIdx.x);
              pg8::EpiProj E{(pb*)(F.ws + WS_PROJ), (size_t)SEQ * 64, (const float*)(F.ws + WS_SSQA), 3, nin / 256 - 1, C2};
              pg8::gemm_phase<pg8::EpiProj, pg8::StaticOrder, true, true>(F.lds + RING_OFF, g, S, E); }
            if (l == 0) { pg8::Gemm g{(const pb*)(F.ws + WS_MEMN), (const pb*)(F.ws + WS_WMKV), NMEM, 2048, DM}; pg8::StaticOrder S; S.init(NMEM, 2048, F.G, (int)((blockIdx.x + F.G - 8) % F.G));
              pg8::EpiProj E{(pb*)(F.ws + WS_MKV), (size_t)NMEM * 64, nullptr, 0, -1, 1.f};
              pg8::gemm_phase<pg8::EpiProj, pg8::StaticOrder, true, true>(F.lds + RING_OFF, g, S, E); }
            if (l + 1 < DEPTH) convert_filler(F, l + 1, 0, (SEQ / 256) * (nin / 256));
            SEAM(pb0); }
        }
        if (IN(pb0 + 1)) { for (int rep = 0; rep < ((MK_DUP & (4 | 32 | 64)) ? ((MK_DUP & 128) ? 5 : 2) : 1); ++rep) { attn_phase(F, l, (rep == 0 || (MK_DUP & 4)) ? args.amask : ((MK_DUP & 32) ? 1 : 2)); SEAM(pb0 + 1); } }
        if (IN(pb0 + 2)) {
            pg8::Gemm g{(const pb*)(F.ws + WS_Y), (const pb*)(F.ws + WS_WOUT + (size_t)l * 2 * MiB), SEQ, DM, DM}; pg8::StaticOrder S; S.init(SEQ, DM, F.G, (int)blockIdx.x);
            pg8::EpiRes E{l == 0 ? F.x : (const float*)F.out, F.out, (pb*)(F.ws + WS_XB), (float*)(F.ws + WS_SSQB), DM};
            pg8::gemm_phase<pg8::EpiRes, pg8::StaticOrder, true, true>(F.lds + RING_OFF, g, S, E);
            SEAM(pb0 + 2);
        }
        if (IN(pb0 + 3)) { for (int rep = 0; rep < ((MK_DUP & 8) ? 2 : 1); ++rep) {
            pg8::Gemm g{(const pb*)(F.ws + WS_XB), (const pb*)(F.ws + WS_WGU + (size_t)l * 11 * MiB), SEQ, NGU, DM}; pg8::StaticOrder S; S.init(SEQ, NGU, F.G, (int)blockIdx.x);
            pg8::EpiGU E{(pb*)(F.ws + WS_H), DFF, (const float*)(F.ws + WS_SSQB)};
            pg8::gemm_phase<pg8::EpiGU, pg8::StaticOrder, true, true>(F.lds + RING_OFF, g, S, E);
            if (l + 1 < DEPTH) convert_filler(F, l + 1, 1, (SEQ / 256) * (NGU / 256));
            SEAM(pb0 + 3); }
        }
        if (IN(pb0 + 4)) {
            pg8::Gemm g{(const pb*)(F.ws + WS_H), (const pb*)(F.ws + WS_WDN + (size_t)l * DFF * DM * 2), SEQ, DM, DFF}; pg8::StaticOrder S; S.init(SEQ, DM, F.G, (int)blockIdx.x);
            pg8::EpiRes E{(const float*)F.out, F.out, (pb*)(F.ws + WS_XB), (float*)(F.ws + WS_SSQA), DM};
            pg8::gemm_phase<pg8::EpiRes, pg8::StaticOrder, true, true>(F.lds + RING_OFF, g, S, E);
            SEAM(pb0 + 4);
        }
    }
    if (IN(N_PHASES - 1)) final_norm(F);
#undef IN
#undef SEAM
}
#if MK_PER_PHASE && MK_NAIVE
namespace nv {
__device__ __forceinline__ float bf2f(unsigned short b) { return __uint_as_float((unsigned)b << 16); }
struct GArgs { const bf16* A; const bf16* Bt; int M, N, K, mode;
    bf16* O; int ldc; const float* ssq; int nq_tiles, qm_tile; float qscale;
    const float* base; float* out; bf16* xb; };
__global__ void __launch_bounds__(256) naive_gemm(GArgs a) {
    __shared__ float As[16][65], Bs[16][65], Bs2[16][65];
    const int tx = threadIdx.x & 15, ty = threadIdx.x >> 4, bx = blockIdx.x, by = blockIdx.y;
    float acc[4][4], acc2[4][4];
#pragma unroll
    for (int i = 0; i < 4; ++i)
#pragma unroll
        for (int j = 0; j < 4; ++j) { acc[i][j] = 0.f; acc2[i][j] = 0.f; }
    const int lr = threadIdx.x >> 2, lk = (threadIdx.x & 3) * 4;
    const int jc = bx * 64 + lr;
    const size_t brow = (a.mode == 2) ? (size_t)((jc / 128) * 256 + (jc % 128)) : (size_t)jc;
    for (int k0 = 0; k0 < a.K; k0 += 16) {
        const bf16* ap = a.A + (size_t)(by * 64 + lr) * a.K + k0 + lk; const bf16* bp = a.Bt + brow * a.K + k0 + lk;
#pragma unroll
        for (int i = 0; i < 4; ++i) { As[lk + i][lr] = bf2f(ap[i]); Bs[lk + i][lr] = bf2f(bp[i]); if (a.mode == 2) Bs2[lk + i][lr] = bf2f(bp[(size_t)128 * a.K + i]); }
        __syncthreads();
#pragma unroll
        for (int k = 0; k < 16; ++k) {
#pragma unroll
            for (int i = 0; i < 4; ++i)
#pragma unroll
                for (int j = 0; j < 4; ++j) { acc[i][j] += As[k][ty * 4 + i] * Bs[k][tx * 4 + j]; if (a.mode == 2) acc2[i][j] += As[k][ty * 4 + i] * Bs2[k][tx * 4 + j]; }
        }
        __syncthreads();
    }
#pragma unroll
    for (int i = 0; i < 4; ++i)
#pragma unroll
        for (int j = 0; j < 4; ++j) {
            const int row = by * 64 + ty * 4 + i, col = bx * 64 + tx * 4 + j;
            if (a.mode == 0) { float rs = 1.f; if (a.ssq) { float s = 0.f; for (int q = 0; q < 16; ++q) s += a.ssq[(size_t)row * 16 + q]; rs = 1.0f / sqrtf(s * (1.0f / 1024.0f) + 1e-6f); }
                const int pn = col / 256; const float sc = (pn < a.nq_tiles || pn == a.qm_tile) ? a.qscale : 1.f;
                a.O[(size_t)(col >> 6) * ((size_t)a.M * 64) + (size_t)row * 64 + (col & 63)] = (bf16)f2bf(acc[i][j] * rs * sc); }
            else if (a.mode == 1) { const size_t o = (size_t)row * a.ldc + col; const float v = a.base[o] + acc[i][j]; a.out[o] = v; a.xb[o] = (bf16)f2bf(v); }
            else { float s = 0.f; for (int q = 0; q < 16; ++q) s += a.ssq[(size_t)row * 16 + q]; const float rs = 1.0f / sqrtf(s * (1.0f / 1024.0f) + 1e-6f);
                const float g = acc[i][j] * rs, u = acc2[i][j] * rs; a.O[(size_t)row * a.ldc + col] = (bf16)f2bf(g / (1.0f + expf(-g)) * u); }
        }
}
__global__ void __launch_bounds__(256) naive_ssq(const float* x, float* ssq) {
    const int row = blockIdx.x * 256 + threadIdx.x; float s = 0.f;
    for (int c = 0; c < DM; ++c) { const float v = x[(size_t)row * DM + c]; s += v * v; }
    for (int q = 0; q < 16; ++q) ssq[(size_t)row * 16 + q] = (q == 0) ? s : 0.f;
}
__device__ __forceinline__ void ld64(const bf16* p, float (&v)[64]) {
#pragma unroll
    for (int c = 0; c < 8; ++c) { const uint4 w = *(const uint4*)(p + 8 * c); const unsigned ww[4] = {w.x, w.y, w.z, w.w};
#pragma unroll
        for (int e = 0; e < 4; ++e) { v[8 * c + 2 * e] = __uint_as_float(ww[e] << 16); v[8 * c + 2 * e + 1] = __uint_as_float(ww[e] & 0xffff0000u); } }
}
__global__ void __launch_bounds__(256) naive_attn(int type, const bf16* P, int nkv, const bf16* MKV, const float* sink, const float* rpb, bf16* Y) {
    const int idx = blockIdx.x * 256 + threadIdx.x; const int nh = (type == 2) ? NMH : NQH; const int h = idx % nh, t = idx / nh;
    constexpr size_t SS = (size_t)SEQ * 64, MS = (size_t)NMEM * 64;
    float q[64], o[64], kv[64];
    ld64(P + (size_t)(type == 2 ? 12 + 2 * nkv + h : h) * SS + (size_t)t * 64, q);
#pragma unroll
    for (int d = 0; d < 64; ++d) o[d] = 0.f;
    float m = -1e30f, l = 0.f;
    int nkeys; if (type == 0) { m = sink[h] * LOG2E; l = 1.f; nkeys = 257; } else if (type == 1) nkeys = 128; else nkeys = 256;
    const float slope2 = exp2f(-8.0f * (float)(h + 1) / 12.0f) * LOG2E;
    const int r = t / 64, c = t % 64; int rs = r - 4; rs = rs < 0 ? 0 : (rs > 248 ? 248 : rs); int cs = c - 8; cs = cs < 0 ? 0 : (cs > 48 ? 48 : cs);
    for (int i = 0; i < nkeys; ++i) {
        const bf16 *kp, *vp; float bias = 0.f;
        if (type == 0) { const int s = t - 128 + i; if (s < 0 || s >= SEQ) continue; kp = P + (size_t)(12 + h / 3) * SS + (size_t)s * 64; vp = P + (size_t)(16 + h / 3) * SS + (size_t)s * 64; bias = -slope2 * fabsf((float)(t - s)); }
        else if (type == 1) { const int kr = rs + (i >> 4), kc = cs + (i & 15); const int s = kr * 64 + kc; kp = P + (size_t)(12 + h) * SS + (size_t)s * 64; vp = P + (size_t)(24 + h) * SS + (size_t)s * 64;
            bias = rpb[(size_t)h * 15 * 31 + (kr - r + 7) * 31 + (kc - c + 15)] * LOG2E; }
        else { kp = MKV + (size_t)h * MS + (size_t)i * 64; vp = MKV + (size_t)(4 + h) * MS + (size_t)i * 64; }
        ld64(kp, kv); float dot = 0.f;
#pragma unroll
        for (int d = 0; d < 64; ++d) dot += q[d] * kv[d];
        const float sc = dot + bias, mn = fmaxf(m, sc), al = exp2f(m - mn), p = exp2f(sc - mn);
        ld64(vp, kv); l = l * al + p;
#pragma unroll
        for (int d = 0; d < 64; ++d) o[d] = o[d] * al + p * kv[d];
        m = mn;
    }
    const float il = 1.0f / l; bf16* yp = Y + (size_t)t * DM + (type == 2 ? 768 : 0) + h * 64;
#pragma unroll
    for (int d = 0; d < 64; ++d) yp[d] = (bf16)f2bf(o[d] * il);
}
}
#endif
extern "C" void kernel_launch(void* const* d_in, const int* in_sizes, int n_in, void* d_out, int out_size, void* d_ws, size_t ws_size, hipStream_t stream) {
    static int grid = 0;
    if (grid == 0) {
        if (n_in != 14 || in_sizes[0] != SEQ * DM || out_size != SEQ * DM || ws_size < WS_END) { fprintf(stderr, "kernel_launch: unexpected shapes (n_in %d, in0 %d, out %d, ws %zu); nothing launched\n", n_in, n_in > 0 ? in_sizes[0] : -1, out_size, ws_size); grid = -1; return; }
        int dev = 0, cus = 0, per_cu = 0;
        if (hipGetDevice(&dev) != hipSuccess || hipDeviceGetAttribute(&cus, hipDeviceAttributeMultiprocessorCount, dev) != hipSuccess) { grid = -1; return; }
        if (hipFuncSetAttribute((const void*)skel_fwd, hipFuncAttributeMaxDynamicSharedMemorySize, LDS_BYTES) != hipSuccess) { fprintf(stderr, "kernel_launch: hipFuncSetAttribute failed\n"); grid = -1; return; }
        if (hipOccupancyMaxActiveBlocksPerMultiprocessor(&per_cu, (const void*)skel_fwd, NWAVES * 64, LDS_BYTES) != hipSuccess || per_cu < 1)
            fprintf(stderr, "kernel_launch: note: occupancy query reports %d workgroups per CU\n", per_cu);
        (void)hipGetLastError();
        grid = cus;
    }
    if (grid < 0) return;
    if (hipMemsetAsync((char*)d_ws + WS_CTL, 0, CTL_ZERO_BYTES, stream) != hipSuccess) return;
    Args a{};
    for (int i = 0; i < 14; ++i) a.in[i] = (const float*)d_in[i];
    a.out = (float*)d_out; a.ws = (unsigned char*)d_ws; a.amask = 3;
#if MK_PER_PHASE
    unsigned char* ws = (unsigned char*)d_ws; const float* const* in = (const float* const*)d_in;
    for (int p = 0; p < N_PHASES; ++p) {
        const int l = (p - 1) / 5, k = (p - 1) % 5; const bool mid = (p > 0 && p < N_PHASES - 1);
        (void)l; (void)k; (void)ws; (void)in;
#if MK_NAIVE
        if (mid && (MK_NAIVE & 1) && k != 1) {
            const int nin = (l & 1) ? WIN_B : WIN_A;
            nv::GArgs g{};
            if (k == 0) { g.A = (const bf16*)(ws + WS_XB); g.Bt = (const bf16*)(ws + WS_WIN + win_off(l)); g.M = SEQ; g.N = nin; g.K = DM; g.mode = 0; g.O = (bf16*)(ws + WS_PROJ); g.ldc = nin; g.ssq = (const float*)(ws + WS_SSQA);
                g.nq_tiles = 3; g.qm_tile = nin / 256 - 1; g.qscale = C2;
                hipLaunchKernelGGL(nv::naive_gemm, dim3(g.N / 64, g.M / 64), dim3(256), 0, stream, g);
                if (l == 0) { nv::GArgs m{}; m.A = (const bf16*)(ws + WS_MEMN); m.Bt = (const bf16*)(ws + WS_WMKV); m.M = NMEM; m.N = 2048; m.K = DM; m.mode = 0; m.O = (bf16*)(ws + WS_MKV); m.ldc = 2048; m.ssq = nullptr; m.nq_tiles = 0; m.qm_tile = -1; m.qscale = 1.f;
                    hipLaunchKernelGGL(nv::naive_gemm, dim3(m.N / 64, m.M / 64), dim3(256), 0, stream, m); } }
            else if (k == 2) { g.A = (const bf16*)(ws + WS_Y); g.Bt = (const bf16*)(ws + WS_WOUT + (size_t)l * 2 * MiB); g.M = SEQ; g.N = DM; g.K = DM; g.mode = 1; g.ldc = DM; g.base = (l == 0) ? in[0] : (const float*)d_out; g.out = (float*)d_out; g.xb = (bf16*)(ws + WS_XB);
                hipLaunchKernelGGL(nv::naive_gemm, dim3(g.N / 64, g.M / 64), dim3(256), 0, stream, g);
                hipLaunchKernelGGL(nv::naive_ssq, dim3(SEQ / 256), dim3(256), 0, stream, (const float*)d_out, (float*)(ws + WS_SSQB)); }
            else if (k == 3) { g.A = (const bf16*)(ws + WS_XB); g.Bt = (const bf16*)(ws + WS_WGU + (size_t)l * 11 * MiB); g.M = SEQ; g.N = DFF; g.K = DM; g.mode = 2; g.O = (bf16*)(ws + WS_H); g.ldc = DFF; g.ssq = (const float*)(ws + WS_SSQB);
                hipLaunchKernelGGL(nv::naive_gemm, dim3(g.N / 64, g.M / 64), dim3(256), 0, stream, g); }
            else { g.A = (const bf16*)(ws + WS_H); g.Bt = (const bf16*)(ws + WS_WDN + (size_t)l * DFF * DM * 2); g.M = SEQ; g.N = DM; g.K = DFF; g.mode = 1; g.ldc = DM; g.base = (const float*)d_out; g.out = (float*)d_out; g.xb = (bf16*)(ws + WS_XB);
                hipLaunchKernelGGL(nv::naive_gemm, dim3(g.N / 64, g.M / 64), dim3(256), 0, stream, g);
                hipLaunchKernelGGL(nv::naive_ssq, dim3(SEQ / 256), dim3(256), 0, stream, (const float*)d_out, (float*)(ws + WS_SSQA)); }
            continue;
        }
        a.amask = 3;
        if (mid && k == 1) {
            const int pitch = (l & 1) ? 12 : 4; const bf16* P = (const bf16*)(ws + WS_PROJ); const bf16* MKV = (const bf16*)(ws + WS_MKV) + (size_t)l * 8 * NMEM * 64; bf16* Y = (bf16*)(ws + WS_Y);
            if (MK_NAIVE & ((l & 1) ? 4 : 2)) { a.amask &= ~1;
                hipLaunchKernelGGL(nv::naive_attn, dim3(SEQ * NQH / 256), dim3(256), 0, stream, (l & 1), P, pitch, MKV, in[7] + (l >> 1) * NQH, in[9] + (size_t)(l >> 1) * NQH * 15 * 31, Y); }
            if (MK_NAIVE & 8) { a.amask &= ~2;
                hipLaunchKernelGGL(nv::naive_attn, dim3(SEQ * NMH / 256), dim3(256), 0, stream, 2, P, pitch, MKV, in[7], in[9], Y); }
            if (a.amask == 0) continue;
        }
#endif
        a.ph_lo = p; a.ph_hi = p + 1; a.li = p;
        hipLaunchKernelGGL(skel_fwd, dim3(grid), dim3(NWAVES * 64), LDS_BYTES, stream, a);
    }
#else
    a.ph_lo = 0; a.ph_hi = N_PHASES; a.li = 0;
    hipLaunchKernelGGL(skel_fwd, dim3(grid), dim3(NWAVES * 64), LDS_BYTES, stream, a);
#endif
    const hipError_t le = hipPeekAtLastError();
    if (le != hipSuccess) fprintf(stderr, "kernel_launch: launch failed: %s\n", hipGetErrorName(le));
}
```
